# Optimizing an MI355X kernel written in HIP

```python
import jax, jax.numpy as jnp
from jax import lax
import numpy as np

D_MODEL = 1024
BATCH = 16
SEQ = 256
DEPTH = 4
DEC_BATCH = 8
DEC_SEQ = 2048
PAST_LEN = 512

GRID_W = 64
N_MIXERS = 2
N_SGU = (DEPTH + 1) // 2
N_RWKV = DEPTH // 2
CHUNK = 128
SGU_WIDTH = D_MODEL
SGU_GROUPS = 16
HEAD_DIM = 64
N_HEADS = D_MODEL // HEAD_DIM
LORA_W = 64
LORA_A = 64
LORA_V = 32
LORA_G = 128
N_DIR = 2
D_FF = 4 * D_MODEL
NORM_EPS = 1e-6
GN_EPS = 64e-5

kernel_name = "hybrid_sgu_rwkv7_diffusion_step"


def _rmsnorm(x, g):
    xf = x.astype(jnp.float32)
    y = xf * lax.rsqrt(jnp.mean(xf * xf, axis=-1, keepdims=True) + NORM_EPS)
    return y.astype(x.dtype) * g


def _layernorm(x, g, b, eps):
    xf = x.astype(jnp.float32)
    mu = jnp.mean(xf, axis=-1, keepdims=True)
    var = jnp.mean(jnp.square(xf - mu), axis=-1, keepdims=True)
    return ((xf - mu) * lax.rsqrt(var + eps)).astype(x.dtype) * g + b


def _centred_shift(x):
    xp = jnp.pad(x, ((0, 0), (1, 1), (0, 0)))
    return 0.5 * (xp[:, :-2] + xp[:, 2:]) - x


def _heads(t):
    return t.reshape(t.shape[:-1] + (N_HEADS, HEAD_DIM))


def _sgu_mixer(h, w_in, ln_g, ln_b, w_s, b_s, w_out):
    B, L, _ = h.shape
    n_chunks = L // CHUNK
    z = jax.nn.gelu(h @ w_in)
    u, v = jnp.split(z, 2, axis=-1)
    v = _layernorm(v, ln_g, ln_b, NORM_EPS)
    v = v.reshape(B, n_chunks, CHUNK, SGU_GROUPS, SGU_WIDTH // SGU_GROUPS)
    v = jnp.einsum('gts,bcsgd->bctgd', w_s, v) + b_s.T[:, :, None]
    return (u * v.reshape(B, L, SGU_WIDTH)) @ w_out


def _wkv_scan(s0, r, decay, k, v, kk, a, reverse):
    def step(s, inp):
        r_t, w_t, k_t, v_t, kk_t, a_t = inp
        sa = jnp.einsum('bhij,bhj->bhi', s, -kk_t)
        s = (s * w_t[:, :, None, :]
             + sa[..., None] * (kk_t * a_t)[:, :, None, :]
             + v_t[..., None] * k_t[:, :, None, :])
        return s, jnp.einsum('bhij,bhj->bhi', s, r_t)
    xs = tuple(jnp.swapaxes(t, 0, 1) for t in (r, decay, k, v, kk, a))
    s_final, ys = lax.scan(step, s0, xs, reverse=reverse)
    return s_final, jnp.swapaxes(ys, 0, 1)


def _rwkv_mixer(h, s0, v_first, P, i):
    B, L, D = h.shape
    f32 = jnp.float32
    xx = _centred_shift(h)
    mu = P['rwkv_mu'][i]
    xr, xw, xk, xv, xa, xg = [h + xx * mu[j] for j in range(6)]
    r = _heads(xr @ P['rwkv_w_r'][i])
    k = _heads(xk @ P['rwkv_w_k'][i])
    v = xv @ P['rwkv_w_v'][i]
    if v_first is None:
        v_first = v
    else:
        j = i - 1
        v = v + (v_first - v) * jax.nn.sigmoid(P['rwkv_v0'][j] + (xv @ P['rwkv_v1'][j]) @ P['rwkv_v2'][j])
    v = _heads(v)
    g = jax.nn.sigmoid(xg @ P['rwkv_g1'][i]) @ P['rwkv_g2'][i]
    kk = (k * _heads(P['rwkv_k_k'][i])).astype(f32)
    kk = kk / jnp.maximum(jnp.sqrt(jnp.sum(kk * kk, axis=-1, keepdims=True)), 1e-12)
    k_a = _heads(P['rwkv_k_a'][i])
    r_k = P['rwkv_r_k'][i]
    y = jnp.zeros(r.shape, f32)
    bonus = 0.0
    finals = []
    for d in range(N_DIR):
        z = (P['rwkv_w0'][i, d] + jnp.tanh(xw @ P['rwkv_w1'][i, d]) @ P['rwkv_w2'][i, d]).astype(f32)
        decay = _heads(jnp.exp(-jnp.exp(-jax.nn.softplus(-z) - 0.5)))
        a = _heads(jax.nn.sigmoid(P['rwkv_a0'][i, d] + (xa @ P['rwkv_a1'][i, d]) @ P['rwkv_a2'][i, d]))
        k_d = k * (1 + (a - 1) * k_a)
        s_fin, y_d = _wkv_scan(s0[:, d].astype(f32), r.astype(f32), decay, k_d.astype(f32),
                               v.astype(f32), kk, a.astype(f32), reverse=(d == 1))
        y = y + y_d
        bonus = bonus + jnp.sum(r * k_d * r_k, axis=-1, keepdims=True)
        finals.append(s_fin)
    y = _layernorm(y, _heads(P['rwkv_ln_g'][i]), _heads(P['rwkv_ln_b'][i]), GN_EPS).astype(h.dtype)
    y = y + bonus * v
    out = (y.reshape(B, L, D) * g) @ P['rwkv_w_o'][i]
    return out, jnp.stack(finals, axis=1), v_first


def _trunk(x, cond, s_init, P):
    B = x.shape[0]
    ada_in = jax.nn.silu(cond)
    v_first = None
    finals = []
    for l in range(DEPTH):
        mod = (ada_in @ P['ada_w'][l] + P['ada_b'][l])[:, None, :]
        sh1, sc1, g1, sh2, sc2, g2 = jnp.split(mod, 6, axis=-1)
        h = _rmsnorm(x, P['norm1_g'][l]) * (1 + sc1) + sh1
        i = l // N_MIXERS
        if l % N_MIXERS == 0:
            m = _sgu_mixer(h, P['sgu_w_in'][i], P['sgu_ln_g'][i], P['sgu_ln_b'][i],
                           P['sgu_w_s'][i], P['sgu_b_s'][i], P['sgu_w_out'][i])
        else:
            if s_init is None:
                s0 = jnp.zeros((B, N_DIR, N_HEADS, HEAD_DIM, HEAD_DIM), jnp.float32)
            else:
                s0 = s_init[:, i]
            m, s_fin, v_first = _rwkv_mixer(h, s0, v_first, P, i)
            finals.append(s_fin)
        x = x + g1 * m
        h = _rmsnorm(x, P['norm2_g'][l]) * (1 + sc2) + sh2
        x = x + g2 * (jnp.square(jax.nn.relu(h @ P['mlp_w1'][l])) @ P['mlp_w2'][l])
    return _rmsnorm(x, P['final_g']), jnp.stack(finals, axis=1)


def setup_inputs(seed: int = 0) -> dict:
    key = jax.random.key(seed)
    ks = iter(jax.random.split(key, 48))

    def nrm(shape, scale):
        return jax.random.normal(next(ks), shape, jnp.float32) * scale

    def unif(shape, lo, hi):
        return jax.random.uniform(next(ks), shape, jnp.float32, lo, hi)

    D, H, N = D_MODEL, N_HEADS, HEAD_DIM
    NV = max(N_RWKV - 1, 0)
    return {
        'x_prompt': nrm((BATCH, SEQ, D), 1.0),
        'x_sample': nrm((DEC_BATCH, DEC_SEQ, D), 1.0),
        'state_wkv': nrm((DEC_BATCH, N_RWKV, N_DIR, H, N, N), 1.0),
        'c': nrm((DEC_BATCH, D), 1.0),
        'c_ctx': nrm((D,), 1.0),
        'norm1_g': 1.0 + nrm((DEPTH, D), 0.02),
        'norm2_g': 1.0 + nrm((DEPTH, D), 0.02),
        'ada_w': nrm((DEPTH, D, 6 * D), 0.5 * D ** -0.5),
        'ada_b': nrm((DEPTH, 6 * D), 0.02),
        'sgu_w_in': nrm((N_SGU, D, 2 * SGU_WIDTH), D ** -0.5),
        'sgu_ln_g': 1.0 + nrm((N_SGU, SGU_WIDTH), 0.02),
        'sgu_ln_b': nrm((N_SGU, SGU_WIDTH), 0.02),
        'sgu_w_s': nrm((N_SGU, SGU_GROUPS, CHUNK, CHUNK), CHUNK ** -0.5),
        'sgu_b_s': 1.0 + nrm((N_SGU, SGU_GROUPS, CHUNK), 0.02),
        'sgu_w_out': nrm((N_SGU, SGU_WIDTH, D), SGU_WIDTH ** -0.5),
        'rwkv_mu': unif((N_RWKV, 6, D), 0.0, 1.0),
        'rwkv_w_r': nrm((N_RWKV, D, D), D ** -0.5),
        'rwkv_w_k': nrm((N_RWKV, D, D), D ** -0.5),
        'rwkv_w_v': nrm((N_RWKV, D, D), D ** -0.5),
        'rwkv_w_o': nrm((N_RWKV, D, D), D ** -0.5),
        'rwkv_w0': unif((N_RWKV, N_DIR, D), -6.0, 1.0),
        'rwkv_w1': nrm((N_RWKV, N_DIR, D, LORA_W), D ** -0.5),
        'rwkv_w2': nrm((N_RWKV, N_DIR, LORA_W, D), 0.1 * LORA_W ** -0.5),
        'rwkv_a0': nrm((N_RWKV, N_DIR, D), 0.1),
        'rwkv_a1': nrm((N_RWKV, N_DIR, D, LORA_A), D ** -0.5),
        'rwkv_a2': nrm((N_RWKV, N_DIR, LORA_A, D), 0.5 * LORA_A ** -0.5),
        'rwkv_v0': nrm((NV, D), 0.1),
        'rwkv_v1': nrm((NV, D, LORA_V), D ** -0.5),
        'rwkv_v2': nrm((NV, LORA_V, D), 0.5 * LORA_V ** -0.5),
        'rwkv_g1': nrm((N_RWKV, D, LORA_G), D ** -0.5),
        'rwkv_g2': nrm((N_RWKV, LORA_G, D), LORA_G ** -0.5),
        'rwkv_k_k': 0.85 + nrm((N_RWKV, D), 0.02),
        'rwkv_k_a': 1.0 + nrm((N_RWKV, D), 0.02),
        'rwkv_r_k': nrm((N_RWKV, H, N), 0.1),
        'rwkv_ln_g': 1.0 + nrm((N_RWKV, D), 0.02),
        'rwkv_ln_b': nrm((N_RWKV, D), 0.02),
        'mlp_w1': nrm((DEPTH, D, D_FF), D ** -0.5),
        'mlp_w2': nrm((DEPTH, D_FF, D), D_FF ** -0.5),
        'final_g': 1.0 + nrm((D,), 0.02),
    }


def reference(x_prompt, x_sample, state_wkv, c, c_ctx, norm1_g, norm2_g, ada_w, ada_b,
              sgu_w_in, sgu_ln_g, sgu_ln_b, sgu_w_s, sgu_b_s, sgu_w_out,
              rwkv_mu, rwkv_w_r, rwkv_w_k, rwkv_w_v, rwkv_w_o, rwkv_w0, rwkv_w1, rwkv_w2,
              rwkv_a0, rwkv_a1, rwkv_a2, rwkv_v0, rwkv_v1, rwkv_v2, rwkv_g1, rwkv_g2,
              rwkv_k_k, rwkv_k_a, rwkv_r_k, rwkv_ln_g, rwkv_ln_b, mlp_w1, mlp_w2, final_g):
    P = dict(norm1_g=norm1_g, norm2_g=norm2_g, ada_w=ada_w, ada_b=ada_b,
             sgu_w_in=sgu_w_in, sgu_ln_g=sgu_ln_g, sgu_ln_b=sgu_ln_b, sgu_w_s=sgu_w_s,
             sgu_b_s=sgu_b_s, sgu_w_out=sgu_w_out,
             rwkv_mu=rwkv_mu, rwkv_w_r=rwkv_w_r, rwkv_w_k=rwkv_w_k, rwkv_w_v=rwkv_w_v,
             rwkv_w_o=rwkv_w_o, rwkv_w0=rwkv_w0, rwkv_w1=rwkv_w1, rwkv_w2=rwkv_w2,
             rwkv_a0=rwkv_a0, rwkv_a1=rwkv_a1, rwkv_a2=rwkv_a2, rwkv_v0=rwkv_v0,
             rwkv_v1=rwkv_v1, rwkv_v2=rwkv_v2, rwkv_g1=rwkv_g1, rwkv_g2=rwkv_g2,
             rwkv_k_k=rwkv_k_k, rwkv_k_a=rwkv_k_a, rwkv_r_k=rwkv_r_k,
             rwkv_ln_g=rwkv_ln_g, rwkv_ln_b=rwkv_ln_b,
             mlp_w1=mlp_w1, mlp_w2=mlp_w2, final_g=final_g)
    y_prompt, new_state_wkv = _trunk(x_prompt, c_ctx[None, :], None, P)
    y_sample, _ = _trunk(x_sample, c, state_wkv, P)
    return (y_prompt, y_sample, new_state_wkv)
```

```cpp
#include <hip/hip_runtime.h>
#include <hip/hip_cooperative_groups.h>
#include <cstdio>
namespace cg = cooperative_groups;

#define LAS __attribute__((address_space(3)))
typedef unsigned short bf16_t;
typedef short bf16x8 __attribute__((ext_vector_type(8)));
typedef float f32x4 __attribute__((ext_vector_type(4)));
typedef float f32x2 __attribute__((ext_vector_type(2)));
typedef unsigned u32x4 __attribute__((ext_vector_type(4)));
typedef unsigned u32x2 __attribute__((ext_vector_type(2)));

#ifndef OPMASK
#define OPMASK 0xFFFFFFFFu
#endif
#define OPEN(b) ((OPMASK >> (b)) & 1u)
#ifndef MULTI_LAUNCH
#define MULTI_LAUNCH 0
#endif

constexpr int T = 20480, TC = 4096, D = 1024, DFF = 4096;
constexpr int NTHREADS = 512;
constexpr int LDS_BYTES = 131072;
constexpr size_t MiB = 1u << 20;
constexpr size_t W_MLP1T = 0, W_MLP2T = 8 * MiB, W_INT = 16 * MiB, W_OUTT = 20 * MiB, W_S = 22 * MiB;
constexpr size_t W_RT = 16 * MiB, W_KT = 18 * MiB, W_VT = 20 * MiB, W_OT = 22 * MiB;
constexpr size_t W_LD = 24 * MiB;
constexpr size_t W_W2T = 25 * MiB;
constexpr size_t W_A2T = 25 * MiB + 256 * 1024;
constexpr size_t W_V2T = 25 * MiB + 512 * 1024;
constexpr size_t W_G2T = 25 * MiB + 640 * 1024;
constexpr size_t WS_MOD = 32 * MiB;
constexpr size_t WS_VST = 53 * MiB;
constexpr size_t WS_BON = 34 * MiB;
constexpr size_t WS_TW = 36 * MiB, WS_A1O = 41 * MiB, WS_SG = 46 * MiB, WS_V1O = 51 * MiB;
constexpr size_t WS_BIG = 56 * MiB, BIGSZ = 40 * MiB;
#define BIG(i) (WS_BIG + (size_t)(i) * BIGSZ)

enum { I_XP = 0, I_XS, I_STATE, I_C, I_CCTX, I_N1G, I_N2G, I_ADAW, I_ADAB, I_SWIN, I_SLNG, I_SLNB, I_SWS, I_SBS, I_SWOUT,
       I_MU, I_WR, I_WK, I_WV, I_WO, I_W0, I_W1, I_W2, I_A0, I_A1, I_A2, I_V0, I_V1, I_V2, I_G1, I_G2, I_KK, I_KA, I_RK, I_LNG, I_LNB,
       I_M1, I_M2, I_FG, N_IN };

struct Params { const float* in[N_IN]; float* out; unsigned char* ws; int ph_lo, ph_hi; };
typedef const __attribute__((address_space(4))) Params* KP;
__device__ __forceinline__ KP kparams() { KP k = (KP)__builtin_amdgcn_kernarg_segment_ptr(); asm volatile("" : "+s"(k)); return k; }

__device__ __forceinline__ int TIDX() { int t = threadIdx.x; asm volatile("" : "+v"(t)); return t; }
__device__ __forceinline__ int BIDX() { int t = blockIdx.x; asm volatile("" : "+s"(t)); return t; }
__device__ __forceinline__ int GDIM() { int t = gridDim.x; asm volatile("" : "+s"(t)); return t; }
__device__ __forceinline__ unsigned cvt_pk_bf16(float lo, float hi) { unsigned r; asm volatile("v_cvt_pk_bf16_f32 %0, %1, %2" : "=v"(r) : "v"(lo), "v"(hi)); return r; }
__device__ __forceinline__ bf16_t f2bf(float f) { unsigned u = __float_as_uint(f); u += 0x7FFFu + ((u >> 16) & 1u); return (bf16_t)(u >> 16); }
__device__ __forceinline__ float bf2f(unsigned b) { return __uint_as_float(b << 16); }
__device__ __forceinline__ float bflo(unsigned w) { return __uint_as_float(w << 16); }
__device__ __forceinline__ float bfhi(unsigned w) { return __uint_as_float(w & 0xFFFF0000u); }
__device__ __forceinline__ float sigmoidf_(float x) { return 1.0f / (1.0f + __expf(-x)); }
__device__ __forceinline__ float tanhf_(float x) { float e = __expf(-2.0f * fabsf(x)); float t = (1.0f - e) / (1.0f + e); return x < 0.f ? -t : t; }
__device__ __forceinline__ float gelu_tanh(float x) { float u = 1.5957691216f * (x + 0.044715f * x * x * x); return x / (1.0f + __expf(-u)); }
__device__ __forceinline__ float wave_sum(float v) {
#pragma unroll
    for (int o = 32; o >= 1; o >>= 1) v += __shfl_xor(v, o);
    return v;
}
template <int CTRL> __device__ __forceinline__ float dpp_f(float x) { return __int_as_float(__builtin_amdgcn_update_dpp(0, __float_as_int(x), CTRL, 0xF, 0xF, true)); }
__device__ __forceinline__ float red8(float x) { x += dpp_f<0xB1>(x); x += dpp_f<0x4E>(x); x += dpp_f<0x141>(x); return x; }
__device__ __forceinline__ float red16(float x) { x = red8(x); x += dpp_f<0x140>(x); return x; }
__device__ __forceinline__ int cond_row(int t) { return t < TC ? 0 : 1 + ((t - TC) >> 11); }
__device__ __forceinline__ const float* xrow_ptr(KP p, bool from_input, int row) {
    if (from_input) return row < TC ? p->in[I_XP] + (size_t)row * D : p->in[I_XS] + (size_t)(row - TC) * D;
    return p->out + (size_t)row * D;
}

namespace pg8 {
constexpr int BM = 256, BK = 64, HALF = 128, HTB = HALF * BK * 2, STAGE_BYTES = 8 * HTB, NXCD = 8, WGM = 8;
__device__ __forceinline__ int lds_byte(int r, int c) { const int st = (r >> 4) * 2 + (c >> 5), rr = r & 15, cc = c & 31, ob = rr * 64 + cc * 2; return st * 1024 + (ob ^ (((ob >> 9) & 1) << 5)); }
__device__ __forceinline__ void stage_rc(int b, int& R, int& C) { const int st = b / 1024, sb = b % 1024, swz = sb ^ (((sb >> 9) & 1) << 5); R = (st >> 1) * 16 + swz / 64; C = (st & 1) * 32 + (swz % 64) / 2; }
__device__ __forceinline__ int perm32(int rho) { const int n = rho >> 4, i = rho & 15; return 8 * (i >> 2) + 4 * n + (i & 3); }
struct Unit { int pm, pn, gi; };
struct Sched {
    const char* A; size_t strideA; const char* Bt; size_t strideB; int tpg, K;
    int nM, nN, nwg, G, c;
    __device__ void init(const void* A_, size_t sA, const void* Bt_, size_t sB, int tpg_, int K_, int M, int Nv, int G_, int c_) {
        A = (const char*)A_; strideA = sA; Bt = (const char*)Bt_; strideB = sB; tpg = tpg_; K = K_; nM = M / BM; nN = Nv / BM; nwg = nM * nN; G = G_; c = c_; }
    __device__ bool next(int i, Unit& u) const {
        const long L = (long)i * G + c; if (L >= nwg) return false;
        int wgid = (int)L; { const int q = nwg / NXCD, r = nwg % NXCD, xcd = wgid % NXCD, off = wgid / NXCD; wgid = (xcd < r ? xcd * (q + 1) : r * (q + 1) + (xcd - r) * q) + off; }
        const int nig = WGM * nN, gid = wgid / nig, fm = gid * WGM, gsz = (nM - fm) < WGM ? (nM - fm) : WGM;
        u.pm = fm + ((wgid % nig) % gsz); const int pv = (wgid % nig) / gsz; u.gi = pv / tpg; u.pn = pv - u.gi * tpg; return true;
    }
};

template <class Epi>
__device__ __forceinline__ void gemm_phase(LAS unsigned char* lds, const Sched& S, const Epi& E) {
    const int tid = TIDX(), wid = __builtin_amdgcn_readfirstlane(tid >> 6), lane = tid & 63, wr = wid >> 2, wc = wid & 3, fr = lane & 15, fq = lane >> 4;
    const int K = S.K, nt = K / BK;
    unsigned voffA[2], voffB[2];
#pragma unroll
    for (int i = 0; i < 2; ++i) { int R, C; stage_rc(tid * 16 + i * 8192, R, C); const int Rb = Epi::PERM ? ((R & ~31) + perm32(R & 31)) : R;
        voffA[i] = (unsigned)(R * K + C) * 2u; voffB[i] = (unsigned)(Rb * K + C) * 2u; }
    const size_t kstep = (size_t)(BK * 2);
    const size_t hstep = (size_t)HALF * K * 2;
    const size_t tstep = 2 * hstep;
    const unsigned ldsw = (unsigned)wid * 1024u;
    const int aoff = lds_byte(wr * 64 + fr, fq * 8), boff = lds_byte(wc * 32 + fr, fq * 8);
#define PG8_SA(b, h) (((b) * 2 + (h)) * HTB)
#define PG8_SB(b, h) ((4 + (b) * 2 + (h)) * HTB)
#define PG8_STAGE(bufoff, gbase, voff) do { _Pragma("unroll") for (int _i = 0; _i < 2; ++_i) \
        __builtin_amdgcn_global_load_lds((const unsigned*)((const char*)(gbase) + (voff)[_i]), (LAS unsigned*)(lds + (bufoff) + ldsw + _i * 8192), 16, 0, 0); } while (0)
#define PG8_LDA(dst, b, h) do { _Pragma("unroll") for (int m = 0; m < 4; ++m) _Pragma("unroll") for (int k = 0; k < 2; ++k) dst[m][k] = *(const LAS bf16x8*)(lds + PG8_SA(b, h) + aoff + m * 2048 + k * 1024); } while (0)
#define PG8_LDB(dst, b, h) do { _Pragma("unroll") for (int n = 0; n < 2; ++n) _Pragma("unroll") for (int k = 0; k < 2; ++k) dst[n][k] = *(const LAS bf16x8*)(lds + PG8_SB(b, h) + boff + n * 2048 + k * 1024); } while (0)
#define PG8_MMA(ai, bj, At, Bt) do { __builtin_amdgcn_s_setprio(1); _Pragma("unroll") for (int m = 0; m < 4; ++m) _Pragma("unroll") for (int n = 0; n < 2; ++n) _Pragma("unroll") for (int k = 0; k < 2; ++k) \
        acc[ai][bj][m][n] = __builtin_amdgcn_mfma_f32_16x16x32_bf16(Bt[n][k], At[m][k], acc[ai][bj][m][n], 0, 0, 0); __builtin_amdgcn_s_setprio(0); } while (0)
#define PG8_WAIT_V(n) asm volatile("s_waitcnt vmcnt(" #n ")" ::: "memory")
#define PG8_WAIT_L(n) asm volatile("s_waitcnt lgkmcnt(" #n ")" ::: "memory")
#define PG8_BAR __builtin_amdgcn_s_barrier()
#define PG8_SCHED __builtin_amdgcn_sched_barrier(0)
    Unit cur, nxt; int ui = 0;
    if (!S.next(0, cur)) return;
    f32x4 acc[2][2][4][2];
#pragma unroll
    for (int a = 0; a < 2; ++a)
#pragma unroll
        for (int b = 0; b < 2; ++b)
#pragma unroll
            for (int m = 0; m < 4; ++m)
#pragma unroll
                for (int n = 0; n < 2; ++n) acc[a][b][m][n] = (f32x4){0.f, 0.f, 0.f, 0.f};
    bf16x8 At[4][2], B0[2][2], B1[2][2];
    const char* cA = S.A + (size_t)cur.gi * S.strideA + (size_t)cur.pm * tstep; const char* cB = S.Bt + (size_t)cur.gi * S.strideB + (size_t)cur.pn * tstep;
    PG8_STAGE(PG8_SB(0, 0), cB, voffB); PG8_STAGE(PG8_SA(0, 0), cA, voffA); PG8_STAGE(PG8_SB(0, 1), cB + hstep, voffB); PG8_STAGE(PG8_SA(0, 1), cA + hstep, voffA);
    if (wr == 1) PG8_BAR;
    PG8_WAIT_V(4); PG8_BAR;
    PG8_STAGE(PG8_SB(1, 0), cB + kstep, voffB); PG8_STAGE(PG8_SA(1, 0), cA + kstep, voffA); PG8_STAGE(PG8_SB(1, 1), cB + hstep + kstep, voffB);
    PG8_WAIT_V(6); PG8_BAR;
    for (;;) {
        const bool has_next = S.next(ui + 1, nxt);
        const char* nA = has_next ? S.A + (size_t)nxt.gi * S.strideA + (size_t)nxt.pm * tstep : cA; const char* nB = has_next ? S.Bt + (size_t)nxt.gi * S.strideB + (size_t)nxt.pn * tstep : cB;
        for (int t = 0; t < nt; t += 2) {
            const bool last = (t == nt - 2);
            const char* a1 = cA + (size_t)(t + 1) * kstep;
            const char* a2 = last ? nA : cA + (size_t)(t + 2) * kstep; const char* b2 = last ? nB : cB + (size_t)(t + 2) * kstep;
            const char* a3 = a2 + kstep; const char* b3 = b2 + kstep;
            PG8_LDB(B0, 0, 0); PG8_SCHED; PG8_LDA(At, 0, 0); PG8_STAGE(PG8_SA(1, 1), a1 + hstep, voffA);
            PG8_WAIT_L(8); PG8_BAR; PG8_WAIT_L(0); PG8_MMA(0, 0, At, B0); PG8_BAR; PG8_SCHED;
            PG8_LDB(B1, 0, 1); PG8_STAGE(PG8_SB(0, 0), b2, voffB);
            PG8_BAR; PG8_WAIT_L(0); PG8_MMA(0, 1, At, B1); PG8_BAR;
            PG8_LDA(At, 0, 1); PG8_STAGE(PG8_SA(0, 0), a2, voffA);
            PG8_BAR; PG8_WAIT_L(0); PG8_MMA(1, 0, At, B0); PG8_BAR; PG8_SCHED;
            PG8_STAGE(PG8_SB(0, 1), b2 + hstep, voffB);
            PG8_WAIT_V(6); PG8_BAR; PG8_MMA(1, 1, At, B1); PG8_BAR;
            PG8_LDB(B0, 1, 0); PG8_SCHED; PG8_LDA(At, 1, 0); PG8_STAGE(PG8_SA(0, 1), a2 + hstep, voffA);
            PG8_WAIT_L(8); PG8_BAR; PG8_WAIT_L(0); PG8_MMA(0, 0, At, B0); PG8_BAR; PG8_SCHED;
            PG8_LDB(B1, 1, 1); PG8_STAGE(PG8_SB(1, 0), b3, voffB);
            PG8_BAR; PG8_WAIT_L(0); PG8_MMA(0, 1, At, B1); PG8_BAR;
            PG8_LDA(At, 1, 1); PG8_STAGE(PG8_SA(1, 0), a3, voffA);
            PG8_BAR; PG8_WAIT_L(0); PG8_MMA(1, 0, At, B0); PG8_BAR; PG8_SCHED;
            PG8_STAGE(PG8_SB(1, 1), b3 + hstep, voffB);
            PG8_WAIT_V(6); PG8_BAR; PG8_MMA(1, 1, At, B1); PG8_BAR;
        }
        E(acc, cur, wr, wc, fr, fq);
        if (!has_next) break;
#pragma unroll
        for (int a = 0; a < 2; ++a)
#pragma unroll
            for (int b = 0; b < 2; ++b)
#pragma unroll
                for (int m = 0; m < 4; ++m)
#pragma unroll
                    for (int n = 0; n < 2; ++n) acc[a][b][m][n] = (f32x4){0.f, 0.f, 0.f, 0.f};
        cur = nxt; cA = nA; cB = nB; ++ui;
    }
    PG8_WAIT_V(0);
    if (wr == 0) PG8_BAR;
    PG8_BAR;
#undef PG8_SA
#undef PG8_SB
#undef PG8_STAGE
#undef PG8_LDA
#undef PG8_LDB
#undef PG8_MMA
#undef PG8_WAIT_V
#undef PG8_WAIT_L
#undef PG8_BAR
#undef PG8_SCHED
}
}

typedef f32x4 Acc[2][2][4][2];

struct EpiRes {
    static constexpr bool PERM = false;
    const float* src_lo; const float* src_hi; float* dst; const float* modl; int goff;
    __device__ __forceinline__ void operator()(const Acc& acc, const pg8::Unit& u, int wr, int wc, int fr, int fq) const {
        const int row0 = u.pm * 256 + wr * 64 + fr, col0 = u.pn * 256 + wc * 32 + 4 * fq;
        const int crow = u.pm < 16 ? 0 : 1 + ((u.pm - 16) >> 3);
        const float* gp = modl + crow * 6144 + goff + col0;
        f32x4 gv[2][2];
#pragma unroll
        for (int bj = 0; bj < 2; ++bj)
#pragma unroll
            for (int n = 0; n < 2; ++n) gv[bj][n] = *(const f32x4*)(gp + bj * 128 + n * 16);
        const float* sb = (u.pm < 16 ? src_lo : src_hi);
#pragma unroll
        for (int ai = 0; ai < 2; ++ai)
#pragma unroll
            for (int m = 0; m < 4; ++m) {
                const size_t ro = (size_t)(row0 + ai * 128 + m * 16) * D + col0;
#pragma unroll
                for (int bj = 0; bj < 2; ++bj)
#pragma unroll
                    for (int n = 0; n < 2; ++n) {
                        const f32x4 xv = *(const f32x4*)(sb + ro + bj * 128 + n * 16);
                        *(f32x4*)(dst + ro + bj * 128 + n * 16) = xv + gv[bj][n] * acc[ai][bj][m][n];
                    }
            }
    }
};
template <int ACT> struct EpiBf16 {
    static constexpr bool PERM = true;
    bf16_t* o0; bf16_t* o1; bf16_t* o2; int ldc;
    __device__ __forceinline__ void operator()(const Acc& acc, const pg8::Unit& u, int wr, int wc, int fr, int fq) const {
        const int row0 = u.pm * 256 + wr * 64 + fr, col0 = u.pn * 256 + wc * 32 + 8 * fq;
        bf16_t* base = u.gi == 0 ? o0 : (u.gi == 1 ? o1 : o2);
#pragma unroll
        for (int ai = 0; ai < 2; ++ai)
#pragma unroll
            for (int m = 0; m < 4; ++m) {
                bf16_t* rowp = base + (size_t)(row0 + ai * 128 + m * 16) * ldc + col0;
#pragma unroll
                for (int bj = 0; bj < 2; ++bj) {
                    f32x4 v0 = acc[ai][bj][m][0], v1 = acc[ai][bj][m][1];
                    if (ACT == 1) {
#pragma unroll
                        for (int j = 0; j < 4; ++j) { float a = fmaxf(v0[j], 0.f), b = fmaxf(v1[j], 0.f); v0[j] = a * a; v1[j] = b * b; }
                    }
                    u32x4 w; w.x = cvt_pk_bf16(v0[0], v0[1]); w.y = cvt_pk_bf16(v0[2], v0[3]); w.z = cvt_pk_bf16(v1[0], v1[1]); w.w = cvt_pk_bf16(v1[2], v1[3]);
                    *(u32x4*)(rowp + bj * 128) = w;
                }
            }
    }
};
struct EpiGeluUV {
    static constexpr bool PERM = true;
    bf16_t* U; bf16_t* V; float* vst;
    __device__ __forceinline__ void operator()(const Acc& acc, const pg8::Unit& u, int wr, int wc, int fr, int fq) const {
        const int row0 = u.pm * 256 + wr * 64 + fr;
        const bool isv = u.pn >= 4;
        const int col0 = (u.pn & 3) * 256 + wc * 32 + 8 * fq;
        bf16_t* base = isv ? V : U;
#pragma unroll
        for (int ai = 0; ai < 2; ++ai)
#pragma unroll
            for (int m = 0; m < 4; ++m) {
                const int row = row0 + ai * 128 + m * 16;
                bf16_t* rowp = base + (size_t)row * D + col0;
                float s1 = 0.f, s2 = 0.f;
#pragma unroll
                for (int bj = 0; bj < 2; ++bj) {
                    f32x4 v0 = acc[ai][bj][m][0], v1 = acc[ai][bj][m][1];
#pragma unroll
                    for (int j = 0; j < 4; ++j) { v0[j] = gelu_tanh(v0[j]); v1[j] = gelu_tanh(v1[j]); s1 += v0[j] + v1[j]; s2 += v0[j] * v0[j] + v1[j] * v1[j]; }
                    u32x4 w; w.x = cvt_pk_bf16(v0[0], v0[1]); w.y = cvt_pk_bf16(v0[2], v0[3]); w.z = cvt_pk_bf16(v1[0], v1[1]); w.w = cvt_pk_bf16(v1[2], v1[3]);
                    *(u32x4*)(rowp + bj * 128) = w;
                }
                if (isv) {
                    s1 += __shfl_xor(s1, 16); s1 += __shfl_xor(s1, 32);
                    s2 += __shfl_xor(s2, 16); s2 += __shfl_xor(s2, 32);
                    if (fq == 0) *(f32x2*)(vst + ((size_t)row * 16 + (u.pn - 4) * 4 + wc) * 2) = (f32x2){s1, s2};
                }
            }
    }
};

__device__ void wconv_tiled(const float* __restrict__ src, int K, int N, bf16_t* dst, int ldd, LAS float* tile, int bid, int G) {
    const int tid = TIDX(); const int tn = N / 64, ntiles = (K / 64) * tn;
    for (int t = bid; t < ntiles; t += G) {
        const int k0 = (t / tn) * 64, n0 = (t % tn) * 64;
#pragma unroll
        for (int i = 0; i < 8; ++i) { const int idx = tid + 512 * i, kk = idx >> 6, nn = idx & 63; tile[kk * 65 + nn] = src[(size_t)(k0 + kk) * N + n0 + nn]; }
        __syncthreads();
        { const int n = tid >> 3, kc = tid & 7; float v[8];
#pragma unroll
          for (int j = 0; j < 8; ++j) v[j] = tile[(kc * 8 + j) * 65 + n];
          u32x4 w; w.x = cvt_pk_bf16(v[0], v[1]); w.y = cvt_pk_bf16(v[2], v[3]); w.z = cvt_pk_bf16(v[4], v[5]); w.w = cvt_pk_bf16(v[6], v[7]);
          *(u32x4*)(dst + (size_t)(n0 + n) * ldd + k0 + kc * 8) = w; }
        __syncthreads();
    }
}
__device__ void wconv_direct(const float* __restrict__ src, int K, int N, bf16_t* dst) {
    const int gsz = GDIM() * NTHREADS;
    for (int e = BIDX() * NTHREADS + TIDX(); e < K * N; e += gsz) { const int n = e / K, k = e - n * K; dst[e] = f2bf(src[(size_t)k * N + n]); }
}
__device__ void wconv_mlp(KP p, int l, LAS float* tile) {
    const int G = GDIM(), b = BIDX();
    wconv_tiled(p->in[I_M1] + (size_t)l * D * DFF, D, DFF, (bf16_t*)(p->ws + W_MLP1T), D, tile, b, G);
    wconv_tiled(p->in[I_M2] + (size_t)l * D * DFF, DFF, D, (bf16_t*)(p->ws + W_MLP2T), DFF, tile, b, G);
}
__device__ void wconv_sgu(KP p, int l, LAS float* tile) {
    const int i = l >> 1, G = GDIM(), b = BIDX();
    wconv_tiled(p->in[I_SWIN] + (size_t)i * D * 2048, D, 2048, (bf16_t*)(p->ws + W_INT), D, tile, b, G);
    wconv_tiled(p->in[I_SWOUT] + (size_t)i * D * D, D, D, (bf16_t*)(p->ws + W_OUTT), D, tile, (b + 64) % G, G);
    { const float* s = p->in[I_SWS] + (size_t)i * 16 * 128 * 128; bf16_t* d = (bf16_t*)(p->ws + W_S);
      for (int e = BIDX() * NTHREADS + TIDX(); e < 16 * 128 * 128; e += G * NTHREADS) d[e] = f2bf(s[e]); }
    wconv_mlp(p, l, tile);
}
__device__ void wconv_rwkv_main(KP p, int l, LAS float* tile) {
    const int il = l >> 1, G = GDIM(), b = BIDX();
    wconv_tiled(p->in[I_WR] + (size_t)il * D * D, D, D, (bf16_t*)(p->ws + W_RT), D, tile, b, G);
    wconv_tiled(p->in[I_WK] + (size_t)il * D * D, D, D, (bf16_t*)(p->ws + W_KT), D, tile, b, G);
    wconv_tiled(p->in[I_WV] + (size_t)il * D * D, D, D, (bf16_t*)(p->ws + W_VT), D, tile, b, G);
    wconv_tiled(p->in[I_WO] + (size_t)il * D * D, D, D, (bf16_t*)(p->ws + W_OT), D, tile, b, G);
    for (int d = 0; d < 2; ++d) {
        wconv_direct(p->in[I_W2] + (size_t)(il * 2 + d) * 64 * D, 64, D, (bf16_t*)(p->ws + W_W2T) + (size_t)d * D * 64);
        wconv_direct(p->in[I_A2] + (size_t)(il * 2 + d) * 64 * D, 64, D, (bf16_t*)(p->ws + W_A2T) + (size_t)d * D * 64);
    }
    if (il == 1) wconv_direct(p->in[I_V2], 32, D, (bf16_t*)(p->ws + W_V2T));
    wconv_direct(p->in[I_G2] + (size_t)il * 128 * D, 128, D, (bf16_t*)(p->ws + W_G2T));
    wconv_mlp(p, l, tile);
}
__device__ void wconv_rwkv_lora_down(KP p, int l, LAS float* tile) {
    const int il = l >> 1, G = GDIM(), b = BIDX();
    bf16_t* ld = (bf16_t*)(p->ws + W_LD);
    for (int d = 0; d < 2; ++d) {
        wconv_tiled(p->in[I_W1] + (size_t)(il * 2 + d) * D * 64, D, 64, ld + (size_t)(d * 64) * D, D, tile, (b + d * 16) % G, G);
        wconv_tiled(p->in[I_A1] + (size_t)(il * 2 + d) * D * 64, D, 64, ld + (size_t)(128 + d * 64) * D, D, tile, (b + 32 + d * 16) % G, G);
    }
    wconv_tiled(p->in[I_G1] + (size_t)il * D * 128, D, 128, ld + (size_t)256 * D, D, tile, (b + 64) % G, G);
    if (il == 1) wconv_direct(p->in[I_V1], D, 32, ld + (size_t)384 * D);
}

__device__ void ada_phase(KP p, LAS unsigned char* lds) {
    LAS float* sc = (LAS float*)lds;
    LAS float* red = sc + 9 * 1024;
    const int tid = TIDX(), G = GDIM();
    float* mod = (float*)(p->ws + WS_MOD);
    if ((int)BIDX() < 192) {
        for (int e = tid; e < 9 * 1024; e += NTHREADS) { const int r = e >> 10, k = e & 1023; const float x = r == 0 ? p->in[I_CCTX][k] : p->in[I_C][(r - 1) * 1024 + k]; sc[e] = x / (1.0f + __expf(-x)); }
        __syncthreads();
    }
    for (int item = BIDX(); item < 192; item += G) {
        const int l = item / 48, c0 = (item % 48) * 128, col4 = tid & 31, kq = tid >> 5;
        const float* wp = p->in[I_ADAW] + ((size_t)l * 1024 + kq * 64) * 6144 + c0 + col4 * 4;
        f32x4 acc[9];
#pragma unroll
        for (int r = 0; r < 9; ++r) acc[r] = (f32x4){0.f, 0.f, 0.f, 0.f};
#pragma unroll 4
        for (int kk = 0; kk < 64; ++kk) {
            const f32x4 w = *(const f32x4*)(wp + (size_t)kk * 6144);
#pragma unroll
            for (int r = 0; r < 9; ++r) acc[r] += sc[r * 1024 + kq * 64 + kk] * w;
        }
#pragma unroll
        for (int r = 0; r < 9; ++r) *(LAS f32x4*)(red + ((kq * 9 + r) * 128 + col4 * 4)) = acc[r];
        __syncthreads();
        for (int o = tid; o < 9 * 128; o += NTHREADS) {
            const int r = o >> 7, cc = o & 127; float s = p->in[I_ADAB][l * 6144 + c0 + cc];
#pragma unroll
            for (int q = 0; q < 16; ++q) s += red[(q * 9 + r) * 128 + cc];
            mod[(size_t)(l * 9 + r) * 6144 + c0 + cc] = s;
        }
        __syncthreads();
    }
}

__device__ void norm_phase(KP p, int l, int which, bool from_input, bf16_t* H) {
    const int lane = TIDX() & 63, gw = BIDX() * 8 + (TIDX() >> 6), nw = GDIM() * 8;
    const float* g = p->in[which ? I_N2G : I_N1G] + l * D;
    const float* mod = (const float*)(p->ws + WS_MOD);
    for (int row = gw; row < T; row += nw) {
        const float* xp = xrow_ptr(p, from_input, row);
        const float* md = mod + (size_t)(l * 9 + cond_row(row)) * 6144 + (which ? 3072 : 0);
        f32x4 v[4]; float ss = 0.f;
#pragma unroll
        for (int i = 0; i < 4; ++i) { v[i] = *(const f32x4*)(xp + i * 256 + lane * 4); ss += v[i][0] * v[i][0] + v[i][1] * v[i][1] + v[i][2] * v[i][2] + v[i][3] * v[i][3]; }
        ss = wave_sum(ss);
        const float rstd = rsqrtf(ss * (1.0f / 1024.0f) + 1e-6f);
#pragma unroll
        for (int i = 0; i < 4; ++i) {
            const int c = i * 256 + lane * 4;
            const f32x4 gg = *(const f32x4*)(g + c), sh = *(const f32x4*)(md + c), sc = *(const f32x4*)(md + 1024 + c);
            const f32x4 o = v[i] * rstd * gg * (1.0f + sc) + sh;
            u32x2 w; w.x = cvt_pk_bf16(o[0], o[1]); w.y = cvt_pk_bf16(o[2], o[3]);
            *(u32x2*)(H + (size_t)row * D + c) = w;
        }
    }
}
__device__ void final_norm_phase(KP p) {
    const int lane = TIDX() & 63, gw = BIDX() * 8 + (TIDX() >> 6), nw = GDIM() * 8;
    const float* g = p->in[I_FG];
    for (int row = gw; row < T; row += nw) {
        float* xp = p->out + (size_t)row * D;
        f32x4 v[4]; float ss = 0.f;
#pragma unroll
        for (int i = 0; i < 4; ++i) { v[i] = *(const f32x4*)(xp + i * 256 + lane * 4); ss += v[i][0] * v[i][0] + v[i][1] * v[i][1] + v[i][2] * v[i][2] + v[i][3] * v[i][3]; }
        ss = wave_sum(ss);
        const float rstd = rsqrtf(ss * (1.0f / 1024.0f) + 1e-6f);
#pragma unroll
        for (int i = 0; i < 4; ++i) { const int c = i * 256 + lane * 4; *(f32x4*)(xp + c) = v[i] * rstd * *(const f32x4*)(g + c); }
    }
}

constexpr int HBS = 1028;
__device__ void rmix_phase(KP p, int l, LAS unsigned char* lds) {
    const int il = l >> 1;
    LAS float* hb = (LAS float*)lds;
    const int tid = TIDX(), lane = tid & 63, wave = tid >> 6, G = GDIM();
    const float* g = p->in[I_N1G] + l * D;
    const float* mu = p->in[I_MU] + (size_t)il * 6 * D;
    const float* mod = (const float*)(p->ws + WS_MOD);
    bf16_t* XR = (bf16_t*)(p->ws + BIG(1)); bf16_t* XK = (bf16_t*)(p->ws + BIG(2)); bf16_t* XV = (bf16_t*)(p->ws + BIG(3));
    const bf16_t* LD = (const bf16_t*)(p->ws + W_LD);
    for (int tile = BIDX(); tile < T / 16; tile += G) {
        const int t0 = tile * 16;
        const int s0 = t0 < TC ? (t0 & ~255) : TC + ((t0 - TC) & ~2047), L = t0 < TC ? 256 : 2048;
        const float* md = mod + (size_t)(l * 9 + cond_row(t0)) * 6144;
        for (int r = wave; r < 18; r += 8) {
            const int t = t0 - 1 + r;
            if (t >= s0 && t < s0 + L) {
                const float* xp = p->out + (size_t)t * D;
                f32x4 v[4]; float ss = 0.f;
#pragma unroll
                for (int i = 0; i < 4; ++i) { v[i] = *(const f32x4*)(xp + i * 256 + lane * 4); ss += v[i][0] * v[i][0] + v[i][1] * v[i][1] + v[i][2] * v[i][2] + v[i][3] * v[i][3]; }
                ss = wave_sum(ss);
                const float rstd = rsqrtf(ss * (1.0f / 1024.0f) + 1e-6f);
#pragma unroll
                for (int i = 0; i < 4; ++i) {
                    const int c = i * 256 + lane * 4;
                    const f32x4 gg = *(const f32x4*)(g + c), sh = *(const f32x4*)(md + c), sc = *(const f32x4*)(md + 1024 + c);
                    *(LAS f32x4*)(hb + r * HBS + c) = v[i] * rstd * gg * (1.0f + sc) + sh;
                }
            } else {
#pragma unroll
                for (int i = 0; i < 4; ++i) *(LAS f32x4*)(hb + r * HBS + i * 256 + lane * 4) = (f32x4){0.f, 0.f, 0.f, 0.f};
            }
        }
        __syncthreads();
        {
            const int row = tid >> 5, q = tid & 31;
#pragma unroll
            for (int pc = 0; pc < 4; ++pc) {
                const int c = pc * 256 + q * 8;
                f32x4 hp[2], hc[2], hn[2], xx[2];
#pragma unroll
                for (int e = 0; e < 2; ++e) { hp[e] = *(const LAS f32x4*)(hb + row * HBS + c + 4 * e); hc[e] = *(const LAS f32x4*)(hb + (row + 1) * HBS + c + 4 * e); hn[e] = *(const LAS f32x4*)(hb + (row + 2) * HBS + c + 4 * e);
                    xx[e] = 0.5f * (hp[e] + hn[e]) - hc[e]; }
                const size_t off = (size_t)(t0 + row) * D + c;
#pragma unroll
                for (int jj = 0; jj < 3; ++jj) {
                    const int j = jj == 0 ? 0 : (jj == 1 ? 2 : 3);
                    const f32x4 m0 = *(const f32x4*)(mu + j * D + c), m1 = *(const f32x4*)(mu + j * D + c + 4);
                    const f32x4 o0 = hc[0] + xx[0] * m0, o1 = hc[1] + xx[1] * m1;
                    u32x4 w; w.x = cvt_pk_bf16(o0[0], o0[1]); w.y = cvt_pk_bf16(o0[2], o0[3]); w.z = cvt_pk_bf16(o1[0], o1[1]); w.w = cvt_pk_bf16(o1[2], o1[3]);
                    bf16_t* dst = jj == 0 ? XR : (jj == 1 ? XK : XV);
                    *(u32x4*)(dst + off) = w;
                }
            }
        }
        if (wave < 6 || (wave == 6 && il == 1)) {
            int jmu, nrow0, ntl, act, ldo, oc0; bf16_t* outp;
            if (wave < 2) { jmu = 1; nrow0 = wave * 64; ntl = 4; act = 1; outp = (bf16_t*)(p->ws + WS_TW); ldo = 128; oc0 = wave * 64; }
            else if (wave < 4) { jmu = 4; nrow0 = 128 + (wave - 2) * 64; ntl = 4; act = 0; outp = (bf16_t*)(p->ws + WS_A1O); ldo = 128; oc0 = (wave - 2) * 64; }
            else if (wave < 6) { jmu = 5; nrow0 = 256 + (wave - 4) * 64; ntl = 4; act = 2; outp = (bf16_t*)(p->ws + WS_SG); ldo = 128; oc0 = (wave - 4) * 64; }
            else { jmu = 3; nrow0 = 384; ntl = 2; act = 0; outp = (bf16_t*)(p->ws + WS_V1O); ldo = 32; oc0 = 0; }
            const int tok = lane & 15, kg = lane >> 4;
            f32x4 acc[4];
#pragma unroll
            for (int n = 0; n < 4; ++n) acc[n] = (f32x4){0.f, 0.f, 0.f, 0.f};
            const float* mup = mu + jmu * D;
            for (int ks = 0; ks < 32; ++ks) {
                const int k = ks * 32 + kg * 8;
                float xm[8];
#pragma unroll
                for (int e = 0; e < 2; ++e) {
                    const f32x4 hp = *(const LAS f32x4*)(hb + tok * HBS + k + 4 * e), hc = *(const LAS f32x4*)(hb + (tok + 1) * HBS + k + 4 * e), hn = *(const LAS f32x4*)(hb + (tok + 2) * HBS + k + 4 * e);
                    const f32x4 m = *(const f32x4*)(mup + k + 4 * e);
                    const f32x4 o = hc + (0.5f * (hp + hn) - hc) * m;
                    xm[4 * e] = o[0]; xm[4 * e + 1] = o[1]; xm[4 * e + 2] = o[2]; xm[4 * e + 3] = o[3];
                }
                u32x4 bw; bw.x = cvt_pk_bf16(xm[0], xm[1]); bw.y = cvt_pk_bf16(xm[2], xm[3]); bw.z = cvt_pk_bf16(xm[4], xm[5]); bw.w = cvt_pk_bf16(xm[6], xm[7]);
                const bf16x8 bfrag = __builtin_bit_cast(bf16x8, bw);
#pragma unroll
                for (int n = 0; n < 4; ++n) if (n < ntl) {
                    const bf16x8 afrag = *(const bf16x8*)(LD + (size_t)(nrow0 + n * 16 + tok) * D + k);
                    acc[n] = __builtin_amdgcn_mfma_f32_16x16x32_bf16(afrag, bfrag, acc[n], 0, 0, 0);
                }
            }
#pragma unroll
            for (int n = 0; n < 4; ++n) if (n < ntl) {
                f32x4 v = acc[n];
#pragma unroll
                for (int j = 0; j < 4; ++j) v[j] = act == 1 ? tanhf_(v[j]) : (act == 2 ? sigmoidf_(v[j]) : v[j]);
                u32x2 w; w.x = cvt_pk_bf16(v[0], v[1]); w.y = cvt_pk_bf16(v[2], v[3]);
                *(u32x2*)(outp + (size_t)(t0 + tok) * ldo + oc0 + n * 16 + kg * 4) = w;
            }
        }
        __syncthreads();
    }
}

__device__ void sgu_mix_phase(KP p, int l, LAS unsigned char* lds) {
    const int i = l >> 1;
    LAS bf16_t* vt = (LAS bf16_t*)lds;
    const int tid = TIDX(), lane = tid & 63, wave = tid >> 6, G = GDIM();
    const float* lng = p->in[I_SLNG] + i * D; const float* lnb = p->in[I_SLNB] + i * D; const float* bs = p->in[I_SBS] + i * 16 * 128;
    const float* vst = (const float*)(p->ws + WS_VST);
    const bf16_t* U = (const bf16_t*)(p->ws + BIG(2)); const bf16_t* V = (const bf16_t*)(p->ws + BIG(3)); bf16_t* UV = (bf16_t*)(p->ws + BIG(4));
    const bf16_t* WS = (const bf16_t*)(p->ws + W_S);
    for (int u = BIDX(); u < 2560; u += G) {
        const int ch = u >> 4, g = u & 15;
        {
            const int s = tid >> 2, q = tid & 3, tok = ch * 128 + s, c0 = 64 * g + q * 16;
            float a1 = 0.f, a2 = 0.f;
#pragma unroll
            for (int e = 0; e < 8; ++e) { const f32x4 pp = *(const f32x4*)(vst + (size_t)tok * 32 + 4 * e); a1 += pp[0]; a2 += pp[1]; a1 += pp[2]; a2 += pp[3]; }
            const float m1 = a1 * (1.0f / 1024.0f), m2 = a2 * (1.0f / 1024.0f);
            const float rstd = rsqrtf(fmaxf(m2 - m1 * m1, 0.f) + 1e-6f);
            const u32x4 a = *(const u32x4*)(V + (size_t)tok * D + c0), b = *(const u32x4*)(V + (size_t)tok * D + c0 + 8);
            const unsigned wv[8] = {a.x, a.y, a.z, a.w, b.x, b.y, b.z, b.w};
#pragma unroll
            for (int e = 0; e < 8; ++e) {
                const int c = c0 + 2 * e;
                const float x0 = (bflo(wv[e]) - m1) * rstd * lng[c] + lnb[c], x1 = (bfhi(wv[e]) - m1) * rstd * lng[c + 1] + lnb[c + 1];
                vt[(q * 16 + 2 * e) * 136 + s] = f2bf(x0); vt[(q * 16 + 2 * e + 1) * 136 + s] = f2bf(x1);
            }
        }
        __syncthreads();
        {
            const int tl = lane & 15, kg = lane >> 4, tt = wave * 16 + tl;
            f32x4 acc[4];
#pragma unroll
            for (int n = 0; n < 4; ++n) acc[n] = (f32x4){0.f, 0.f, 0.f, 0.f};
#pragma unroll
            for (int ks = 0; ks < 4; ++ks) {
                const bf16x8 bfrag = *(const bf16x8*)(WS + ((size_t)g * 128 + tt) * 128 + ks * 32 + kg * 8);
#pragma unroll
                for (int n = 0; n < 4; ++n) {
                    const bf16x8 afrag = *(const LAS bf16x8*)(vt + (n * 16 + tl) * 136 + ks * 32 + kg * 8);
                    acc[n] = __builtin_amdgcn_mfma_f32_16x16x32_bf16(afrag, bfrag, acc[n], 0, 0, 0);
                }
            }
            const int tok = ch * 128 + tt; const float bb = bs[g * 128 + tt];
#pragma unroll
            for (int n = 0; n < 4; ++n) {
                const int c = 64 * g + n * 16 + kg * 4;
                const u32x2 uu = *(const u32x2*)(U + (size_t)tok * D + c);
                const float o0 = (acc[n][0] + bb) * bflo(uu.x), o1 = (acc[n][1] + bb) * bfhi(uu.x), o2 = (acc[n][2] + bb) * bflo(uu.y), o3 = (acc[n][3] + bb) * bfhi(uu.y);
                u32x2 w; w.x = cvt_pk_bf16(o0, o1); w.y = cvt_pk_bf16(o2, o3);
                *(u32x2*)(UV + (size_t)tok * D + c) = w;
            }
        }
        __syncthreads();
    }
}

__device__ void prep_phase(KP p, int l) {
    const int il = l >> 1;
    const int lane = TIDX() & 63, gw = BIDX() * 8 + (TIDX() >> 6), nw = GDIM() * 8;
    const int tl = lane & 15, kg = lane >> 4;
    const bf16_t* W2T = (const bf16_t*)(p->ws + W_W2T); const bf16_t* A2T = (const bf16_t*)(p->ws + W_A2T); const bf16_t* V2T = (const bf16_t*)(p->ws + W_V2T);
    const bf16_t* TW = (const bf16_t*)(p->ws + WS_TW); const bf16_t* A1O = (const bf16_t*)(p->ws + WS_A1O); const bf16_t* V1O = (const bf16_t*)(p->ws + WS_V1O);
    const bf16_t* R = (const bf16_t*)(p->ws + BIG(4)); const bf16_t* Kb = (const bf16_t*)(p->ws + BIG(5));
    bf16_t* Vb = (bf16_t*)(p->ws + (il == 0 ? BIG(0) : BIG(6))); const bf16_t* VF = (const bf16_t*)(p->ws + BIG(0));
    bf16_t* Z[2] = {(bf16_t*)(p->ws + BIG(1)), (bf16_t*)(p->ws + BIG(2))}; bf16_t* AP[2] = {(bf16_t*)(p->ws + BIG(3)), (bf16_t*)(p->ws + BIG(7))};
    float* BON = (float*)(p->ws + WS_BON);
    const float* w0 = p->in[I_W0] + (size_t)il * 2 * D; const float* a0 = p->in[I_A0] + (size_t)il * 2 * D; const float* v0 = p->in[I_V0];
    const float* k_a = p->in[I_KA] + il * D; const float* r_k = p->in[I_RK] + il * D;
    for (int u = gw; u < (T / 16) * 16; u += nw) {
        const int tok0 = (u >> 4) * 16, h = u & 15, tk = tok0 + tl;
        f32x4 az[2][4], aa[2][4], av[4];
#pragma unroll
        for (int d = 0; d < 2; ++d)
#pragma unroll
            for (int n = 0; n < 4; ++n) { az[d][n] = (f32x4){0.f, 0.f, 0.f, 0.f}; aa[d][n] = (f32x4){0.f, 0.f, 0.f, 0.f}; }
#pragma unroll
        for (int n = 0; n < 4; ++n) av[n] = (f32x4){0.f, 0.f, 0.f, 0.f};
#pragma unroll
        for (int d = 0; d < 2; ++d)
#pragma unroll
            for (int ks = 0; ks < 2; ++ks) {
                const bf16x8 bz = *(const bf16x8*)(TW + (size_t)tk * 128 + d * 64 + ks * 32 + kg * 8);
                const bf16x8 ba = *(const bf16x8*)(A1O + (size_t)tk * 128 + d * 64 + ks * 32 + kg * 8);
#pragma unroll
                for (int n = 0; n < 4; ++n) {
                    const size_t wrow = (size_t)d * D * 64 + (size_t)(h * 64 + n * 16 + tl) * 64 + ks * 32 + kg * 8;
                    az[d][n] = __builtin_amdgcn_mfma_f32_16x16x32_bf16(*(const bf16x8*)(W2T + wrow), bz, az[d][n], 0, 0, 0);
                    aa[d][n] = __builtin_amdgcn_mfma_f32_16x16x32_bf16(*(const bf16x8*)(A2T + wrow), ba, aa[d][n], 0, 0, 0);
                }
            }
        if (il == 1) {
            const bf16x8 bv = *(const bf16x8*)(V1O + (size_t)tk * 32 + kg * 8);
#pragma unroll
            for (int n = 0; n < 4; ++n) av[n] = __builtin_amdgcn_mfma_f32_16x16x32_bf16(*(const bf16x8*)(V2T + (size_t)(h * 64 + n * 16 + tl) * 32 + kg * 8), bv, av[n], 0, 0, 0);
        }
        float bsum = 0.f;
#pragma unroll
        for (int n = 0; n < 4; ++n) {
            const int c = h * 64 + n * 16 + kg * 4; const size_t off = (size_t)tk * D + c;
            const u32x2 rr = *(const u32x2*)(R + off), kk = *(const u32x2*)(Kb + off);
            const float rf[4] = {bflo(rr.x), bfhi(rr.x), bflo(rr.y), bfhi(rr.y)}, kf[4] = {bflo(kk.x), bfhi(kk.x), bflo(kk.y), bfhi(kk.y)};
            const f32x4 ka = *(const f32x4*)(k_a + c), rk = *(const f32x4*)(r_k + c);
#pragma unroll
            for (int d = 0; d < 2; ++d) {
                const f32x4 w0v = *(const f32x4*)(w0 + d * D + c), a0v = *(const f32x4*)(a0 + d * D + c);
                const f32x4 z = az[d][n] + w0v, ap = aa[d][n] + a0v;
                u32x2 wz, wa; wz.x = cvt_pk_bf16(z[0], z[1]); wz.y = cvt_pk_bf16(z[2], z[3]); wa.x = cvt_pk_bf16(ap[0], ap[1]); wa.y = cvt_pk_bf16(ap[2], ap[3]);
                *(u32x2*)(Z[d] + off) = wz; *(u32x2*)(AP[d] + off) = wa;
                const float apr[4] = {bflo(wa.x), bfhi(wa.x), bflo(wa.y), bfhi(wa.y)};
#pragma unroll
                for (int j = 0; j < 4; ++j) { const float a = sigmoidf_(apr[j]); bsum += rf[j] * kf[j] * (1.0f + (a - 1.0f) * ka[j]) * rk[j]; }
            }
            if (il == 1) {
                const u32x2 vv = *(const u32x2*)(Vb + off), vf = *(const u32x2*)(VF + off);
                const float vx[4] = {bflo(vv.x), bfhi(vv.x), bflo(vv.y), bfhi(vv.y)}, fx[4] = {bflo(vf.x), bfhi(vf.x), bflo(vf.y), bfhi(vf.y)};
                const f32x4 v0v = *(const f32x4*)(v0 + c);
                float o[4];
#pragma unroll
                for (int j = 0; j < 4; ++j) o[j] = vx[j] + (fx[j] - vx[j]) * sigmoidf_(v0v[j] + av[n][j]);
                u32x2 w; w.x = cvt_pk_bf16(o[0], o[1]); w.y = cvt_pk_bf16(o[2], o[3]);
                *(u32x2*)(Vb + off) = w;
            }
        }
        bsum += __shfl_xor(bsum, 16); bsum += __shfl_xor(bsum, 32);
        if (kg == 0) BON[(size_t)tk * 16 + h] = bsum;
    }
}

__device__ void scan_phase(KP p, int l, LAS unsigned char* lds) {
    const int il = l >> 1;
    const int tid = TIDX(), hb = tid >> 8, ht = tid & 255, hw = ht >> 6, lane = tid & 63, cg = lane & 7, rg = lane >> 3, G = GDIM();
    LAS float* stg = (LAS float*)(lds + hb * 57344);
    LAS float* ybuf = stg + 2 * 16 * 384;
    const bf16_t* R = (const bf16_t*)(p->ws + BIG(4)); const bf16_t* Kb = (const bf16_t*)(p->ws + BIG(5));
    const bf16_t* Vb = (const bf16_t*)(p->ws + (il == 0 ? BIG(0) : BIG(6)));
    const int ts = ht >> 4, c4 = ht & 15;
    for (int slot = BIDX(); slot < 256; slot += G) {
        f32x2 s[2][4];
        int b = 0, h = 0, d = 0, tok0 = 0, L = 0; bool active = false;
        bf16_t* Zd = nullptr; const bf16_t* APd = nullptr;
        f32x4 kkc = (f32x4){0.f, 0.f, 0.f, 0.f}, kac = kkc;
        u32x2 pr, pk, pv, pz, pa; pr = pk = pv = pz = pa = (u32x2){0u, 0u};
        for (int ci = 0; ci <= 128; ++ci) {
            const bool start = hb == 0 ? (ci == 0) : (ci == 0 || ci == 16);
            const bool finish = hb == 0 ? (ci == 128) : (ci == 16 || ci == 32);
            if (finish && active && hb == 1) {
                float* so = p->out + (size_t)T * D + ((size_t)((b * 2 + il) * 2 + d) * 16 + h) * 4096;
#pragma unroll
                for (int a = 0; a < 2; ++a)
#pragma unroll
                    for (int bp = 0; bp < 4; ++bp) *(f32x2*)(so + (16 * hw + 2 * rg + a) * 64 + 8 * cg + 2 * bp) = s[a][bp];
            }
            if (ci == 128) break;
            if (start) {
                int sid;
                if (hb == 0) { sid = slot; tok0 = TC; L = 2048; } else { sid = slot * 2 + (ci >> 4); tok0 = 0; L = 256; }
                b = sid >> 5; h = (sid & 31) >> 1; d = sid & 1; tok0 += b * L; active = true;
                Zd = (bf16_t*)(p->ws + BIG(1 + d)); APd = (const bf16_t*)(p->ws + (d == 0 ? BIG(3) : BIG(7)));
                kkc = *(const f32x4*)(p->in[I_KK] + il * D + h * 64 + 4 * c4); kac = *(const f32x4*)(p->in[I_KA] + il * D + h * 64 + 4 * c4);
                if (hb == 0) {
                    const float* si = p->in[I_STATE] + ((size_t)((b * 2 + il) * 2 + d) * 16 + h) * 4096;
#pragma unroll
                    for (int a = 0; a < 2; ++a)
#pragma unroll
                        for (int bp = 0; bp < 4; ++bp) s[a][bp] = *(const f32x2*)(si + (16 * hw + 2 * rg + a) * 64 + 8 * cg + 2 * bp);
                } else {
#pragma unroll
                    for (int a = 0; a < 2; ++a)
#pragma unroll
                        for (int bp = 0; bp < 4; ++bp) s[a][bp] = (f32x2){0.f, 0.f};
                }
            } else if (hb == 1 && ci >= 32) active = false;
            const int nch = L >> 4;
            const int cj = hb == 0 ? ci : (ci & 15);
#define SCAN_GLOAD(chunk) do { const int tt_ = (chunk) * 16 + ts, t_ = tok0 + (d ? L - 1 - tt_ : tt_); \
                const size_t off_ = (size_t)t_ * D + h * 64 + 4 * c4; \
                pr = *(const u32x2*)(R + off_); pk = *(const u32x2*)(Kb + off_); pv = *(const u32x2*)(Vb + off_); pz = *(const u32x2*)(Zd + off_); pa = *(const u32x2*)(APd + off_); } while (0)
#define SCAN_STAGE(bufi) do { \
                const float kf[4] = {bflo(pk.x), bfhi(pk.x), bflo(pk.y), bfhi(pk.y)}; \
                f32x4 kx; float ss = 0.f; \
                _Pragma("unroll") for (int j = 0; j < 4; ++j) { kx[j] = kf[j] * kkc[j]; ss += kx[j] * kx[j]; } \
                ss = red16(ss); \
                const float inv = 1.0f / fmaxf(sqrtf(ss), 1e-12f); \
                const float zf[4] = {bflo(pz.x), bfhi(pz.x), bflo(pz.y), bfhi(pz.y)}, af[4] = {bflo(pa.x), bfhi(pa.x), bflo(pa.y), bfhi(pa.y)}; \
                f32x4 nkk, wv, bv, kd, rv, vv; \
                _Pragma("unroll") for (int j = 0; j < 4; ++j) { \
                    const float kk = kx[j] * inv, a = sigmoidf_(af[j]); \
                    nkk[j] = -kk; wv[j] = __expf(-0.6065306597f * sigmoidf_(zf[j])); bv[j] = kk * a; kd[j] = kf[j] * (1.0f + (a - 1.0f) * kac[j]); } \
                rv = (f32x4){bflo(pr.x), bfhi(pr.x), bflo(pr.y), bfhi(pr.y)}; vv = (f32x4){bflo(pv.x), bfhi(pv.x), bflo(pv.y), bfhi(pv.y)}; \
                LAS float* sp_ = stg + ((bufi) * 16 + ts) * 384 + 4 * c4; \
                *(LAS f32x4*)(sp_) = nkk; *(LAS f32x4*)(sp_ + 64) = wv; *(LAS f32x4*)(sp_ + 128) = bv; *(LAS f32x4*)(sp_ + 192) = kd; *(LAS f32x4*)(sp_ + 256) = rv; *(LAS f32x4*)(sp_ + 320) = vv; } while (0)
            const int buf = ci & 1;
            if (start) { SCAN_GLOAD(0); SCAN_STAGE(buf); }
            __syncthreads();
            const bool pre = active && (cj + 1 < nch);
            if (pre) SCAN_GLOAD(cj + 1);
            if (active) {
#pragma unroll 2
                for (int st = 0; st < 16; ++st) {
                    const LAS float* sp = stg + (buf * 16 + st) * 384;
                    const f32x4 nk0 = *(const LAS f32x4*)(sp + 8 * cg), nk1 = *(const LAS f32x4*)(sp + 8 * cg + 4);
                    const f32x4 w0 = *(const LAS f32x4*)(sp + 64 + 8 * cg), w1 = *(const LAS f32x4*)(sp + 64 + 8 * cg + 4);
                    const f32x4 b0 = *(const LAS f32x4*)(sp + 128 + 8 * cg), b1 = *(const LAS f32x4*)(sp + 128 + 8 * cg + 4);
                    const f32x4 k0 = *(const LAS f32x4*)(sp + 192 + 8 * cg), k1 = *(const LAS f32x4*)(sp + 192 + 8 * cg + 4);
                    const f32x4 r0 = *(const LAS f32x4*)(sp + 256 + 8 * cg), r1 = *(const LAS f32x4*)(sp + 256 + 8 * cg + 4);
                    const f32x2 vr = *(const LAS f32x2*)(sp + 320 + 16 * hw + 2 * rg);
                    const f32x2 nk[4] = {{nk0[0], nk0[1]}, {nk0[2], nk0[3]}, {nk1[0], nk1[1]}, {nk1[2], nk1[3]}};
                    const f32x2 ww[4] = {{w0[0], w0[1]}, {w0[2], w0[3]}, {w1[0], w1[1]}, {w1[2], w1[3]}};
                    const f32x2 bb[4] = {{b0[0], b0[1]}, {b0[2], b0[3]}, {b1[0], b1[1]}, {b1[2], b1[3]}};
                    const f32x2 kd[4] = {{k0[0], k0[1]}, {k0[2], k0[3]}, {k1[0], k1[1]}, {k1[2], k1[3]}};
                    const f32x2 rr[4] = {{r0[0], r0[1]}, {r0[2], r0[3]}, {r1[0], r1[1]}, {r1[2], r1[3]}};
                    float yo[2];
#pragma unroll
                    for (int a = 0; a < 2; ++a) {
                        f32x2 t = s[a][0] * nk[0]; t += s[a][1] * nk[1]; t += s[a][2] * nk[2]; t += s[a][3] * nk[3];
                        const float sa = red8(t[0] + t[1]);
                        const f32x2 sa2 = (f32x2){sa, sa}, v2 = (f32x2){vr[a], vr[a]};
#pragma unroll
                        for (int bp = 0; bp < 4; ++bp) s[a][bp] = s[a][bp] * ww[bp] + sa2 * bb[bp] + v2 * kd[bp];
                        f32x2 y = s[a][0] * rr[0]; y += s[a][1] * rr[1]; y += s[a][2] * rr[2]; y += s[a][3] * rr[3];
                        yo[a] = red8(y[0] + y[1]);
                    }
                    if (cg == 0) *(LAS f32x2*)(ybuf + (buf * 16 + st) * 64 + 16 * hw + 2 * rg) = (f32x2){yo[0], yo[1]};
                }
            }
            if (pre) SCAN_STAGE(buf ^ 1);
            __syncthreads();
            if (active) {
                const int tt = cj * 16 + ts, t = tok0 + (d ? L - 1 - tt : tt);
                const f32x4 y = *(const LAS f32x4*)(ybuf + (buf * 16 + ts) * 64 + 4 * c4);
                u32x2 w; w.x = cvt_pk_bf16(y[0], y[1]); w.y = cvt_pk_bf16(y[2], y[3]);
                *(u32x2*)(Zd + (size_t)t * D + h * 64 + 4 * c4) = w;
            }
        }
        __syncthreads();
    }
}

__device__ void post_phase(KP p, int l) {
    const int il = l >> 1;
    const int lane = TIDX() & 63, gw = BIDX() * 8 + (TIDX() >> 6), nw = GDIM() * 8;
    const int tl = lane & 15, kg = lane >> 4;
    const bf16_t* G2T = (const bf16_t*)(p->ws + W_G2T); const bf16_t* SG = (const bf16_t*)(p->ws + WS_SG);
    const bf16_t* Y0 = (const bf16_t*)(p->ws + BIG(1)); const bf16_t* Y1 = (const bf16_t*)(p->ws + BIG(2));
    const bf16_t* Vb = (const bf16_t*)(p->ws + (il == 0 ? BIG(0) : BIG(6)));
    bf16_t* YG = (bf16_t*)(p->ws + BIG(3));
    const float* BON = (const float*)(p->ws + WS_BON);
    const float* lng = p->in[I_LNG] + il * D; const float* lnb = p->in[I_LNB] + il * D;
    for (int u = gw; u < (T / 16) * 16; u += nw) {
        const int tok0 = (u >> 4) * 16, h = u & 15, tk = tok0 + tl;
        f32x4 ag[4];
#pragma unroll
        for (int n = 0; n < 4; ++n) ag[n] = (f32x4){0.f, 0.f, 0.f, 0.f};
#pragma unroll
        for (int ks = 0; ks < 4; ++ks) {
            const bf16x8 bg = *(const bf16x8*)(SG + (size_t)tk * 128 + ks * 32 + kg * 8);
#pragma unroll
            for (int n = 0; n < 4; ++n) ag[n] = __builtin_amdgcn_mfma_f32_16x16x32_bf16(*(const bf16x8*)(G2T + (size_t)(h * 64 + n * 16 + tl) * 128 + ks * 32 + kg * 8), bg, ag[n], 0, 0, 0);
        }
        f32x4 y[4]; float s1 = 0.f;
#pragma unroll
        for (int n = 0; n < 4; ++n) {
            const size_t off = (size_t)tk * D + h * 64 + n * 16 + kg * 4;
            const u32x2 a = *(const u32x2*)(Y0 + off), b = *(const u32x2*)(Y1 + off);
            y[n] = (f32x4){bflo(a.x) + bflo(b.x), bfhi(a.x) + bfhi(b.x), bflo(a.y) + bflo(b.y), bfhi(a.y) + bfhi(b.y)};
            s1 += y[n][0] + y[n][1] + y[n][2] + y[n][3];
        }
        s1 += __shfl_xor(s1, 16); s1 += __shfl_xor(s1, 32);
        const float mean = s1 * (1.0f / 64.0f); float s2 = 0.f;
#pragma unroll
        for (int n = 0; n < 4; ++n)
#pragma unroll
            for (int j = 0; j < 4; ++j) { const float dd = y[n][j] - mean; s2 += dd * dd; }
        s2 += __shfl_xor(s2, 16); s2 += __shfl_xor(s2, 32);
        const float rstd = rsqrtf(s2 * (1.0f / 64.0f) + 64e-5f);
        const float bon = BON[(size_t)tk * 16 + h];
#pragma unroll
        for (int n = 0; n < 4; ++n) {
            const int c = h * 64 + n * 16 + kg * 4; const size_t off = (size_t)tk * D + c;
            const u32x2 vv = *(const u32x2*)(Vb + off);
            const float vx[4] = {bflo(vv.x), bfhi(vv.x), bflo(vv.y), bfhi(vv.y)};
            const f32x4 gg = *(const f32x4*)(lng + c), gb = *(const f32x4*)(lnb + c);
            float o[4];
#pragma unroll
            for (int j = 0; j < 4; ++j) o[j] = ((y[n][j] - mean) * rstd * gg[j] + gb[j] + bon * vx[j]) * ag[n][j];
            u32x2 w; w.x = cvt_pk_bf16(o[0], o[1]); w.y = cvt_pk_bf16(o[2], o[3]);
            *(u32x2*)(YG + off) = w;
        }
    }
}

constexpr int N_PHASES = 1 + 7 + 9 + 7 + 9 + 1;

__device__ void run_phase(KP p, int ph, LAS unsigned char* lds) {
    const int G = GDIM(), bid = BIDX();
    unsigned char* ws = p->ws;
    const float* mod = (const float*)(ws + WS_MOD);
    if (ph == 0 && OPEN(30)) {
        ada_phase(p, lds);
        wconv_sgu(p, 0, (LAS float*)lds);
        return;
    }
    if (ph == N_PHASES - 1) { if (OPEN(31)) final_norm_phase(p); return; }
    int q = ph - 1, l;
    if (q < 7) l = 0; else if (q < 16) { l = 1; q -= 7; } else if (q < 23) { l = 2; q -= 16; } else { l = 3; q -= 23; }
    const bool sgu = (l & 1) == 0;
    const float* modl = mod + (size_t)l * 9 * 6144;
    int op;
    if (sgu) op = q < 4 ? q : 10 + (q - 4); else op = q < 6 ? 20 + q : 10 + (q - 6);
    const float* xp_lo = p->out; const float* xp_hi = p->out;
    if (l == 0 && op == 3) { xp_lo = p->in[I_XP]; xp_hi = p->in[I_XS] - (size_t)TC * D; }
    pg8::Sched S;
    switch (op) {
    case 0: if (!OPEN(0)) break;
        if (l > 0) wconv_sgu(p, l, (LAS float*)lds);
        norm_phase(p, l, 0, l == 0, (bf16_t*)(ws + BIG(1)));
        break;
    case 1: if (!OPEN(1)) break; {
        S.init(ws + BIG(1), 0, ws + W_INT, 0, 8, D, T, 2048, G, bid);
        EpiGeluUV E{(bf16_t*)(ws + BIG(2)), (bf16_t*)(ws + BIG(3)), (float*)(ws + WS_VST)};
        pg8::gemm_phase(lds, S, E);
    } break;
    case 2: if (!OPEN(2)) break; sgu_mix_phase(p, l, lds); break;
    case 3: if (!OPEN(3)) break; {
        S.init(ws + BIG(4), 0, ws + W_OUTT, 0, 4, D, T, D, G, bid);
        EpiRes E{xp_lo, xp_hi, p->out, modl, 2048};
        pg8::gemm_phase(lds, S, E);
    } break;
    case 10: if (!OPEN(10)) break;
        if (sgu) wconv_rwkv_lora_down(p, l + 1, (LAS float*)lds);
        norm_phase(p, l, 1, false, (bf16_t*)(ws + BIG(1)));
        break;
    case 11: if (!OPEN(11)) break; {
        S.init(ws + BIG(1), 0, ws + W_MLP1T, 0, 16, D, T, DFF, G, bid);
        EpiBf16<1> E{(bf16_t*)(ws + BIG(2)), nullptr, nullptr, DFF};
        pg8::gemm_phase(lds, S, E);
    } break;
    case 12: if (!OPEN(12)) break; {
        S.init(ws + BIG(2), 0, ws + W_MLP2T, 0, 4, DFF, T, D, G, bid);
        EpiRes E{p->out, p->out, p->out, modl, 5120};
        pg8::gemm_phase(lds, S, E);
    } break;
    case 20: if (!OPEN(20)) break;
        wconv_rwkv_main(p, l, (LAS float*)(lds + 80 * 1024));
        rmix_phase(p, l, lds);
        break;
    case 21: if (!OPEN(21)) break; {
        S.init(ws + BIG(1), BIGSZ, ws + W_RT, 2 * MiB, 4, D, T, 3 * D, G, bid);
        EpiBf16<0> E{(bf16_t*)(ws + BIG(4)), (bf16_t*)(ws + BIG(5)), (bf16_t*)(ws + (l == 1 ? BIG(0) : BIG(6))), D};
        pg8::gemm_phase(lds, S, E);
    } break;
    case 22: if (!OPEN(22)) break; prep_phase(p, l); break;
    case 23: if (!OPEN(23)) break; scan_phase(p, l, lds); break;
    case 24: if (!OPEN(24)) break; post_phase(p, l); break;
    case 25: if (!OPEN(25)) break; {
        S.init(ws + BIG(3), 0, ws + W_OT, 0, 4, D, T, D, G, bid);
        EpiRes E{p->out, p->out, p->out, modl, 2048};
        pg8::gemm_phase(lds, S, E);
    } break;
    default: break;
    }
}

__global__ void __launch_bounds__(NTHREADS, 2) mega(Params p_unused) {
    extern __shared__ __attribute__((aligned(16))) unsigned char smem[];
    LAS unsigned char* lds = (LAS unsigned char*)smem;
#if MULTI_LAUNCH
    run_phase(kparams(), kparams()->ph_lo, lds);
#else
    cg::grid_group grid = cg::this_grid();
    const int lo = kparams()->ph_lo, hi = kparams()->ph_hi;
    for (int ph = lo; ph < hi; ++ph) {
        run_phase(kparams(), ph, lds);
        if (ph + 1 < hi) { __syncthreads(); grid.sync(); }
    }
#endif
}

extern "C" void kernel_launch(void* const* d_in, const int* in_sizes, int n_in, void* d_out, int out_size, void* d_ws, size_t ws_size, hipStream_t stream) {
    static int grid = 0;
    if (grid == 0) {
        int dev = 0, cus = 0, per_cu = 0;
        hipGetDevice(&dev);
        hipDeviceGetAttribute(&cus, hipDeviceAttributeMultiprocessorCount, dev);
        if (hipFuncSetAttribute((const void*)mega, hipFuncAttributeMaxDynamicSharedMemorySize, LDS_BYTES) != hipSuccess) { fprintf(stderr, "hipFuncSetAttribute failed\n"); grid = -1; return; }
        if (hipOccupancyMaxActiveBlocksPerMultiprocessor(&per_cu, (const void*)mega, NTHREADS, LDS_BYTES) != hipSuccess || per_cu < 1) { fprintf(stderr, "occupancy query failed (%d)\n", per_cu); per_cu = 1; }
        (void)hipGetLastError();
        grid = cus * (per_cu < 1 ? 1 : (per_cu > 1 ? 1 : per_cu));
        if (ws_size < BIG(8)) fprintf(stderr, "workspace too small: %zu < %zu\n", ws_size, (size_t)BIG(8));
    }
    if (grid < 0) return;
    Params hp{};
    for (int i = 0; i < N_IN; ++i) hp.in[i] = (const float*)d_in[i];
    hp.out = (float*)d_out; hp.ws = (unsigned char*)d_ws;
#if MULTI_LAUNCH
    for (int ph = 0; ph < N_PHASES; ++ph) {
        hp.ph_lo = ph; hp.ph_hi = ph + 1;
        hipLaunchKernelGGL(mega, dim3(grid), dim3(NTHREADS), LDS_BYTES, stream, hp);
    }
#else
    hp.ph_lo = 0; hp.ph_hi = N_PHASES;
    void* args[] = {&hp};
    hipError_t e = hipLaunchCooperativeKernel((const void*)mega, dim3(grid), dim3(NTHREADS), args, LDS_BYTES, stream);
    if (e != hipSuccess) fprintf(stderr, "cooperative launch failed: %s (grid %d)\n", hipGetErrorString(e), grid);
#endif
}
```

```cpp
#include <hip/hip_runtime.h>
#include <hip/hip_cooperative_groups.h>
#include <cstdio>
namespace cg = cooperative_groups;

#define LAS __attribute__((address_space(3)))
typedef unsigned short bf16_t;
typedef short bf16x8 __attribute__((ext_vector_type(8)));
typedef float f32x4 __attribute__((ext_vector_type(4)));
typedef float f32x2 __attribute__((ext_vector_type(2)));
typedef unsigned u32x4 __attribute__((ext_vector_type(4)));
typedef unsigned u32x2 __attribute__((ext_vector_type(2)));

#ifndef OPMASK
#define OPMASK 0xFFFFFFFFu
#endif
#define OPEN(b) ((OPMASK >> (b)) & 1u)
#ifndef DUPMASK
#define DUPMASK 0u
#endif
#define DUP(b) ((DUPMASK >> (b)) & 1u)
#ifndef SCANVAR
#define SCANVAR 0
#endif
#ifndef PROFMASK
#define PROFMASK 0u
#endif
#ifndef MERGED_MLP
#define MERGED_MLP 1
#endif
#ifndef MULTI_LAUNCH
#define MULTI_LAUNCH 0
#endif

constexpr int T = 20480, TC = 4096, D = 1024, DFF = 4096;
constexpr int NTHREADS = 512;
constexpr int LDS_BYTES = 131072 + 16;
constexpr size_t MiB = 1u << 20;
constexpr size_t W_MLP1T = 0, W_MLP2T = 8 * MiB, W_INT = 16 * MiB, W_OUTT = 20 * MiB, W_S = 22 * MiB;
constexpr size_t W_RT = 16 * MiB, W_KT = 18 * MiB, W_VT = 20 * MiB, W_OT = 22 * MiB;
constexpr size_t W_LD = 24 * MiB;
constexpr size_t W_W2T = 25 * MiB;
constexpr size_t W_A2T = 25 * MiB + 256 * 1024;
constexpr size_t W_V2T = 25 * MiB + 512 * 1024;
constexpr size_t W_G2T = 25 * MiB + 640 * 1024;
constexpr size_t WS_MOD = 32 * MiB;
constexpr size_t WS_VST = 53 * MiB;
constexpr size_t WS_BON = 34 * MiB;
constexpr size_t WS_TW = 36 * MiB, WS_A1O = 41 * MiB, WS_SG = 46 * MiB, WS_V1O = 51 * MiB;
constexpr size_t WS_BAR = 55 * MiB + 768 * 1024;
constexpr size_t WS_RDY = WS_BAR + 16 * 1024;
constexpr size_t WS_BIG = 56 * MiB, BIGSZ = 40 * MiB;
#define BIG(i) (WS_BIG + (size_t)(i) * BIGSZ)

enum { I_XP = 0, I_XS, I_STATE, I_C, I_CCTX, I_N1G, I_N2G, I_ADAW, I_ADAB, I_SWIN, I_SLNG, I_SLNB, I_SWS, I_SBS, I_SWOUT,
       I_MU, I_WR, I_WK, I_WV, I_WO, I_W0, I_W1, I_W2, I_A0, I_A1, I_A2, I_V0, I_V1, I_V2, I_G1, I_G2, I_KK, I_KA, I_RK, I_LNG, I_LNB,
       I_M1, I_M2, I_FG, N_IN };

struct Params { const float* in[N_IN]; float* out; unsigned char* ws; int ph_lo, ph_hi; };
typedef const __attribute__((address_space(4))) Params* KP;
__device__ __forceinline__ KP kparams() { KP k = (KP)__builtin_amdgcn_kernarg_segment_ptr(); asm volatile("" : "+s"(k)); return k; }

__device__ __forceinline__ int TIDX() { int t = threadIdx.x; asm volatile("" : "+v"(t)); return t; }
__device__ __forceinline__ int BIDX() { int t = blockIdx.x; asm volatile("" : "+s"(t)); return t; }
__device__ __forceinline__ int GDIM() { int t = gridDim.x; asm volatile("" : "+s"(t)); return t; }
__device__ __forceinline__ unsigned cvt_pk_bf16(float lo, float hi) { unsigned r; asm volatile("v_cvt_pk_bf16_f32 %0, %1, %2" : "=v"(r) : "v"(lo), "v"(hi)); return r; }
__device__ __forceinline__ bf16_t f2bf(float f) { unsigned u = __float_as_uint(f); u += 0x7FFFu + ((u >> 16) & 1u); return (bf16_t)(u >> 16); }
__device__ __forceinline__ float bf2f(unsigned b) { return __uint_as_float(b << 16); }
__device__ __forceinline__ float bflo(unsigned w) { return __uint_as_float(w << 16); }
__device__ __forceinline__ float bfhi(unsigned w) { return __uint_as_float(w & 0xFFFF0000u); }
__device__ __forceinline__ float rcpf_(float x) { return __builtin_amdgcn_rcpf(x); }
__device__ __forceinline__ float sigmoidf_(float x) { return rcpf_(1.0f + __expf(-x)); }
__device__ __forceinline__ float tanhf_(float x) { float e = __expf(-2.0f * fabsf(x)); float t = (1.0f - e) * rcpf_(1.0f + e); return x < 0.f ? -t : t; }
__device__ __forceinline__ float gelu_tanh(float x) { float u = 1.5957691216f * (x + 0.044715f * x * x * x); return x * rcpf_(1.0f + __expf(-u)); }
__device__ __forceinline__ float wave_sum(float v) {
#pragma unroll
    for (int o = 32; o >= 1; o >>= 1) v += __shfl_xor(v, o);
    return v;
}
#define LDS_BARRIER() do { asm volatile("s_waitcnt lgkmcnt(0)" ::: "memory"); __builtin_amdgcn_s_barrier(); asm volatile("" ::: "memory"); } while (0)
template <int CTRL> __device__ __forceinline__ float dpp_f(float x) { return __int_as_float(__builtin_amdgcn_update_dpp(0, __float_as_int(x), CTRL, 0xF, 0xF, true)); }
__device__ __forceinline__ float red8(float x) { x += dpp_f<0xB1>(x); x += dpp_f<0x4E>(x); x += dpp_f<0x141>(x); return x; }
__device__ __forceinline__ float red16(float x) { x = red8(x); x += dpp_f<0x140>(x); return x; }
__device__ __forceinline__ int cond_row(int t) { return t < TC ? 0 : 1 + ((t - TC) >> 11); }
__device__ __forceinline__ const float* xrow_ptr(KP p, bool from_input, int row) {
    if (from_input) return row < TC ? p->in[I_XP] + (size_t)row * D : p->in[I_XS] + (size_t)(row - TC) * D;
    return p->out + (size_t)row * D;
}

namespace pg8 {
constexpr int BM = 256, BK = 64, HALF = 128, HTB = HALF * BK * 2, STAGE_BYTES = 8 * HTB, NXCD = 8, WGM = 8;
__device__ __forceinline__ int lds_byte(int r, int c) { const int st = (r >> 4) * 2 + (c >> 5), rr = r & 15, cc = c & 31, ob = rr * 64 + cc * 2; return st * 1024 + (ob ^ (((ob >> 9) & 1) << 5)); }
__device__ __forceinline__ void stage_rc(int b, int& R, int& C) { const int st = b / 1024, sb = b % 1024, swz = sb ^ (((sb >> 9) & 1) << 5); R = (st >> 1) * 16 + swz / 64; C = (st & 1) * 32 + (swz % 64) / 2; }
__device__ __forceinline__ int perm32(int rho) { const int n = rho >> 4, i = rho & 15; return 8 * (i >> 2) + 4 * n + (i & 3); }
struct Unit { int pm, pn, gi; };
struct Sched {
    const char* A; size_t strideA; const char* Bt; size_t strideB; int tpg, K;
    int nM, nN, nwg, G, c, mode;
    unsigned* ready;
    __device__ void init(const void* A_, size_t sA, const void* Bt_, size_t sB, int tpg_, int K_, int M, int Nv, int G_, int c_, int mode_ = 0, unsigned* ready_ = nullptr) {
        A = (const char*)A_; strideA = sA; Bt = (const char*)Bt_; strideB = sB; tpg = tpg_; K = K_; nM = M / BM; nN = Nv / BM; nwg = nM * nN; G = G_; c = c_; mode = mode_; ready = ready_; }
    __device__ bool next(int i, Unit& u) const {
        int pm = 0, pn = 0, gi = 0; bool ok;
        if (mode == 1) {
            const int ui = i < 2 ? i * 256 + c : 512 + (i - 2) * 192 + (c - 64);
            ok = (i < 2) || (c >= 64 && i < 6);
            pm = ui >> 4; pn = ui & 15;
        } else if (mode == 2) {
            const int d = c < 64 ? c + 64 * i : 128 + (c - 64);
            ok = c < 64 ? (i < 2) : (i < 1);
            pm = d >> 2; pn = d & 3;
        } else {
            const long L = (long)i * G + c; ok = L < nwg;
            int wgid = ok ? (int)L : 0; { const int q = nwg / NXCD, r = nwg % NXCD, xcd = wgid % NXCD, off = wgid / NXCD; wgid = (xcd < r ? xcd * (q + 1) : r * (q + 1) + (xcd - r) * q) + off; }
            const int nig = WGM * nN, gid = wgid / nig, fm = gid * WGM, gsz = (nM - fm) < WGM ? (nM - fm) : WGM;
            pm = fm + ((wgid % nig) % gsz); const int pv = (wgid % nig) / gsz; gi = pv / tpg; pn = pv - gi * tpg;
        }
        u.pm = pm; u.pn = pn; u.gi = gi;
        return ok;
    }
    __device__ __forceinline__ void a_ready(const Unit& u) const {
        if (mode != 2) return;
        if (threadIdx.x < 64) {
            unsigned spins = 0;
            while ((unsigned)__builtin_amdgcn_readfirstlane(__hip_atomic_load(ready + 64 * u.pm, __ATOMIC_RELAXED, __HIP_MEMORY_SCOPE_AGENT)) < 128u) {
                __builtin_amdgcn_s_sleep(2); if (++spins > (1u << 24)) break; }
            __builtin_amdgcn_fence(__ATOMIC_ACQUIRE, "agent");
            asm volatile("s_waitcnt vmcnt(0)" ::: "memory");
        }
        asm volatile("" ::: "memory"); __builtin_amdgcn_s_barrier(); asm volatile("" ::: "memory");
    }
    __device__ __forceinline__ void done(const Unit& u) const {
        if (mode != 1) return;
        asm volatile("s_waitcnt vmcnt(0)" ::: "memory");
        if ((threadIdx.x & 63) == 0) __hip_atomic_fetch_add(ready + 64 * u.pm, 1u, __ATOMIC_RELAXED, __HIP_MEMORY_SCOPE_AGENT);
    }
};

template <class Epi>
__device__ __forceinline__ void gemm_phase(LAS unsigned char* lds, const Sched& S, const Epi& E) {
    const int tid = TIDX(), wid = __builtin_amdgcn_readfirstlane(tid >> 6), lane = tid & 63, wr = wid >> 2, wc = wid & 3, fr = lane & 15, fq = lane >> 4;
    const int K = S.K, nt = K / BK;
    unsigned voffA[2], voffB[2];
#pragma unroll
    for (int i = 0; i < 2; ++i) { int R, C; stage_rc(tid * 16 + i * 8192, R, C); const int Rb = Epi::PERM ? ((R & ~31) + perm32(R & 31)) : R;
        voffA[i] = (unsigned)(R * K + C) * 2u; voffB[i] = (unsigned)(Rb * K + C) * 2u; }
    const size_t kstep = (size_t)(BK * 2);
    const size_t hstep = (size_t)HALF * K * 2;
    const size_t tstep = 2 * hstep;
    const unsigned ldsw = (unsigned)wid * 1024u;
    const int aoff = lds_byte(wr * 64 + fr, fq * 8), boff = lds_byte(wc * 32 + fr, fq * 8);
#define PG8_SA(b, h) (((b) * 2 + (h)) * HTB)
#define PG8_SB(b, h) ((4 + (b) * 2 + (h)) * HTB)
#define PG8_STAGE(bufoff, gbase, voff) do { _Pragma("unroll") for (int _i = 0; _i < 2; ++_i) \
        __builtin_amdgcn_global_load_lds((const unsigned*)((const char*)(gbase) + (voff)[_i]), (LAS unsigned*)(lds + (bufoff) + ldsw + _i * 8192), 16, 0, 0); } while (0)
#define PG8_LDA(dst, b, h) do { _Pragma("unroll") for (int m = 0; m < 4; ++m) _Pragma("unroll") for (int k = 0; k < 2; ++k) dst[m][k] = *(const LAS bf16x8*)(lds + PG8_SA(b, h) + aoff + m * 2048 + k * 1024); } while (0)
#define PG8_LDB(dst, b, h) do { _Pragma("unroll") for (int n = 0; n < 2; ++n) _Pragma("unroll") for (int k = 0; k < 2; ++k) dst[n][k] = *(const LAS bf16x8*)(lds + PG8_SB(b, h) + boff + n * 2048 + k * 1024); } while (0)
#define PG8_MMA(ai, bj, At, Bt) do { __builtin_amdgcn_s_setprio(1); _Pragma("unroll") for (int m = 0; m < 4; ++m) _Pragma("unroll") for (int n = 0; n < 2; ++n) _Pragma("unroll") for (int k = 0; k < 2; ++k) \
        acc[ai][bj][m][n] = __builtin_amdgcn_mfma_f32_16x16x32_bf16(Bt[n][k], At[m][k], acc[ai][bj][m][n], 0, 0, 0); __builtin_amdgcn_s_setprio(0); } while (0)
#define PG8_WAIT_V(n) asm volatile("s_waitcnt vmcnt(" #n ")" ::: "memory")
#define PG8_WAIT_L(n) asm volatile("s_waitcnt lgkmcnt(" #n ")" ::: "memory")
#define PG8_BAR __builtin_amdgcn_s_barrier()
#define PG8_SCHED __builtin_amdgcn_sched_barrier(0)
    Unit cur, nxt; int ui = 0;
    if (!S.next(0, cur)) return;
    f32x4 acc[2][2][4][2];
#pragma unroll
    for (int a = 0; a < 2; ++a)
#pragma unroll
        for (int b = 0; b < 2; ++b)
#pragma unroll
            for (int m = 0; m < 4; ++m)
#pragma unroll
                for (int n = 0; n < 2; ++n) acc[a][b][m][n] = (f32x4){0.f, 0.f, 0.f, 0.f};
    bf16x8 At[4][2], B0[2][2], B1[2][2];
    const char* cA = S.A + (size_t)cur.gi * S.strideA + (size_t)cur.pm * tstep; const char* cB = S.Bt + (size_t)cur.gi * S.strideB + (size_t)cur.pn * tstep;
    S.a_ready(cur);
    PG8_STAGE(PG8_SB(0, 0), cB, voffB); PG8_STAGE(PG8_SA(0, 0), cA, voffA); PG8_STAGE(PG8_SB(0, 1), cB + hstep, voffB); PG8_STAGE(PG8_SA(0, 1), cA + hstep, voffA);
    if (wr == 1) PG8_BAR;
    PG8_WAIT_V(4); PG8_BAR;
    PG8_STAGE(PG8_SB(1, 0), cB + kstep, voffB); PG8_STAGE(PG8_SA(1, 0), cA + kstep, voffA); PG8_STAGE(PG8_SB(1, 1), cB + hstep + kstep, voffB);
    PG8_WAIT_V(6); PG8_BAR;
    for (;;) {
        const bool has_next = S.next(ui + 1, nxt);
        const char* nA = has_next ? S.A + (size_t)nxt.gi * S.strideA + (size_t)nxt.pm * tstep : cA; const char* nB = has_next ? S.Bt + (size_t)nxt.gi * S.strideB + (size_t)nxt.pn * tstep : cB;
        for (int t = 0; t < nt; t += 2) {
            const bool last = (t == nt - 2);
            const char* a1 = cA + (size_t)(t + 1) * kstep;
            const char* a2 = last ? nA : cA + (size_t)(t + 2) * kstep; const char* b2 = last ? nB : cB + (size_t)(t + 2) * kstep;
            const char* a3 = a2 + kstep; const char* b3 = b2 + kstep;
            if (last && has_next) S.a_ready(nxt);
            PG8_LDB(B0, 0, 0); PG8_SCHED; PG8_LDA(At, 0, 0); PG8_STAGE(PG8_SA(1, 1), a1 + hstep, voffA);
            PG8_WAIT_L(8); PG8_BAR; PG8_WAIT_L(0); PG8_MMA(0, 0, At, B0); PG8_BAR; PG8_SCHED;
            PG8_LDB(B1, 0, 1); PG8_STAGE(PG8_SB(0, 0), b2, voffB);
            PG8_BAR; PG8_WAIT_L(0); PG8_MMA(0, 1, At, B1); PG8_BAR;
            PG8_LDA(At, 0, 1); PG8_STAGE(PG8_SA(0, 0), a2, voffA);
            PG8_BAR; PG8_WAIT_L(0); PG8_MMA(1, 0, At, B0); PG8_BAR; PG8_SCHED;
            PG8_STAGE(PG8_SB(0, 1), b2 + hstep, voffB);
            PG8_WAIT_V(6); PG8_BAR; PG8_MMA(1, 1, At, B1); PG8_BAR;
            PG8_LDB(B0, 1, 0); PG8_SCHED; PG8_LDA(At, 1, 0); PG8_STAGE(PG8_SA(0, 1), a2 + hstep, voffA);
            PG8_WAIT_L(8); PG8_BAR; PG8_WAIT_L(0); PG8_MMA(0, 0, At, B0); PG8_BAR; PG8_SCHED;
            PG8_LDB(B1, 1, 1); PG8_STAGE(PG8_SB(1, 0), b3, voffB);
            PG8_BAR; PG8_WAIT_L(0); PG8_MMA(0, 1, At, B1); PG8_BAR;
            PG8_LDA(At, 1, 1); PG8_STAGE(PG8_SA(1, 0), a3, voffA);
            PG8_BAR; PG8_WAIT_L(0); PG8_MMA(1, 0, At, B0); PG8_BAR; PG8_SCHED;
            PG8_STAGE(PG8_SB(1, 1), b3 + hstep, voffB);
            PG8_WAIT_V(6); PG8_BAR; PG8_MMA(1, 1, At, B1); PG8_BAR;
        }
        E(acc, cur, wr, wc, fr, fq); S.done(cur);
        if (!has_next) break;
#pragma unroll
        for (int a = 0; a < 2; ++a)
#pragma unroll
            for (int b = 0; b < 2; ++b)
#pragma unroll
                for (int m = 0; m < 4; ++m)
#pragma unroll
                    for (int n = 0; n < 2; ++n) acc[a][b][m][n] = (f32x4){0.f, 0.f, 0.f, 0.f};
        cur = nxt; cA = nA; cB = nB; ++ui;
    }
    PG8_WAIT_V(0);
    if (wr == 0) PG8_BAR;
    PG8_BAR;
#undef PG8_SA
#undef PG8_SB
#undef PG8_STAGE
#undef PG8_LDA
#undef PG8_LDB
#undef PG8_MMA
#undef PG8_WAIT_V
#undef PG8_WAIT_L
#undef PG8_BAR
#undef PG8_SCHED
}
}

typedef f32x4 Acc[2][2][4][2];

struct EpiRes {
    static constexpr bool PERM = true;
    const float* src_lo; const float* src_hi; float* dst; const float* modl; int goff; int dry;
    __device__ __forceinline__ void operator()(const Acc& acc, const pg8::Unit& u, int wr, int wc, int fr, int fq) const {
        const int row0 = u.pm * 256 + wr * 64 + fr, col0 = u.pn * 256 + wc * 32 + 8 * fq;
        const int crow = u.pm < 16 ? 0 : 1 + ((u.pm - 16) >> 3);
        const float* gp = modl + crow * 6144 + goff + col0;
        f32x4 gv[2][2];
#pragma unroll
        for (int bj = 0; bj < 2; ++bj)
#pragma unroll
            for (int n = 0; n < 2; ++n) gv[bj][n] = *(const f32x4*)(gp + bj * 128 + n * 4);
        const float* sb = (u.pm < 16 ? src_lo : src_hi);
#pragma unroll
        for (int ai = 0; ai < 2; ++ai)
#pragma unroll
            for (int m = 0; m < 4; ++m) {
                const size_t ro = (size_t)(row0 + ai * 128 + m * 16) * D + col0;
                f32x4 xv[2][2];
#pragma unroll
                for (int bj = 0; bj < 2; ++bj)
#pragma unroll
                    for (int n = 0; n < 2; ++n) xv[bj][n] = *(const f32x4*)(sb + ro + bj * 128 + n * 4);
#pragma unroll
                for (int bj = 0; bj < 2; ++bj)
#pragma unroll
                    for (int n = 0; n < 2; ++n) if (!dry) *(f32x4*)(dst + ro + bj * 128 + n * 4) = xv[bj][n] + gv[bj][n] * acc[ai][bj][m][n];
            }
    }
};
template <int ACT> struct EpiBf16 {
    static constexpr bool PERM = true;
    bf16_t* o0; bf16_t* o1; bf16_t* o2; int ldc; int wt;
    __device__ __forceinline__ void operator()(const Acc& acc, const pg8::Unit& u, int wr, int wc, int fr, int fq) const {
        const int row0 = u.pm * 256 + wr * 64 + fr, col0 = u.pn * 256 + wc * 32 + 8 * fq;
        bf16_t* base = u.gi == 0 ? o0 : (u.gi == 1 ? o1 : o2);
#pragma unroll
        for (int ai = 0; ai < 2; ++ai)
#pragma unroll
            for (int m = 0; m < 4; ++m) {
                bf16_t* rowp = base + (size_t)(row0 + ai * 128 + m * 16) * ldc + col0;
#pragma unroll
                for (int bj = 0; bj < 2; ++bj) {
                    f32x4 v0 = acc[ai][bj][m][0], v1 = acc[ai][bj][m][1];
                    if (ACT == 1) {
#pragma unroll
                        for (int j = 0; j < 4; ++j) { float a = fmaxf(v0[j], 0.f), b = fmaxf(v1[j], 0.f); v0[j] = a * a; v1[j] = b * b; }
                    }
                    u32x4 w; w.x = cvt_pk_bf16(v0[0], v0[1]); w.y = cvt_pk_bf16(v0[2], v0[3]); w.z = cvt_pk_bf16(v1[0], v1[1]); w.w = cvt_pk_bf16(v1[2], v1[3]);
                    if (wt) asm volatile("global_store_dwordx4 %0, %1, off sc0 sc1\n\ts_nop 1" :: "v"(rowp + bj * 128), "v"(w) : "memory");
                    else *(u32x4*)(rowp + bj * 128) = w;
                }
            }
    }
};
struct EpiGeluUV {
    static constexpr bool PERM = true;
    bf16_t* U; bf16_t* V; float* vst;
    __device__ __forceinline__ void operator()(const Acc& acc, const pg8::Unit& u, int wr, int wc, int fr, int fq) const {
        const int row0 = u.pm * 256 + wr * 64 + fr;
        const bool isv = u.pn >= 4;
        const int col0 = (u.pn & 3) * 256 + wc * 32 + 8 * fq;
        bf16_t* base = isv ? V : U;
#pragma unroll
        for (int ai = 0; ai < 2; ++ai)
#pragma unroll
            for (int m = 0; m < 4; ++m) {
                const int row = row0 + ai * 128 + m * 16;
                bf16_t* rowp = base + (size_t)row * D + col0;
                float s1 = 0.f, s2 = 0.f;
#pragma unroll
                for (int bj = 0; bj < 2; ++bj) {
                    f32x4 v0 = acc[ai][bj][m][0], v1 = acc[ai][bj][m][1];
#pragma unroll
                    for (int j = 0; j < 4; ++j) { v0[j] = gelu_tanh(v0[j]); v1[j] = gelu_tanh(v1[j]); s1 += v0[j] + v1[j]; s2 += v0[j] * v0[j] + v1[j] * v1[j]; }
                    u32x4 w; w.x = cvt_pk_bf16(v0[0], v0[1]); w.y = cvt_pk_bf16(v0[2], v0[3]); w.z = cvt_pk_bf16(v1[0], v1[1]); w.w = cvt_pk_bf16(v1[2], v1[3]);
                    *(u32x4*)(rowp + bj * 128) = w;
                }
                if (isv) {
                    s1 += __shfl_xor(s1, 16); s1 += __shfl_xor(s1, 32);
                    s2 += __shfl_xor(s2, 16); s2 += __shfl_xor(s2, 32);
                    if (fq == 0) *(f32x2*)(vst + ((size_t)row * 16 + (u.pn - 4) * 4 + wc) * 2) = (f32x2){s1, s2};
                }
            }
    }
};

__device__ void wconv_tiled(const float* __restrict__ src, int K, int N, bf16_t* dst, int ldd, LAS float* tile, int bid, int G) {
    const int tid = TIDX(); const int tn = N / 64, ntiles = (K / 64) * tn;
    for (int t = bid; t < ntiles; t += G) {
        const int k0 = (t / tn) * 64, n0 = (t % tn) * 64;
#pragma unroll
        for (int i = 0; i < 8; ++i) { const int idx = tid + 512 * i, kk = idx >> 6, nn = idx & 63; tile[kk * 65 + nn] = src[(size_t)(k0 + kk) * N + n0 + nn]; }
        __syncthreads();
        { const int n = tid >> 3, kc = tid & 7; float v[8];
#pragma unroll
          for (int j = 0; j < 8; ++j) v[j] = tile[(kc * 8 + j) * 65 + n];
          u32x4 w; w.x = cvt_pk_bf16(v[0], v[1]); w.y = cvt_pk_bf16(v[2], v[3]); w.z = cvt_pk_bf16(v[4], v[5]); w.w = cvt_pk_bf16(v[6], v[7]);
          *(u32x4*)(dst + (size_t)(n0 + n) * ldd + k0 + kc * 8) = w; }
        __syncthreads();
    }
}
__device__ void wconv_tiled256(const float* __restrict__ src, int K, int N, bf16_t* dst, int ldd, LAS float* tile, int bid, int G) {
    const int tid = TIDX(); const int tn = N / 256, ntiles = (K / 64) * tn;
    const int lane = tid & 63, wave = tid >> 6;
    for (int t = bid; t < ntiles; t += G) {
        const int k0 = (t / tn) * 64, n0 = (t % tn) * 256;
        f32x4 v[8];
#pragma unroll
        for (int i = 0; i < 8; ++i) { const int idx = tid + 512 * i, kk = idx >> 6, n4 = idx & 63; v[i] = *(const f32x4*)(src + (size_t)(k0 + kk) * N + n0 + n4 * 4); }
#pragma unroll
        for (int i = 0; i < 8; ++i) { const int idx = tid + 512 * i, kk = idx >> 6, n4 = idx & 63; *(LAS f32x4*)(tile + kk * 260 + n4 * 4) = v[i]; }
        __syncthreads();
        { const int n = lane + 64 * (wave & 3);
#pragma unroll
          for (int q = 0; q < 4; ++q) { const int kc = 4 * (wave >> 2) + q; float x[8];
#pragma unroll
            for (int j = 0; j < 8; ++j) x[j] = tile[(kc * 8 + j) * 260 + n];
            u32x4 w; w.x = cvt_pk_bf16(x[0], x[1]); w.y = cvt_pk_bf16(x[2], x[3]); w.z = cvt_pk_bf16(x[4], x[5]); w.w = cvt_pk_bf16(x[6], x[7]);
            *(u32x4*)(dst + (size_t)(n0 + n) * ldd + k0 + kc * 8) = w; } }
        __syncthreads();
    }
}
__device__ void wconv_tiled_frag(const float* __restrict__ src, int N, bf16_t* dst, int nrow0, LAS float* tile, int bid, int G) {
    const int tid = TIDX(); const int tn = N / 64, ntiles = 16 * tn;
    for (int t = bid; t < ntiles; t += G) {
        const int k0 = (t / tn) * 64, n0 = (t % tn) * 64;
#pragma unroll
        for (int i = 0; i < 8; ++i) { const int idx = tid + 512 * i, kk = idx >> 6, nn = idx & 63; tile[kk * 65 + nn] = src[(size_t)(k0 + kk) * N + n0 + nn]; }
        __syncthreads();
        { const int n = tid >> 3, kc = tid & 7; float v[8];
#pragma unroll
          for (int j = 0; j < 8; ++j) v[j] = tile[(kc * 8 + j) * 65 + n];
          u32x4 w; w.x = cvt_pk_bf16(v[0], v[1]); w.y = cvt_pk_bf16(v[2], v[3]); w.z = cvt_pk_bf16(v[4], v[5]); w.w = cvt_pk_bf16(v[6], v[7]);
          const int na = nrow0 + n0 + n, k = k0 + kc * 8;
          *(u32x4*)(dst + ((size_t)(((na >> 4) * 32 + (k >> 5)) * 64 + ((k >> 3) & 3) * 16 + (na & 15))) * 8) = w; }
        __syncthreads();
    }
}
__device__ void wconv_direct(const float* __restrict__ src, int K, int N, bf16_t* dst) {
    const int gsz = GDIM() * NTHREADS;
    for (int e = BIDX() * NTHREADS + TIDX(); e < K * N; e += gsz) { const int n = e / K, k = e - n * K; dst[e] = f2bf(src[(size_t)k * N + n]); }
}
__device__ void wconv_mlp(KP p, int l, LAS float* tile) {
    const int G = GDIM(), b = BIDX();
    wconv_tiled256(p->in[I_M1] + (size_t)l * D * DFF, D, DFF, (bf16_t*)(p->ws + W_MLP1T), D, tile, b, G);
    wconv_tiled256(p->in[I_M2] + (size_t)l * D * DFF, DFF, D, (bf16_t*)(p->ws + W_MLP2T), DFF, tile, b, G);
}
__device__ void wconv_sgu(KP p, int l, LAS float* tile) {
    const int i = l >> 1, G = GDIM(), b = BIDX();
    wconv_tiled256(p->in[I_SWIN] + (size_t)i * D * 2048, D, 2048, (bf16_t*)(p->ws + W_INT), D, tile, b, G);
    wconv_tiled256(p->in[I_SWOUT] + (size_t)i * D * D, D, D, (bf16_t*)(p->ws + W_OUTT), D, tile, (b + 128) % G, G);
    { const float* s = p->in[I_SWS] + (size_t)i * 16 * 128 * 128; bf16_t* d = (bf16_t*)(p->ws + W_S);
      for (int e = BIDX() * NTHREADS + TIDX(); e < 16 * 128 * 128; e += G * NTHREADS) d[e] = f2bf(s[e]); }
    wconv_mlp(p, l, tile);
}
__device__ void wconv_rwkv_main(KP p, int l, LAS float* tile) {
    const int il = l >> 1, G = GDIM(), b = BIDX();
    wconv_tiled256(p->in[I_WR] + (size_t)il * D * D, D, D, (bf16_t*)(p->ws + W_RT), D, tile, b, G);
    wconv_tiled256(p->in[I_WK] + (size_t)il * D * D, D, D, (bf16_t*)(p->ws + W_KT), D, tile, (b + 64) % G, G);
    wconv_tiled256(p->in[I_WV] + (size_t)il * D * D, D, D, (bf16_t*)(p->ws + W_VT), D, tile, (b + 128) % G, G);
    wconv_tiled256(p->in[I_WO] + (size_t)il * D * D, D, D, (bf16_t*)(p->ws + W_OT), D, tile, (b + 192) % G, G);
    for (int d = 0; d < 2; ++d) {
        wconv_direct(p->in[I_W2] + (size_t)(il * 2 + d) * 64 * D, 64, D, (bf16_t*)(p->ws + W_W2T) + (size_t)d * D * 64);
        wconv_direct(p->in[I_A2] + (size_t)(il * 2 + d) * 64 * D, 64, D, (bf16_t*)(p->ws + W_A2T) + (size_t)d * D * 64);
    }
    if (il == 1) wconv_direct(p->in[I_V2], 32, D, (bf16_t*)(p->ws + W_V2T));
    wconv_direct(p->in[I_G2] + (size_t)il * 128 * D, 128, D, (bf16_t*)(p->ws + W_G2T));
    wconv_mlp(p, l, tile);
}
__device__ void wconv_rwkv_lora_down(KP p, int l, LAS float* tile) {
    const int il = l >> 1, G = GDIM(), b = BIDX();
    bf16_t* ld = (bf16_t*)(p->ws + W_LD);
    for (int d = 0; d < 2; ++d) {
        wconv_tiled_frag(p->in[I_W1] + (size_t)(il * 2 + d) * D * 64, 64, ld, d * 64, tile, (b + d * 16) % G, G);
        wconv_tiled_frag(p->in[I_A1] + (size_t)(il * 2 + d) * D * 64, 64, ld, 128 + d * 64, tile, (b + 32 + d * 16) % G, G);
    }
    wconv_tiled_frag(p->in[I_G1] + (size_t)il * D * 128, 128, ld, 256, tile, (b + 64) % G, G);
    if (il == 1) {
        const float* src = p->in[I_V1];
        for (int e = BIDX() * NTHREADS + TIDX(); e < D * 32; e += G * NTHREADS) { const int k = e >> 5, na = 384 + (e & 31);
            ld[((size_t)(((na >> 4) * 32 + (k >> 5)) * 64 + ((k >> 3) & 3) * 16 + (na & 15))) * 8 + (k & 7)] = f2bf(src[e]); }
    }
}

__device__ void ada_phase(KP p, LAS unsigned char* lds) {
    LAS float* sc = (LAS float*)lds;
    LAS float* red = sc + 9 * 1024;
    const int tid = TIDX(), G = GDIM();
    float* mod = (float*)(p->ws + WS_MOD);
    if ((int)BIDX() < 192) {
        for (int e = tid; e < 9 * 1024; e += NTHREADS) { const int r = e >> 10, k = e & 1023; const float x = r == 0 ? p->in[I_CCTX][k] : p->in[I_C][(r - 1) * 1024 + k]; sc[e] = x * rcpf_(1.0f + __expf(-x)); }
        __syncthreads();
    }
    for (int item = BIDX(); item < 192; item += G) {
        const int l = item / 48, c0 = (item % 48) * 128, col4 = tid & 31, kq = tid >> 5;
        const float* wp = p->in[I_ADAW] + ((size_t)l * 1024 + kq * 64) * 6144 + c0 + col4 * 4;
        f32x4 acc[9];
#pragma unroll
        for (int r = 0; r < 9; ++r) acc[r] = (f32x4){0.f, 0.f, 0.f, 0.f};
#pragma unroll 8
        for (int kk = 0; kk < 64; ++kk) {
            const f32x4 w = *(const f32x4*)(wp + (size_t)kk * 6144);
#pragma unroll
            for (int r = 0; r < 9; ++r) acc[r] += sc[r * 1024 + kq * 64 + kk] * w;
        }
#pragma unroll
        for (int r = 0; r < 9; ++r) *(LAS f32x4*)(red + ((kq * 9 + r) * 128 + col4 * 4)) = acc[r];
        __syncthreads();
        for (int o = tid; o < 9 * 128; o += NTHREADS) {
            const int r = o >> 7, cc = o & 127; float s = p->in[I_ADAB][l * 6144 + c0 + cc];
#pragma unroll
            for (int q = 0; q < 16; ++q) s += red[(q * 9 + r) * 128 + cc];
            mod[(size_t)(l * 9 + r) * 6144 + c0 + cc] = s;
        }
        __syncthreads();
    }
}

__device__ void norm_phase(KP p, int l, int which, bool from_input, bf16_t* H) {
    const int lane = TIDX() & 63, gw = BIDX() * 8 + (TIDX() >> 6), nw = GDIM() * 8;
    const float* g = p->in[which ? I_N2G : I_N1G] + l * D;
    const float* mod = (const float*)(p->ws + WS_MOD);
    for (int row = gw; row < T; row += 4 * nw) {
        f32x4 v[4][4]; int rws[4]; bool has[4];
#pragma unroll
        for (int q = 0; q < 4; ++q) {
            rws[q] = row + q * nw; has[q] = rws[q] < T;
            const float* xp = xrow_ptr(p, from_input, has[q] ? rws[q] : row);
#pragma unroll
            for (int i = 0; i < 4; ++i) v[q][i] = *(const f32x4*)(xp + i * 256 + lane * 4);
        }
#pragma unroll
        for (int q = 0; q < 4; ++q) {
            if (!has[q]) break;
            const int r_ = rws[q];
            const float* md = mod + (size_t)(l * 9 + cond_row(r_)) * 6144 + (which ? 3072 : 0);
            float ss = 0.f;
#pragma unroll
            for (int i = 0; i < 4; ++i) { const f32x4 x = v[q][i]; ss += x[0] * x[0] + x[1] * x[1] + x[2] * x[2] + x[3] * x[3]; }
            ss = wave_sum(ss);
            const float rstd = rsqrtf(ss * (1.0f / 1024.0f) + 1e-6f);
#pragma unroll
            for (int i = 0; i < 4; ++i) {
                const int c = i * 256 + lane * 4;
                const f32x4 gg = *(const f32x4*)(g + c), sh = *(const f32x4*)(md + c), sc = *(const f32x4*)(md + 1024 + c);
                const f32x4 o = v[q][i] * rstd * gg * (1.0f + sc) + sh;
                u32x2 w; w.x = cvt_pk_bf16(o[0], o[1]); w.y = cvt_pk_bf16(o[2], o[3]);
                *(u32x2*)(H + (size_t)r_ * D + c) = w;
            }
        }
    }
}
__device__ void final_norm_phase(KP p) {
    const int lane = TIDX() & 63, gw = BIDX() * 8 + (TIDX() >> 6), nw = GDIM() * 8;
    const float* g = p->in[I_FG];
    f32x4 gv[4];
#pragma unroll
    for (int i = 0; i < 4; ++i) gv[i] = *(const f32x4*)(g + i * 256 + lane * 4);
    for (int row = gw; row < T; row += 4 * nw) {
        f32x4 v[4][4]; bool has[4];
#pragma unroll
        for (int q = 0; q < 4; ++q) {
            has[q] = row + q * nw < T;
            const float* xp = p->out + (size_t)(has[q] ? row + q * nw : row) * D;
#pragma unroll
            for (int i = 0; i < 4; ++i) v[q][i] = *(const f32x4*)(xp + i * 256 + lane * 4);
        }
#pragma unroll
        for (int q = 0; q < 4; ++q) {
            if (!has[q]) break;
            float* xp = p->out + (size_t)(row + q * nw) * D;
            float ss = 0.f;
#pragma unroll
            for (int i = 0; i < 4; ++i) { const f32x4 x = v[q][i]; ss += x[0] * x[0] + x[1] * x[1] + x[2] * x[2] + x[3] * x[3]; }
            ss = wave_sum(ss);
            const float rstd = rsqrtf(ss * (1.0f / 1024.0f) + 1e-6f);
#pragma unroll
            for (int i = 0; i < 4; ++i) *(f32x4*)(xp + i * 256 + lane * 4) = v[q][i] * rstd * gv[i];
        }
    }
}

constexpr int HBS = 1028;
__device__ void rmix_phase(KP p, int l, LAS unsigned char* lds) {
    const int il = l >> 1;
    LAS float* hb = (LAS float*)lds;
    const int tid = TIDX(), lane = tid & 63, wave = tid >> 6, G = GDIM();
    const float* g = p->in[I_N1G] + l * D;
    const float* mu = p->in[I_MU] + (size_t)il * 6 * D;
    const float* mod = (const float*)(p->ws + WS_MOD);
    bf16_t* XR = (bf16_t*)(p->ws + BIG(1)); bf16_t* XK = (bf16_t*)(p->ws + BIG(2)); bf16_t* XV = (bf16_t*)(p->ws + BIG(3));
    const bf16_t* LD = (const bf16_t*)(p->ws + W_LD);
    LAS float* mul = (LAS float*)(lds + 76 * 1024);
    for (int e = tid; e < 6 * 256; e += NTHREADS) *(LAS f32x4*)(mul + 4 * e) = *(const f32x4*)(mu + 4 * e);
    __syncthreads();
#define RMIX_LOADROWS(tile_) do { const int t0_ = (tile_) * 16; \
        const int s0_ = t0_ < TC ? (t0_ & ~255) : TC + ((t0_ - TC) & ~2047), L_ = t0_ < TC ? 256 : 2048; \
        _Pragma("unroll") for (int ri = 0; ri < 3; ++ri) { \
            const int r = wave + 8 * ri, t = t0_ - 1 + r; \
            ok[ri] = (r < 18) && (t >= s0_) && (t < s0_ + L_); \
            if (ok[ri]) { const float* xp = p->out + (size_t)t * D; \
                _Pragma("unroll") for (int i = 0; i < 4; ++i) v[ri][i] = *(const f32x4*)(xp + i * 256 + lane * 4); } \
            else { _Pragma("unroll") for (int i = 0; i < 4; ++i) v[ri][i] = (f32x4){0.f, 0.f, 0.f, 0.f}; } } } while (0)
    f32x4 v[3][4]; bool ok[3];
    if (BIDX() < T / 16) RMIX_LOADROWS(BIDX());
    for (int tile = BIDX(); tile < T / 16; tile += G) {
        const int t0 = tile * 16;
        const float* md = mod + (size_t)(l * 9 + cond_row(t0)) * 6144;
        {
#pragma unroll
            for (int ri = 0; ri < 3; ++ri) {
                const int r = wave + 8 * ri;
                if (r < 18) {
                    float ss = 0.f;
#pragma unroll
                    for (int i = 0; i < 4; ++i) ss += v[ri][i][0] * v[ri][i][0] + v[ri][i][1] * v[ri][i][1] + v[ri][i][2] * v[ri][i][2] + v[ri][i][3] * v[ri][i][3];
                    ss = wave_sum(ss);
                    const float rstd = rsqrtf(ss * (1.0f / 1024.0f) + 1e-6f);
#pragma unroll
                    for (int i = 0; i < 4; ++i) {
                        const int c = i * 256 + lane * 4;
                        const f32x4 gg = *(const f32x4*)(g + c), sh = *(const f32x4*)(md + c), sc = *(const f32x4*)(md + 1024 + c);
                        *(LAS f32x4*)(hb + r * HBS + c) = ok[ri] ? (v[ri][i] * rstd * gg * (1.0f + sc) + sh) : (f32x4){0.f, 0.f, 0.f, 0.f};
                    }
                }
            }
        }
        __syncthreads();
        {
            const int row = tid >> 5, q = tid & 31;
#pragma unroll
            for (int pc = 0; pc < 4; ++pc) {
                const int c = pc * 256 + q * 8;
                f32x4 hp[2], hc[2], hn[2], xx[2];
#pragma unroll
                for (int e = 0; e < 2; ++e) { hp[e] = *(const LAS f32x4*)(hb + row * HBS + c + 4 * e); hc[e] = *(const LAS f32x4*)(hb + (row + 1) * HBS + c + 4 * e); hn[e] = *(const LAS f32x4*)(hb + (row + 2) * HBS + c + 4 * e);
                    xx[e] = 0.5f * (hp[e] + hn[e]) - hc[e]; }
                const size_t off = (size_t)(t0 + row) * D + c;
#pragma unroll
                for (int jj = 0; jj < 3; ++jj) {
                    const int j = jj == 0 ? 0 : (jj == 1 ? 2 : 3);
                    const f32x4 m0 = *(const LAS f32x4*)(mul + j * D + c), m1 = *(const LAS f32x4*)(mul + j * D + c + 4);
                    const f32x4 o0 = hc[0] + xx[0] * m0, o1 = hc[1] + xx[1] * m1;
                    u32x4 w; w.x = cvt_pk_bf16(o0[0], o0[1]); w.y = cvt_pk_bf16(o0[2], o0[3]); w.z = cvt_pk_bf16(o1[0], o1[1]); w.w = cvt_pk_bf16(o1[2], o1[3]);
                    bf16_t* dst = jj == 0 ? XR : (jj == 1 ? XK : XV);
                    *(u32x4*)(dst + off) = w;
                }
            }
        }
        if (tile + G < T / 16) RMIX_LOADROWS(tile + G);
        if (wave < 6 || (wave == 6 && il == 1)) {
            int jmu, nrow0, ntl, act, ldo, oc0; bf16_t* outp;
            if (wave < 2) { jmu = 1; nrow0 = wave * 64; ntl = 4; act = 1; outp = (bf16_t*)(p->ws + WS_TW); ldo = 128; oc0 = wave * 64; }
            else if (wave < 4) { jmu = 4; nrow0 = 128 + (wave - 2) * 64; ntl = 4; act = 0; outp = (bf16_t*)(p->ws + WS_A1O); ldo = 128; oc0 = (wave - 2) * 64; }
            else if (wave < 6) { jmu = 5; nrow0 = 256 + (wave - 4) * 64; ntl = 4; act = 2; outp = (bf16_t*)(p->ws + WS_SG); ldo = 128; oc0 = (wave - 4) * 64; }
            else { jmu = 3; nrow0 = 384; ntl = 2; act = 0; outp = (bf16_t*)(p->ws + WS_V1O); ldo = 32; oc0 = 0; }
            const int tok = lane & 15, kg = lane >> 4;
            f32x4 acc[4];
#pragma unroll
            for (int n = 0; n < 4; ++n) acc[n] = (f32x4){0.f, 0.f, 0.f, 0.f};
            const LAS float* mup = mul + jmu * D;
            for (int ks0 = 0; ks0 < 32; ks0 += 4) {
                bf16x8 af[4][4];
#pragma unroll
                for (int kk = 0; kk < 4; ++kk)
#pragma unroll
                    for (int n = 0; n < 4; ++n) if (n < ntl) af[kk][n] = *(const bf16x8*)(LD + ((size_t)(((nrow0 >> 4) + n) * 32 + ks0 + kk) * 64 + lane) * 8);
#pragma unroll
                for (int kk = 0; kk < 4; ++kk) {
                    const int k = (ks0 + kk) * 32 + kg * 8;
                    float xm[8];
#pragma unroll
                    for (int e = 0; e < 2; ++e) {
                        const f32x4 hp = *(const LAS f32x4*)(hb + tok * HBS + k + 4 * e), hc = *(const LAS f32x4*)(hb + (tok + 1) * HBS + k + 4 * e), hn = *(const LAS f32x4*)(hb + (tok + 2) * HBS + k + 4 * e);
                        const f32x4 m = *(const LAS f32x4*)(mup + k + 4 * e);
                        const f32x4 o = hc + (0.5f * (hp + hn) - hc) * m;
                        xm[4 * e] = o[0]; xm[4 * e + 1] = o[1]; xm[4 * e + 2] = o[2]; xm[4 * e + 3] = o[3];
                    }
                    u32x4 bw; bw.x = cvt_pk_bf16(xm[0], xm[1]); bw.y = cvt_pk_bf16(xm[2], xm[3]); bw.z = cvt_pk_bf16(xm[4], xm[5]); bw.w = cvt_pk_bf16(xm[6], xm[7]);
                    const bf16x8 bfrag = __builtin_bit_cast(bf16x8, bw);
#pragma unroll
                    for (int n = 0; n < 4; ++n) if (n < ntl) acc[n] = __builtin_amdgcn_mfma_f32_16x16x32_bf16(af[kk][n], bfrag, acc[n], 0, 0, 0);
                }
            }
#pragma unroll
            for (int n = 0; n < 4; ++n) if (n < ntl) {
                f32x4 v = acc[n];
#pragma unroll
                for (int j = 0; j < 4; ++j) v[j] = act == 1 ? tanhf_(v[j]) : (act == 2 ? sigmoidf_(v[j]) : v[j]);
                u32x2 w; w.x = cvt_pk_bf16(v[0], v[1]); w.y = cvt_pk_bf16(v[2], v[3]);
                *(u32x2*)(outp + (size_t)(t0 + tok) * ldo + oc0 + n * 16 + kg * 4) = w;
            }
        }
        __syncthreads();
    }
}

__device__ void sgu_mix_phase(KP p, int l, LAS unsigned char* lds) {
    const int i = l >> 1;
    LAS bf16_t* vt = (LAS bf16_t*)lds;
    const int tid = TIDX(), lane = tid & 63, wave = tid >> 6, G = GDIM();
    const float* lng = p->in[I_SLNG] + i * D; const float* lnb = p->in[I_SLNB] + i * D; const float* bs = p->in[I_SBS] + i * 16 * 128;
    const float* vst = (const float*)(p->ws + WS_VST);
    const bf16_t* U = (const bf16_t*)(p->ws + BIG(2)); const bf16_t* V = (const bf16_t*)(p->ws + BIG(3)); bf16_t* UV = (bf16_t*)(p->ws + BIG(4));
    const bf16_t* WS = (const bf16_t*)(p->ws + W_S);
    const int g = BIDX() & 15;
    f32x4 lgr[4], lbr[4];
    { const int c0 = 64 * g + (tid & 3) * 16;
#pragma unroll
      for (int e = 0; e < 4; ++e) { lgr[e] = *(const f32x4*)(lng + c0 + 4 * e); lbr[e] = *(const f32x4*)(lnb + c0 + 4 * e); } }
    bf16x8 wfr[4];
#pragma unroll
    for (int ks = 0; ks < 4; ++ks) wfr[ks] = *(const bf16x8*)(WS + ((size_t)g * 128 + wave * 16 + (lane & 15)) * 128 + ks * 32 + (lane >> 4) * 8);
    for (int ch = (BIDX() < (G & ~15)) ? (BIDX() >> 4) : T; ch < T / 128; ch += (G >> 4)) {
        {
            const int s = tid >> 2, q = tid & 3, tok = ch * 128 + s, c0 = 64 * g + q * 16;
            float a1, a2;
            { const f32x4 p0 = *(const f32x4*)(vst + (size_t)tok * 32 + 8 * q), p1 = *(const f32x4*)(vst + (size_t)tok * 32 + 8 * q + 4);
              a1 = (p0[0] + p0[2]) + (p1[0] + p1[2]); a2 = (p0[1] + p0[3]) + (p1[1] + p1[3]);
              a1 += dpp_f<0xB1>(a1); a1 += dpp_f<0x4E>(a1); a2 += dpp_f<0xB1>(a2); a2 += dpp_f<0x4E>(a2); }
            const float m1 = a1 * (1.0f / 1024.0f), m2 = a2 * (1.0f / 1024.0f);
            const float rstd = rsqrtf(fmaxf(m2 - m1 * m1, 0.f) + 1e-6f);
            const u32x4 a = *(const u32x4*)(V + (size_t)tok * D + c0), b = *(const u32x4*)(V + (size_t)tok * D + c0 + 8);
            const unsigned wv[8] = {a.x, a.y, a.z, a.w, b.x, b.y, b.z, b.w};
#pragma unroll
            for (int e = 0; e < 8; ++e) {
                const float x0 = (bflo(wv[e]) - m1) * rstd * lgr[e >> 1][(2 * e) & 3] + lbr[e >> 1][(2 * e) & 3], x1 = (bfhi(wv[e]) - m1) * rstd * lgr[e >> 1][(2 * e + 1) & 3] + lbr[e >> 1][(2 * e + 1) & 3];
                vt[(q * 16 + 2 * e) * 136 + (s ^ (q << 3))] = f2bf(x0); vt[(q * 16 + 2 * e + 1) * 136 + (s ^ (q << 3))] = f2bf(x1);
            }
        }
        __syncthreads();
        {
            const int tl = lane & 15, kg = lane >> 4, tt = wave * 16 + tl;
            f32x4 acc[4];
#pragma unroll
            for (int n = 0; n < 4; ++n) acc[n] = (f32x4){0.f, 0.f, 0.f, 0.f};
#pragma unroll
            for (int ks = 0; ks < 4; ++ks) {
                const bf16x8 bfrag = wfr[ks];
#pragma unroll
                for (int n = 0; n < 4; ++n) {
                    const bf16x8 afrag = *(const LAS bf16x8*)(vt + (n * 16 + tl) * 136 + ((ks * 32 + kg * 8) ^ (n << 3)));
                    acc[n] = __builtin_amdgcn_mfma_f32_16x16x32_bf16(afrag, bfrag, acc[n], 0, 0, 0);
                }
            }
            const int tok = ch * 128 + tt; const float bb = bs[g * 128 + tt];
#pragma unroll
            for (int n = 0; n < 4; ++n) {
                const int c = 64 * g + n * 16 + kg * 4;
                const u32x2 uu = *(const u32x2*)(U + (size_t)tok * D + c);
                const float o0 = (acc[n][0] + bb) * bflo(uu.x), o1 = (acc[n][1] + bb) * bfhi(uu.x), o2 = (acc[n][2] + bb) * bflo(uu.y), o3 = (acc[n][3] + bb) * bfhi(uu.y);
                u32x2 w; w.x = cvt_pk_bf16(o0, o1); w.y = cvt_pk_bf16(o2, o3);
                *(u32x2*)(UV + (size_t)tok * D + c) = w;
            }
        }
        __syncthreads();
    }
}

constexpr int STS = 388;
constexpr int SCAN_HALF_BYTES = (2 * 16 * STS + 2 * 16 * 64) * 4;
#define SVX_GLOAD_A(P, tok0_, L_, d_, h_, chunk) do { const int tt_ = (chunk) * 16 + ts, t_ = (tok0_) + ((d_) ? (L_) - 1 - tt_ : tt_); \
    const unsigned hb_ = (unsigned)(t_ * D + (h_) * 64) * 2u; \
    P##k0 = *(const u32x2*)(wsb + (unsigned)(BIG(5) + hb_ + 8 * kgrp)); P##k1 = *(const u32x2*)(wsb + (unsigned)(BIG(5) + hb_ + 32 + 8 * kgrp)); \
    P##k2 = *(const u32x2*)(wsb + (unsigned)(BIG(5) + hb_ + 64 + 8 * kgrp)); P##k3 = *(const u32x2*)(wsb + (unsigned)(BIG(5) + hb_ + 96 + 8 * kgrp)); \
    P##r = *(const u32x2*)(wsb + (unsigned)(BIG(4) + hb_ + 2 * cown)); P##v = *(const u32x2*)(wsb + (unsigned)(vboff + hb_ + 2 * cown)); \
    if (il == 1) P##vf = *(const u32x2*)(wsb + (unsigned)(BIG(0) + hb_ + 2 * cown)); } while (0)
#define SVX_GLOAD_B(P, tok0_, L_, d_, h_, chunk) do { const int tt_ = (chunk) * 16 + ts, t_ = (tok0_) + ((d_) ? (L_) - 1 - tt_ : tt_); \
    const unsigned lo_ = (unsigned)(t_ * 128 + (d_) * 64 + kgrp * 8) * 2u; \
    P##tw0 = *(const bf16x8*)(wsb + (unsigned)(WS_TW + lo_)); P##tw1 = *(const bf16x8*)(wsb + (unsigned)(WS_TW + lo_ + 64)); \
    P##a0 = *(const bf16x8*)(wsb + (unsigned)(WS_A1O + lo_)); P##a1 = *(const bf16x8*)(wsb + (unsigned)(WS_A1O + lo_ + 64)); \
    if (il == 1) P##v1 = *(const bf16x8*)(wsb + (unsigned)(WS_V1O + (unsigned)(t_ * 32 + kgrp * 8) * 2u)); } while (0)
#define SVX_GLOAD(P, tok0_, L_, d_, h_, chunk) do { SVX_GLOAD_A(P, tok0_, L_, d_, h_, chunk); SVX_GLOAD_B(P, tok0_, L_, d_, h_, chunk); } while (0)
#define SVX_CONSTS(d_, h_) \
    const int ch_ = (h_) * 64 + cown; \
    const unsigned wrow_ = (unsigned)((d_) * D * 64 + ((h_) * 64 + 16 * hw + ts) * 64 + kgrp * 8) * 2u; \
    const bf16x8 wz0 = *(const bf16x8*)(wsb + (unsigned)(W_W2T + wrow_)), wz1 = *(const bf16x8*)(wsb + (unsigned)(W_W2T + wrow_ + 64)); \
    const bf16x8 wa0 = *(const bf16x8*)(wsb + (unsigned)(W_A2T + wrow_)), wa1 = *(const bf16x8*)(wsb + (unsigned)(W_A2T + wrow_ + 64)); \
    bf16x8 wv = wz0; f32x4 v0c = (f32x4){0.f, 0.f, 0.f, 0.f}; \
    if (il == 1) { wv = *(const bf16x8*)(wsb + (unsigned)(W_V2T + (unsigned)(((h_) * 64 + 16 * hw + ts) * 32 + kgrp * 8) * 2u)); v0c = *(const f32x4*)(p->in[I_V0] + ch_); } \
    const f32x4 w0c = *(const f32x4*)(p->in[I_W0] + (size_t)(il * 2 + (d_)) * D + ch_), a0c = *(const f32x4*)(p->in[I_A0] + (size_t)(il * 2 + (d_)) * D + ch_); \
    const f32x4 kac = *(const f32x4*)(p->in[I_KA] + il * D + ch_), rkc = *(const f32x4*)(p->in[I_RK] + il * D + ch_); \
    const float* kkp_ = p->in[I_KK] + il * D + (h_) * 64 + 4 * kgrp;
#define SVX_STAGE(P, tok0_, L_, d_, h_, chunk, stg_, bufi) do { const int tt_ = (chunk) * 16 + ts, t_ = (tok0_) + ((d_) ? (L_) - 1 - tt_ : tt_); \
    f32x4 accz = (f32x4){0.f, 0.f, 0.f, 0.f}, acca = accz; \
    accz = __builtin_amdgcn_mfma_f32_16x16x32_bf16(wz0, P##tw0, accz, 0, 0, 0); accz = __builtin_amdgcn_mfma_f32_16x16x32_bf16(wz1, P##tw1, accz, 0, 0, 0); \
    acca = __builtin_amdgcn_mfma_f32_16x16x32_bf16(wa0, P##a0, acca, 0, 0, 0); acca = __builtin_amdgcn_mfma_f32_16x16x32_bf16(wa1, P##a1, acca, 0, 0, 0); \
    f32x4 kf, kx, sq; \
    { const f32x4 kq_ = (f32x4){bflo(P##k0.x), bfhi(P##k0.x), bflo(P##k0.y), bfhi(P##k0.y)}; const f32x4 xq_ = kq_ * *(const f32x4*)(kkp_); sq = xq_ * xq_; kf = kq_; kx = xq_; } \
    { const f32x4 kq_ = (f32x4){bflo(P##k1.x), bfhi(P##k1.x), bflo(P##k1.y), bfhi(P##k1.y)}; const f32x4 xq_ = kq_ * *(const f32x4*)(kkp_ + 16); sq += xq_ * xq_; if (hw == 1) { kf = kq_; kx = xq_; } } \
    { const f32x4 kq_ = (f32x4){bflo(P##k2.x), bfhi(P##k2.x), bflo(P##k2.y), bfhi(P##k2.y)}; const f32x4 xq_ = kq_ * *(const f32x4*)(kkp_ + 32); sq += xq_ * xq_; if (hw == 2) { kf = kq_; kx = xq_; } } \
    { const f32x4 kq_ = (f32x4){bflo(P##k3.x), bfhi(P##k3.x), bflo(P##k3.y), bfhi(P##k3.y)}; const f32x4 xq_ = kq_ * *(const f32x4*)(kkp_ + 48); sq += xq_ * xq_; if (hw == 3) { kf = kq_; kx = xq_; } } \
    float ss = (sq[0] + sq[1]) + (sq[2] + sq[3]); ss += __shfl_xor(ss, 16); ss += __shfl_xor(ss, 32); \
    const float inv = __builtin_amdgcn_rsqf(fmaxf(ss, 1e-24f)); \
    const f32x4 zz = accz + w0c, ap = acca + a0c; \
    f32x4 nkk, wv_, bv_, kd_, rv_, vv_; \
    rv_ = (f32x4){bflo(P##r.x), bfhi(P##r.x), bflo(P##r.y), bfhi(P##r.y)}; vv_ = (f32x4){bflo(P##v.x), bfhi(P##v.x), bflo(P##v.y), bfhi(P##v.y)}; \
    if (il == 1) { f32x4 accv = (f32x4){0.f, 0.f, 0.f, 0.f}; accv = __builtin_amdgcn_mfma_f32_16x16x32_bf16(wv, P##v1, accv, 0, 0, 0); \
        const f32x4 vf_ = (f32x4){bflo(P##vf.x), bfhi(P##vf.x), bflo(P##vf.y), bfhi(P##vf.y)}; \
        _Pragma("unroll") for (int j = 0; j < 4; ++j) vv_[j] = vv_[j] + (vf_[j] - vv_[j]) * sigmoidf_(v0c[j] + accv[j]); \
        if ((d_) == 0) { u32x2 w_; w_.x = cvt_pk_bf16(vv_[0], vv_[1]); w_.y = cvt_pk_bf16(vv_[2], vv_[3]); *(u32x2*)(wsb + (unsigned)(BIG(7) + (unsigned)(t_ * D + (h_) * 64 + cown) * 2u)) = w_; } } \
    float bsum = 0.f; \
    _Pragma("unroll") for (int j = 0; j < 4; ++j) { \
        const float kk = kx[j] * inv, a = sigmoidf_(ap[j]); \
        const float lw = -0.6065306597f * sigmoidf_(zz[j]);            \
        float li = lw; li += dpp_f<0x111>(li); li += dpp_f<0x112>(li); li += dpp_f<0x114>(li); li += dpp_f<0x118>(li);     \
        const float pin = __expf(li), pex = __expf(li - lw), ipn = rcpf_(pin); \
        const float kdj = kf[j] * (1.0f + (a - 1.0f) * kac[j]); \
        bsum += rv_[j] * kdj * rkc[j]; \
        nkk[j] = -kk * pex; wv_[j] = pin; bv_[j] = kk * a * ipn; kd_[j] = kdj * ipn; rv_[j] = rv_[j] * pin; } \
    bsum += __shfl_xor(bsum, 16); bsum += __shfl_xor(bsum, 32); \
    if (kgrp == 0) *(float*)(wsb + (unsigned)(BIG(3) + (unsigned)((((d_) * T + t_) * 16 + (h_)) * 4 + hw) * 4u)) = bsum; \
    LAS float* sp_ = (stg_) + ((bufi) * 16 + ts) * STS + cown; \
    *(LAS f32x4*)(sp_) = nkk; *(LAS f32x4*)(sp_ + 64) = wv_; *(LAS f32x4*)(sp_ + 128) = bv_; *(LAS f32x4*)(sp_ + 192) = kd_; *(LAS f32x4*)(sp_ + 256) = rv_; *(LAS f32x4*)(sp_ + 320) = vv_; } while (0)
#define SVX_YSTORE(tok0_, L_, d_, h_, chunk, ybuf_, bufi) do { const int tt_ = (chunk) * 16 + ts, t_ = (tok0_) + ((d_) ? (L_) - 1 - tt_ : tt_); \
    const f32x4 y_ = *(const LAS f32x4*)((ybuf_) + ((bufi) * 16 + ts) * 64 + cown); \
    u32x2 w_; w_.x = cvt_pk_bf16(y_[0], y_[1]); w_.y = cvt_pk_bf16(y_[2], y_[3]); \
    *(u32x2*)(wsb + (unsigned)(BIG(1) + (unsigned)(d_) * (unsigned)BIGSZ + (unsigned)(t_ * D + (h_) * 64 + cown) * 2u)) = w_; } while (0)
#define SCAN_LDV(X, sp_) do { \
    X##nk0 = *(const LAS f32x4*)((sp_) + 8 * cg); X##nk1 = *(const LAS f32x4*)((sp_) + 8 * cg + 4); \
    X##b0 = *(const LAS f32x4*)((sp_) + 128 + 8 * cg); X##b1 = *(const LAS f32x4*)((sp_) + 128 + 8 * cg + 4); \
    X##k0 = *(const LAS f32x4*)((sp_) + 192 + 8 * cg); X##k1 = *(const LAS f32x4*)((sp_) + 192 + 8 * cg + 4); \
    X##r0 = *(const LAS f32x4*)((sp_) + 256 + 8 * cg); X##r1 = *(const LAS f32x4*)((sp_) + 256 + 8 * cg + 4); \
    X##vr = *(const LAS f32x2*)((sp_) + 320 + 16 * hw + 2 * rg); } while (0)
#define SCAN_STEP(X, yp_) do { \
    const f32x2 nk[4] = {{X##nk0[0], X##nk0[1]}, {X##nk0[2], X##nk0[3]}, {X##nk1[0], X##nk1[1]}, {X##nk1[2], X##nk1[3]}}; \
    const f32x2 bb[4] = {{X##b0[0], X##b0[1]}, {X##b0[2], X##b0[3]}, {X##b1[0], X##b1[1]}, {X##b1[2], X##b1[3]}}; \
    const f32x2 kd[4] = {{X##k0[0], X##k0[1]}, {X##k0[2], X##k0[3]}, {X##k1[0], X##k1[1]}, {X##k1[2], X##k1[3]}}; \
    const f32x2 rr[4] = {{X##r0[0], X##r0[1]}, {X##r0[2], X##r0[3]}, {X##r1[0], X##r1[1]}, {X##r1[2], X##r1[3]}}; \
    float yo[2]; \
    _Pragma("unroll") for (int a = 0; a < 2; ++a) { \
        f32x2 t = s[a][0] * nk[0]; t += s[a][1] * nk[1]; t += s[a][2] * nk[2]; t += s[a][3] * nk[3]; \
        const float sa = red8(t[0] + t[1]); \
        const f32x2 sa2 = (f32x2){sa, sa}, v2 = (f32x2){X##vr[a], X##vr[a]}; \
        _Pragma("unroll") for (int bp = 0; bp < 4; ++bp) s[a][bp] = s[a][bp] + sa2 * bb[bp] + v2 * kd[bp]; \
        f32x2 y = s[a][0] * rr[0]; y += s[a][1] * rr[1]; y += s[a][2] * rr[2]; y += s[a][3] * rr[3]; \
        yo[a] = y[0] + y[1]; } \
      \
    { float keep_ = cg < 4 ? yo[0] : yo[1]; const float send_ = cg < 4 ? yo[1] : yo[0]; \
      keep_ += dpp_f<0x141>(send_); keep_ += dpp_f<0xB1>(keep_); keep_ += dpp_f<0x4E>(keep_); \
      if ((cg & 3) == 0) *(LAS float*)((yp_) + (cg >> 2)) = keep_; } } while (0)
#define SCAN_RENORM(sp15_) do { const f32x4 p0_ = *(const LAS f32x4*)((sp15_) + 64 + 8 * cg), p1_ = *(const LAS f32x4*)((sp15_) + 64 + 8 * cg + 4); \
    const f32x2 pp_[4] = {{p0_[0], p0_[1]}, {p0_[2], p0_[3]}, {p1_[0], p1_[1]}, {p1_[2], p1_[3]}}; \
    _Pragma("unroll") for (int a = 0; a < 2; ++a) _Pragma("unroll") for (int bp = 0; bp < 4; ++bp) s[a][bp] = s[a][bp] * pp_[bp]; } while (0)
__device__ void scan_phase(KP p, int l, LAS unsigned char* lds) {
    const int il = l >> 1;
    const int tid = TIDX(), hb = tid >> 8, ht = tid & 255, hw = ht >> 6, lane = tid & 63, cg = lane & 7, rg = lane >> 3, G = GDIM();
    const int ts = lane & 15, kgrp = lane >> 4, cown = 16 * hw + 4 * kgrp;
    unsigned char* wsb = p->ws; const unsigned vboff = (unsigned)(il == 0 ? BIG(0) : BIG(6));
    LAS float* stg0 = (LAS float*)lds; LAS float* ybuf0 = stg0 + 2 * 16 * STS;
    LAS float* stg1 = (LAS float*)(lds + SCAN_HALF_BYTES); LAS float* ybuf1 = stg1 + 2 * 16 * STS;
    for (int slot = BIDX(); slot < 256; slot += G) {
        const int lh = (slot & 31) >> 1, ldir = slot & 1, ltok0 = TC + (slot >> 5) * 2048;
        f32x2 s[2][4];
        f32x4 Ank0, Ank1, Ab0, Ab1, Ak0, Ak1, Ar0, Ar1; f32x2 Avr;
        f32x4 Bnk0, Bnk1, Bb0, Bb1, Bk0, Bk1, Br0, Br1; f32x2 Bvr;
        if (hb == 0) {
            {
                const float* si = p->in[I_STATE] + ((size_t)(((slot >> 5) * 2 + il) * 2 + ldir) * 16 + lh) * 4096;
#pragma unroll
                for (int a = 0; a < 2; ++a)
#pragma unroll
                    for (int bp = 0; bp < 4; ++bp) s[a][bp] = *(const f32x2*)(si + (16 * hw + 2 * rg + a) * 64 + 8 * cg + 2 * bp);
                float one = 1.0f; asm volatile("" : "+v"(one));
#pragma unroll
                for (int a = 0; a < 2; ++a)
#pragma unroll
                    for (int bp = 0; bp < 4; ++bp) s[a][bp] = s[a][bp] * one;
            }
            for (int ci = 0; ci < 128; ++ci) {
                const int buf = ci & 1;
                LDS_BARRIER();
                __builtin_amdgcn_s_setprio(2);
                const LAS float* sb = stg0 + (buf * 16) * STS; LAS float* yb = ybuf0 + (buf * 16) * 64 + 16 * hw + 2 * rg;
                SCAN_LDV(A, sb);
#pragma unroll
                for (int st = 0; st < 16; st += 2) {
                    SCAN_LDV(B, sb + (st + 1) * STS);
                    SCAN_STEP(A, yb + st * 64);
                    if (st + 2 < 16) SCAN_LDV(A, sb + (st + 2) * STS);
                    SCAN_STEP(B, yb + (st + 1) * 64);
                }
                SCAN_RENORM(sb + 15 * STS);
                __builtin_amdgcn_s_setprio(0);
                LDS_BARRIER();
            }
        } else {
            u32x2 Lk0, Lk1, Lk2, Lk3, Lr, Lv, Lvf; bf16x8 Ltw0, Ltw1, La0, La1, Lv1;
            u32x2 Sk0, Sk1, Sk2, Sk3, Sr, Sv, Svf; bf16x8 Stw0, Stw1, Sa0, Sa1, Sv1;
            Lvf = Svf = (u32x2){0u, 0u}; Lv1 = Sv1 = (bf16x8){0, 0, 0, 0, 0, 0, 0, 0};
#pragma unroll
            for (int a = 0; a < 2; ++a)
#pragma unroll
                for (int bp = 0; bp < 4; ++bp) s[a][bp] = (f32x2){0.f, 0.f};
            {
                SVX_GLOAD(L, ltok0, 2048, ldir, lh, 0);
                const int sid = slot * 2, sh = (sid & 31) >> 1, sd = sid & 1, stok0 = (sid >> 5) * 256;
                SVX_GLOAD(S, stok0, 256, sd, sh, 0);
                { SVX_CONSTS(ldir, lh) SVX_STAGE(L, ltok0, 2048, ldir, lh, 0, stg0, 0); }
                { SVX_CONSTS(sd, sh) SVX_STAGE(S, stok0, 256, sd, sh, 0, stg1, 0); }
                SVX_GLOAD(L, ltok0, 2048, ldir, lh, 1);
            }
            SVX_CONSTS(ldir, lh)
            for (int ci = 0; ci < 128; ++ci) {
                const int buf = ci & 1;
                LDS_BARRIER();
                if (ci + 1 < 128) SVX_STAGE(L, ltok0, 2048, ldir, lh, ci + 1, stg0, buf ^ 1);
                __builtin_amdgcn_sched_barrier(0);
                if (ci + 2 < 128) SVX_GLOAD(L, ltok0, 2048, ldir, lh, ci + 2);
                __builtin_amdgcn_sched_barrier(0);
                const int cj = (ci >> 2) & 15, q = ci & 3, sbuf = cj & 1;
                {
                    const LAS float* sb = stg1 + (sbuf * 16 + 4 * q) * STS; LAS float* yb = ybuf1 + (sbuf * 16 + 4 * q) * 64 + 16 * hw + 2 * rg;
                    SCAN_LDV(A, sb); SCAN_LDV(B, sb + STS);
                    SCAN_STEP(A, yb); SCAN_LDV(A, sb + 2 * STS);
                    SCAN_STEP(B, yb + 64); SCAN_LDV(B, sb + 3 * STS);
                    SCAN_STEP(A, yb + 128); SCAN_STEP(B, yb + 192);
                    if (q == 3) SCAN_RENORM(stg1 + (sbuf * 16 + 15) * STS);
                }
                __builtin_amdgcn_sched_barrier(0);
                const int gc = (ci >> 2) + 1;
                if (gc < 32 && (q == 0 || q == 2)) {
                    const int sid = slot * 2 + (gc >> 4), sh = (sid & 31) >> 1, sd = sid & 1, stok0 = (sid >> 5) * 256;
                    if (q == 0) SVX_GLOAD_A(S, stok0, 256, sd, sh, gc & 15);
                    else { SVX_GLOAD_B(S, stok0, 256, sd, sh, gc & 15); SVX_CONSTS(sd, sh) SVX_STAGE(S, stok0, 256, sd, sh, gc & 15, stg1, gc & 1); }
                }
                LDS_BARRIER();
                SVX_YSTORE(ltok0, 2048, ldir, lh, ci, ybuf0, buf);
                {
                    const int sid = slot * 2 + (ci >> 6), sb_ = sid >> 5, sh = (sid & 31) >> 1, sd = sid & 1, stok0 = sb_ * 256;
                    if (q == 3) SVX_YSTORE(stok0, 256, sd, sh, cj, ybuf1, sbuf);
                    if ((ci & 63) == 63) {
                        float* so = p->out + (size_t)T * D + ((size_t)((sb_ * 2 + il) * 2 + sd) * 16 + sh) * 4096;
#pragma unroll
                        for (int a = 0; a < 2; ++a)
#pragma unroll
                            for (int bp = 0; bp < 4; ++bp) { *(f32x2*)(so + (16 * hw + 2 * rg + a) * 64 + 8 * cg + 2 * bp) = s[a][bp]; s[a][bp] = (f32x2){0.f, 0.f}; }
                    }
                }
            }
        }
        __syncthreads();
    }
}

__device__ void post_phase(KP p, int l) {
    const int il = l >> 1;
    const int lane = TIDX() & 63, gw = BIDX() * 8 + (TIDX() >> 6), nw = GDIM() * 8;
    const int tl = lane & 15, kg = lane >> 4;
    const bf16_t* G2T = (const bf16_t*)(p->ws + W_G2T); const bf16_t* SG = (const bf16_t*)(p->ws + WS_SG);
    const bf16_t* Y0 = (const bf16_t*)(p->ws + BIG(1)); const bf16_t* Y1 = (const bf16_t*)(p->ws + BIG(2));
    const bf16_t* Vb = (const bf16_t*)(p->ws + (il == 0 ? BIG(0) : BIG(7)));
    bf16_t* YG = (bf16_t*)(p->ws + BIG(4));
    const float* BONP = (const float*)(p->ws + BIG(3));
    const float* lng = p->in[I_LNG] + il * D; const float* lnb = p->in[I_LNB] + il * D;
    const int h = gw & 15, tlanes = nw >> 4;
    bf16x8 gfr[4][4]; f32x4 lgv[4], lbv[4];
#pragma unroll
    for (int n = 0; n < 4; ++n) {
#pragma unroll
        for (int ks = 0; ks < 4; ++ks) gfr[ks][n] = *(const bf16x8*)(G2T + (size_t)(h * 64 + n * 16 + tl) * 128 + ks * 32 + kg * 8);
        lgv[n] = *(const f32x4*)(lng + h * 64 + n * 16 + kg * 4); lbv[n] = *(const f32x4*)(lnb + h * 64 + n * 16 + kg * 4);
    }
    for (int tile = (gw < (nw & ~15)) ? (gw >> 4) : T; tile < T / 16; tile += tlanes) {
        const int tok0 = tile * 16, tk = tok0 + tl;
        f32x4 ag[4];
#pragma unroll
        for (int n = 0; n < 4; ++n) ag[n] = (f32x4){0.f, 0.f, 0.f, 0.f};
#pragma unroll
        for (int ks = 0; ks < 4; ++ks) {
            const bf16x8 bg = *(const bf16x8*)(SG + (size_t)tk * 128 + ks * 32 + kg * 8);
#pragma unroll
            for (int n = 0; n < 4; ++n) ag[n] = __builtin_amdgcn_mfma_f32_16x16x32_bf16(gfr[ks][n], bg, ag[n], 0, 0, 0);
        }
        f32x4 y[4]; float s1 = 0.f;
#pragma unroll
        for (int n = 0; n < 4; ++n) {
            const size_t off = (size_t)tk * D + h * 64 + n * 16 + kg * 4;
            const u32x2 a = *(const u32x2*)(Y0 + off), b = *(const u32x2*)(Y1 + off);
            y[n] = (f32x4){bflo(a.x) + bflo(b.x), bfhi(a.x) + bfhi(b.x), bflo(a.y) + bflo(b.y), bfhi(a.y) + bfhi(b.y)};
            s1 += y[n][0] + y[n][1] + y[n][2] + y[n][3];
        }
        s1 += __shfl_xor(s1, 16); s1 += __shfl_xor(s1, 32);
        const float mean = s1 * (1.0f / 64.0f); float s2 = 0.f;
#pragma unroll
        for (int n = 0; n < 4; ++n)
#pragma unroll
            for (int j = 0; j < 4; ++j) { const float dd = y[n][j] - mean; s2 += dd * dd; }
        s2 += __shfl_xor(s2, 16); s2 += __shfl_xor(s2, 32);
        const float rstd = rsqrtf(s2 * (1.0f / 64.0f) + 64e-5f);
        const f32x4 bq0 = *(const f32x4*)(BONP + ((size_t)tk * 16 + h) * 4), bq1 = *(const f32x4*)(BONP + ((size_t)(T + tk) * 16 + h) * 4);
        const float bon = ((bq0[0] + bq0[1]) + (bq0[2] + bq0[3])) + ((bq1[0] + bq1[1]) + (bq1[2] + bq1[3]));
#pragma unroll
        for (int n = 0; n < 4; ++n) {
            const int c = h * 64 + n * 16 + kg * 4; const size_t off = (size_t)tk * D + c;
            const u32x2 vv = *(const u32x2*)(Vb + off);
            const float vx[4] = {bflo(vv.x), bfhi(vv.x), bflo(vv.y), bfhi(vv.y)};
            const f32x4 gg = lgv[n], gb = lbv[n];
            float o[4];
#pragma unroll
            for (int j = 0; j < 4; ++j) o[j] = ((y[n][j] - mean) * rstd * gg[j] + gb[j] + bon * vx[j]) * ag[n][j];
            u32x2 w; w.x = cvt_pk_bf16(o[0], o[1]); w.y = cvt_pk_bf16(o[2], o[3]);
            *(u32x2*)(YG + off) = w;
        }
    }
}


#define XB_TMO      128
#define XB_XCNT(j)  (256  + 64 * (j))
#define XB_XSUB(j)  (1280 + 64 * (j))
#define XB_XGEN(j)  (2304 + 64 * (j))
#define XB_TOP      3328
#define XB_TOPGEN   3392
#define XCD_BAR_WORDS 3456
#define XB_SPIN_CAP (1u << 22)
__device__ __forceinline__ unsigned xb_ld(unsigned* p)              { return __hip_atomic_load(p, __ATOMIC_RELAXED, __HIP_MEMORY_SCOPE_AGENT); }
__device__ __forceinline__ unsigned xb_add(unsigned* p, unsigned v) { return __hip_atomic_fetch_add(p, v, __ATOMIC_RELAXED, __HIP_MEMORY_SCOPE_AGENT); }
__device__ __forceinline__ unsigned xb_xcc_id() { return (unsigned)__builtin_amdgcn_s_getreg((3 << 11) | 20) & 0xFu; }
#define XB_SPIN(cond, bar) do { unsigned _sp = 0; while (cond) { __builtin_amdgcn_s_sleep(1); \
    if ((++_sp & 255u) == 0u) { if (xb_ld(&(bar)[XB_TMO])) break; if (_sp > XB_SPIN_CAP) { atomicAdd(&(bar)[XB_TMO], 1u); break; } } } } while (0)
__device__ __forceinline__ void xcd_barrier_complete(unsigned* bar, unsigned x, unsigned& nloc, unsigned& nx) {
    const unsigned G = gridDim.x;
    unsigned sum, cnt, mine, sp = 0u;
    for (;;) {
        sum = 0u; cnt = 0u; mine = 0u;
#pragma unroll
        for (unsigned j = 0; j < 16; ++j) { const unsigned c = xb_ld(&bar[XB_XCNT(j)]); sum += c; cnt += (c > 0u) ? 1u : 0u; mine = (j == x) ? c : mine; }
        if (sum == G) break;
        __builtin_amdgcn_s_sleep(1);
        if ((++sp & 255u) == 0u) { if (xb_ld(&bar[XB_TMO])) break; if (sp > XB_SPIN_CAP) { atomicAdd(&bar[XB_TMO], 1u); break; } }
    }
    nloc = mine > 0u ? mine : 1u; nx = cnt > 0u ? cnt : 1u;
}
__device__ __forceinline__ void xcd_barrier(unsigned* bar, volatile LAS unsigned* st) {
    asm volatile("s_waitcnt vmcnt(0)" ::: "memory");
    __syncthreads();
    if (threadIdx.x == 0) {
        const unsigned x = xb_xcc_id();
        __builtin_amdgcn_s_waitcnt(0);
        unsigned nloc = st[0], nx = st[1];
        if (nloc == 0u) { xcd_barrier_complete(bar, x, nloc, nx); st[0] = nloc; st[1] = nx; }
        const unsigned old = xb_add(&bar[XB_XSUB(x)], 1u);
        const unsigned gen = old / nloc;
        if (old + 1u == (gen + 1u) * nloc) {
            __builtin_amdgcn_fence(__ATOMIC_RELEASE, "agent");
            asm volatile("s_waitcnt vmcnt(0)" ::: "memory");
            const unsigned og = xb_add(&bar[XB_TOP], 1u);
            const unsigned tg = og / nx;
            if (og + 1u == (tg + 1u) * nx) xb_add(&bar[XB_TOPGEN], 1u);
            else XB_SPIN(xb_ld(&bar[XB_TOPGEN]) == tg, bar);
            __builtin_amdgcn_fence(__ATOMIC_ACQUIRE, "agent");
            xb_add(&bar[XB_XGEN(x)], 1u);
            asm volatile("s_waitcnt vmcnt(0)" ::: "memory");
        } else {
            XB_SPIN(xb_ld(&bar[XB_XGEN(x)]) == gen, bar);
            __builtin_amdgcn_fence(__ATOMIC_ACQUIRE, "agent");
            asm volatile("s_waitcnt vmcnt(0)" ::: "memory");
        }
    }
    __syncthreads();
}

constexpr int N_PHASES = 1 + 7 + 9 + 7 + 9 + 1;


__device__ __forceinline__ int phase_opcode(int ph) {
    if (ph == 0) return 30;
    if (ph == N_PHASES - 1) return 31;
    int q = ph - 1, l;
    if (q < 7) l = 0; else if (q < 16) { l = 1; q -= 7; } else if (q < 23) { l = 2; q -= 16; } else { l = 3; q -= 23; }
    if ((l & 1) == 0) return q < 4 ? q : 10 + (q - 4);
    return q < 6 ? 20 + q : 10 + (q - 6);
}
#define REGION_T0() unsigned long long rt0_ = 0; if (PROFMASK != 0u && blockIdx.x == 0 && threadIdx.x == 0) rt0_ = __builtin_amdgcn_s_memrealtime()
#define REGION_T1(bit) do { if (PROFMASK != 0u && ((PROFMASK >> (bit)) & 1u) && blockIdx.x == 0 && threadIdx.x == 0) ((volatile LAS unsigned*)(lds + 131072))[2] += (unsigned)(__builtin_amdgcn_s_memrealtime() - rt0_); } while (0)
__device__ void run_phase(KP p, int ph, LAS unsigned char* lds) {
    const int G = GDIM(), bid = BIDX();
    unsigned char* ws = p->ws;
    const float* mod = (const float*)(ws + WS_MOD);
    if (ph == 0 && OPEN(30)) {
        if (DUP(14)) { ada_phase(p, lds); wconv_sgu(p, 0, (LAS float*)lds); }
        if (DUP(15)) { const unsigned long long t0 = __builtin_amdgcn_s_memrealtime(); while (__builtin_amdgcn_s_memrealtime() - t0 < 50000ull) __builtin_amdgcn_s_sleep(8); }
        ada_phase(p, lds);
        wconv_sgu(p, 0, (LAS float*)lds);
        return;
    }
    if (ph == N_PHASES - 1) { if (OPEN(31)) final_norm_phase(p); return; }
    int q = ph - 1, l;
    if (q < 7) l = 0; else if (q < 16) { l = 1; q -= 7; } else if (q < 23) { l = 2; q -= 16; } else { l = 3; q -= 23; }
    const bool sgu = (l & 1) == 0;
    const float* modl = mod + (size_t)l * 9 * 6144;
    int op;
    if (sgu) op = q < 4 ? q : 10 + (q - 4); else op = q < 6 ? 20 + q : 10 + (q - 6);
    const float* xp_lo = p->out; const float* xp_hi = p->out;
    if (l == 0 && op == 3) { xp_lo = p->in[I_XP]; xp_hi = p->in[I_XS] - (size_t)TC * D; }
    pg8::Sched S;
    switch (op) {
    case 0: if (!OPEN(0)) break;
        if (l > 0) { if (DUP(2)) wconv_sgu(p, l, (LAS float*)lds); wconv_sgu(p, l, (LAS float*)lds); }
        if (DUP(3)) norm_phase(p, l, 0, l == 0, (bf16_t*)(ws + BIG(1)));
        norm_phase(p, l, 0, l == 0, (bf16_t*)(ws + BIG(1)));
        break;
    case 1: if (!OPEN(1)) break; {
        S.init(ws + BIG(1), 0, ws + W_INT, 0, 8, D, T, 2048, G, bid);
        EpiGeluUV E{(bf16_t*)(ws + BIG(2)), (bf16_t*)(ws + BIG(3)), (float*)(ws + WS_VST)};
        if (DUP(12)) { pg8::gemm_phase(lds, S, E); __syncthreads(); }
        pg8::gemm_phase(lds, S, E);
    } break;
    case 2: if (!OPEN(2)) break; if (DUP(8)) sgu_mix_phase(p, l, lds); sgu_mix_phase(p, l, lds); break;
    case 3: if (!OPEN(3)) break; {
        S.init(ws + BIG(4), 0, ws + W_OUTT, 0, 4, D, T, D, G, bid);
        EpiRes E{xp_lo, xp_hi, p->out, modl, 2048, 0};
        if (DUP(13)) { EpiRes E2 = E; int dry = 1; asm volatile("" : "+s"(dry)); E2.dry = dry; pg8::gemm_phase(lds, S, E2); __syncthreads(); }
        pg8::gemm_phase(lds, S, E);
    } break;
    case 10: if (!OPEN(10)) break;
        if (sgu) { if (DUP(2)) wconv_rwkv_lora_down(p, l + 1, (LAS float*)lds); wconv_rwkv_lora_down(p, l + 1, (LAS float*)lds); }
        if (DUP(3)) norm_phase(p, l, 1, false, (bf16_t*)(ws + BIG(1)));
        norm_phase(p, l, 1, false, (bf16_t*)(ws + BIG(1)));
        break;
    case 11: if (!OPEN(11)) break; {
        const int merged = ((G == 256) && MERGED_MLP) ? 1 : 0;
        S.init(ws + BIG(1), 0, ws + W_MLP1T, 0, 16, D, T, DFF, G, bid, merged, (unsigned*)(ws + WS_RDY) + (size_t)l * 80 * 64);
        EpiBf16<1> E{(bf16_t*)(ws + BIG(2)), nullptr, nullptr, DFF, merged};
        pg8::gemm_phase(lds, S, E);
        if (!merged) break;
    }
    case 12: if (!OPEN(12)) break; {
        const int merged = ((G == 256) && MERGED_MLP) ? 2 : 0;
        pg8::Sched S2;
        S2.init(ws + BIG(2), 0, ws + W_MLP2T, 0, 4, DFF, T, D, G, bid, merged, (unsigned*)(ws + WS_RDY) + (size_t)l * 80 * 64);
        EpiRes E{p->out, p->out, p->out, modl, 5120, 0};
        pg8::gemm_phase(lds, S2, E);
    } break;
    case 20: if (!OPEN(20)) break;
        if (DUP(2)) wconv_rwkv_main(p, l, (LAS float*)lds);
        { REGION_T0(); wconv_rwkv_main(p, l, (LAS float*)lds); __syncthreads(); REGION_T1(26); }
        { REGION_T0(); rmix_phase(p, l, lds); REGION_T1(27); }
        break;
    case 21: if (!OPEN(21)) break; {
        S.init(ws + BIG(1), BIGSZ, ws + W_RT, 2 * MiB, 4, D, T, 3 * D, G, bid);
        EpiBf16<0> E{(bf16_t*)(ws + BIG(4)), (bf16_t*)(ws + BIG(5)), (bf16_t*)(ws + (l == 1 ? BIG(0) : BIG(6))), D, 0};
        if (DUP(11)) { pg8::gemm_phase(lds, S, E); __syncthreads(); }
        pg8::gemm_phase(lds, S, E);
    } break;
    case 22: break;
    case 23: if (!OPEN(23)) break; scan_phase(p, l, lds); break;
    case 24: if (!OPEN(24)) break; if (DUP(7)) post_phase(p, l); post_phase(p, l); break;
    case 25: if (!OPEN(25)) break; {
        S.init(ws + BIG(4), 0, ws + W_OT, 0, 4, D, T, D, G, bid);
        EpiRes E{p->out, p->out, p->out, modl, 2048, 0};
        pg8::gemm_phase(lds, S, E);
    } break;
    default: break;
    }
}

__global__ void __launch_bounds__(NTHREADS, 2) mega(Params p_unused) {
    extern __shared__ __attribute__((aligned(16))) unsigned char smem[];
    LAS unsigned char* lds = (LAS unsigned char*)smem;
#if MULTI_LAUNCH
    run_phase(kparams(), kparams()->ph_lo, lds);
#else
    cg::grid_group grid = cg::this_grid();
    const int lo = kparams()->ph_lo, hi = kparams()->ph_hi;
    volatile LAS unsigned* st = (volatile LAS unsigned*)(lds + 131072);
    if (threadIdx.x == 0) { st[0] = 0u; st[1] = 0u; st[2] = 0u; st[3] = 0u; }
    __syncthreads();
    if (threadIdx.x == 0) (void)xb_add(&((unsigned*)(kparams()->ws + WS_BAR))[XB_XCNT(xb_xcc_id())], 1u);
    if (lo > hi) grid.sync();
    for (int ph = lo; ph < hi; ++ph) {
        if (phase_opcode(ph) == 22) continue;
        if (phase_opcode(ph) == 12 && gridDim.x == 256 && MERGED_MLP) continue;
        unsigned long long t0 = 0;
        if (PROFMASK != 0u && blockIdx.x == 0 && threadIdx.x == 0) t0 = __builtin_amdgcn_s_memrealtime();
        run_phase(kparams(), ph, lds);
        if (ph + 1 < hi) xcd_barrier((unsigned*)(kparams()->ws + WS_BAR), (volatile LAS unsigned*)(lds + 131072));
        if (PROFMASK != 0u && blockIdx.x == 0 && threadIdx.x == 0 && ((PROFMASK >> phase_opcode(ph)) & 1u)) st[2] += (unsigned)(__builtin_amdgcn_s_memrealtime() - t0);
    }
    if (PROFMASK != 0u && blockIdx.x == 0 && threadIdx.x == 0) { const unsigned long long t0 = __builtin_amdgcn_s_memrealtime(); const unsigned long long dt = st[2]; while (__builtin_amdgcn_s_memrealtime() - t0 < dt) __builtin_amdgcn_s_sleep(8); }
#endif
}

extern "C" void kernel_launch(void* const* d_in, const int* in_sizes, int n_in, void* d_out, int out_size, void* d_ws, size_t ws_size, hipStream_t stream) {
    static int grid = 0;
    if (grid == 0) {
        int dev = 0, cus = 0, per_cu = 0;
        hipGetDevice(&dev);
        hipDeviceGetAttribute(&cus, hipDeviceAttributeMultiprocessorCount, dev);
        if (hipFuncSetAttribute((const void*)mega, hipFuncAttributeMaxDynamicSharedMemorySize, LDS_BYTES) != hipSuccess) { fprintf(stderr, "hipFuncSetAttribute failed\n"); grid = -1; return; }
        if (hipOccupancyMaxActiveBlocksPerMultiprocessor(&per_cu, (const void*)mega, NTHREADS, LDS_BYTES) != hipSuccess || per_cu < 1) { fprintf(stderr, "occupancy query failed (%d)\n", per_cu); per_cu = 1; }
        (void)hipGetLastError();
        grid = cus * (per_cu < 1 ? 1 : (per_cu > 1 ? 1 : per_cu));
        if (ws_size < BIG(8)) fprintf(stderr, "workspace too small: %zu < %zu\n", ws_size, (size_t)BIG(8));
    }
    if (grid < 0) return;
    Params hp{};
    for (int i = 0; i < N_IN; ++i) hp.in[i] = (const float*)d_in[i];
    hp.out = (float*)d_out; hp.ws = (unsigned char*)d_ws;
#if MULTI_LAUNCH
    for (int ph = 0; ph < N_PHASES; ++ph) {
        hp.ph_lo = ph; hp.ph_hi = ph + 1;
        hipLaunchKernelGGL(mega, dim3(grid), dim3(NTHREADS), LDS_BYTES, stream, hp);
    }
#else
    hp.ph_lo = 0; hp.ph_hi = N_PHASES;
    if (hipMemsetAsync((char*)d_ws + WS_BAR, 0, 16 * 1024 + 4 * 80 * 256, stream) != hipSuccess) { fprintf(stderr, "memset of barrier words failed\n"); return; }
    void* args[] = {&hp};
    hipError_t e = hipLaunchCooperativeKernel((const void*)mega, dim3(grid), dim3(NTHREADS), args, LDS_BYTES, stream);
    if (e != hipSuccess) fprintf(stderr, "cooperative launch failed: %s (grid %d)\n", hipGetErrorString(e), grid);
#endif
}
```

```cpp
#include <hip/hip_runtime.h>
#include <hip/hip_cooperative_groups.h>
#include <cstdio>
namespace cg = cooperative_groups;

#define LAS __attribute__((address_space(3)))
typedef unsigned short bf16_t;
typedef short bf16x8 __attribute__((ext_vector_type(8)));
typedef float f32x4 __attribute__((ext_vector_type(4)));
typedef float f32x2 __attribute__((ext_vector_type(2)));
typedef unsigned u32x4 __attribute__((ext_vector_type(4)));
typedef unsigned u32x2 __attribute__((ext_vector_type(2)));

#ifndef OPMASK
#define OPMASK 0xFFFFFFFFu
#endif
#define OPEN(b) ((OPMASK >> (b)) & 1u)
#ifndef DUPMASK
#define DUPMASK 0u
#endif
#define DUP(b) ((DUPMASK >> (b)) & 1u)
#ifndef SCANVAR
#define SCANVAR 0
#endif
#ifndef PROFMASK
#define PROFMASK 0u
#endif
#ifndef MERGED_MLP
#define MERGED_MLP 1
#endif
#ifndef MULTI_LAUNCH
#define MULTI_LAUNCH 0
#endif

constexpr int T = 20480, TC = 4096, D = 1024, DFF = 4096;
constexpr int NTHREADS = 512;
constexpr int LDS_BYTES = 131072 + 16;
constexpr size_t MiB = 1u << 20;
constexpr size_t W_MLP1T = 0, W_MLP2T = 8 * MiB, W_INT = 16 * MiB, W_OUTT = 20 * MiB, W_S = 22 * MiB;
constexpr size_t W_RT = 16 * MiB, W_KT = 18 * MiB, W_VT = 20 * MiB, W_OT = 22 * MiB;
constexpr size_t W_LD = 24 * MiB;
constexpr size_t W_W2T = 25 * MiB;
constexpr size_t W_A2T = 25 * MiB + 256 * 1024;
constexpr size_t W_V2T = 25 * MiB + 512 * 1024;
constexpr size_t W_G2T = 25 * MiB + 640 * 1024;
constexpr size_t WS_MOD = 32 * MiB;
constexpr size_t WS_VST = 53 * MiB;
constexpr size_t WS_BON = 34 * MiB;
constexpr size_t WS_TW = 36 * MiB, WS_A1O = 41 * MiB, WS_SG = 46 * MiB, WS_V1O = 51 * MiB;
constexpr size_t WS_BAR = 55 * MiB + 768 * 1024;
constexpr size_t WS_RDY = WS_BAR + 16 * 1024;
constexpr size_t WS_BIG = 56 * MiB, BIGSZ = 40 * MiB;
#define BIG(i) (WS_BIG + (size_t)(i) * BIGSZ)

enum { I_XP = 0, I_XS, I_STATE, I_C, I_CCTX, I_N1G, I_N2G, I_ADAW, I_ADAB, I_SWIN, I_SLNG, I_SLNB, I_SWS, I_SBS, I_SWOUT,
       I_MU, I_WR, I_WK, I_WV, I_WO, I_W0, I_W1, I_W2, I_A0, I_A1, I_A2, I_V0, I_V1, I_V2, I_G1, I_G2, I_KK, I_KA, I_RK, I_LNG, I_LNB,
       I_M1, I_M2, I_FG, N_IN };

struct Params { const float* in[N_IN]; float* out; unsigned char* ws; int ph_lo, ph_hi; };
typedef const __attribute__((address_space(4))) Params* KP;
__device__ __forceinline__ KP kparams() { KP k = (KP)__builtin_amdgcn_kernarg_segment_ptr(); asm volatile("" : "+s"(k)); return k; }

__device__ __forceinline__ int TIDX() { int t = threadIdx.x; asm volatile("" : "+v"(t)); return t; }
__device__ __forceinline__ int BIDX() { int t = blockIdx.x; asm volatile("" : "+s"(t)); return t; }
__device__ __forceinline__ int GDIM() { int t = gridDim.x; asm volatile("" : "+s"(t)); return t; }
__device__ __forceinline__ unsigned cvt_pk_bf16(float lo, float hi) { unsigned r; asm volatile("v_cvt_pk_bf16_f32 %0, %1, %2" : "=v"(r) : "v"(lo), "v"(hi)); return r; }
__device__ __forceinline__ bf16_t f2bf(float f) { unsigned u = __float_as_uint(f); u += 0x7FFFu + ((u >> 16) & 1u); return (bf16_t)(u >> 16); }
__device__ __forceinline__ float bf2f(unsigned b) { return __uint_as_float(b << 16); }
__device__ __forceinline__ float bflo(unsigned w) { return __uint_as_float(w << 16); }
__device__ __forceinline__ float bfhi(unsigned w) { return __uint_as_float(w & 0xFFFF0000u); }
__device__ __forceinline__ float rcpf_(float x) { return __builtin_amdgcn_rcpf(x); }
__device__ __forceinline__ float sigmoidf_(float x) { return rcpf_(1.0f + __expf(-x)); }
__device__ __forceinline__ float tanhf_(float x) { float e = __expf(-2.0f * fabsf(x)); float t = (1.0f - e) * rcpf_(1.0f + e); return x < 0.f ? -t : t; }
__device__ __forceinline__ float gelu_tanh(float x) { float u = 1.5957691216f * (x + 0.044715f * x * x * x); return x * rcpf_(1.0f + __expf(-u)); }
__device__ __forceinline__ float wave_sum(float v) {
#pragma unroll
    for (int o = 32; o >= 1; o >>= 1) v += __shfl_xor(v, o);
    return v;
}
#define LDS_BARRIER() do { asm volatile("s_waitcnt lgkmcnt(0)" ::: "memory"); __builtin_amdgcn_s_barrier(); asm volatile("" ::: "memory"); } while (0)
template <int CTRL> __device__ __forceinline__ float dpp_f(float x) { return __int_as_float(__builtin_amdgcn_update_dpp(0, __float_as_int(x), CTRL, 0xF, 0xF, true)); }
__device__ __forceinline__ float red8(float x) { x += dpp_f<0xB1>(x); x += dpp_f<0x4E>(x); x += dpp_f<0x141>(x); return x; }
__device__ __forceinline__ float red16(float x) { x = red8(x); x += dpp_f<0x140>(x); return x; }
__device__ __forceinline__ int cond_row(int t) { return t < TC ? 0 : 1 + ((t - TC) >> 11); }
__device__ __forceinline__ const float* xrow_ptr(KP p, bool from_input, int row) {
    if (from_input) return row < TC ? p->in[I_XP] + (size_t)row * D : p->in[I_XS] + (size_t)(row - TC) * D;
    return p->out + (size_t)row * D;
}

namespace pg8 {
constexpr int BM = 256, BK = 64, HALF = 128, HTB = HALF * BK * 2, STAGE_BYTES = 8 * HTB, NXCD = 8, WGM = 8;
__device__ __forceinline__ int lds_byte(int r, int c) { const int st = (r >> 4) * 2 + (c >> 5), rr = r & 15, cc = c & 31, ob = rr * 64 + cc * 2; return st * 1024 + (ob ^ (((ob >> 9) & 1) << 5)); }
__device__ __forceinline__ void stage_rc(int b, int& R, int& C) { const int st = b / 1024, sb = b % 1024, swz = sb ^ (((sb >> 9) & 1) << 5); R = (st >> 1) * 16 + swz / 64; C = (st & 1) * 32 + (swz % 64) / 2; }
__device__ __forceinline__ int perm32(int rho) { const int n = rho >> 4, i = rho & 15; return 8 * (i >> 2) + 4 * n + (i & 3); }
struct Unit { int pm, pn, gi; };
struct Sched {
    const char* A; size_t strideA; const char* Bt; size_t strideB; int tpg, K;
    int nM, nN, nwg, G, c, mode;
    unsigned* ready;
    __device__ void init(const void* A_, size_t sA, const void* Bt_, size_t sB, int tpg_, int K_, int M, int Nv, int G_, int c_, int mode_ = 0, unsigned* ready_ = nullptr) {
        A = (const char*)A_; strideA = sA; Bt = (const char*)Bt_; strideB = sB; tpg = tpg_; K = K_; nM = M / BM; nN = Nv / BM; nwg = nM * nN; G = G_; c = c_; mode = mode_; ready = ready_; }
    __device__ bool next(int i, Unit& u) const {
        int pm = 0, pn = 0, gi = 0; bool ok;
        if (mode == 1) {
            const int ui = i < 2 ? i * 256 + c : 512 + (i - 2) * 192 + (c - 64);
            ok = (i < 2) || (c >= 64 && i < 6);
            pm = ui >> 4; pn = ui & 15;
        } else if (mode == 2) {
            const int d = c < 64 ? c + 64 * i : 128 + (c - 64);
            ok = c < 64 ? (i < 2) : (i < 1);
            pm = d >> 2; pn = d & 3;
        } else {
            const long L = (long)i * G + c; ok = L < nwg;
            int wgid = ok ? (int)L : 0; { const int q = nwg / NXCD, r = nwg % NXCD, xcd = wgid % NXCD, off = wgid / NXCD; wgid = (xcd < r ? xcd * (q + 1) : r * (q + 1) + (xcd - r) * q) + off; }
            const int nig = WGM * nN, gid = wgid / nig, fm = gid * WGM, gsz = (nM - fm) < WGM ? (nM - fm) : WGM;
            pm = fm + ((wgid % nig) % gsz); const int pv = (wgid % nig) / gsz; gi = pv / tpg; pn = pv - gi * tpg;
        }
        u.pm = pm; u.pn = pn; u.gi = gi;
        return ok;
    }
    __device__ __forceinline__ void a_ready(const Unit& u) const {
        if (mode != 2) return;
        if (threadIdx.x < 64) {
            unsigned spins = 0;
            while ((unsigned)__builtin_amdgcn_readfirstlane(__hip_atomic_load(ready + 64 * u.pm, __ATOMIC_RELAXED, __HIP_MEMORY_SCOPE_AGENT)) < 128u) {
                __builtin_amdgcn_s_sleep(2); if (++spins > (1u << 24)) break; }
            __builtin_amdgcn_fence(__ATOMIC_ACQUIRE, "agent");
            asm volatile("s_waitcnt vmcnt(0)" ::: "memory");
        }
        asm volatile("" ::: "memory"); __builtin_amdgcn_s_barrier(); asm volatile("" ::: "memory");
    }
    __device__ __forceinline__ void done(const Unit& u) const {
        if (mode != 1) return;
        asm volatile("s_waitcnt vmcnt(0)" ::: "memory");
        if ((threadIdx.x & 63) == 0) __hip_atomic_fetch_add(ready + 64 * u.pm, 1u, __ATOMIC_RELAXED, __HIP_MEMORY_SCOPE_AGENT);
    }
};

template <class Epi>
__device__ __forceinline__ void gemm_phase(LAS unsigned char* lds, const Sched& S, const Epi& E) {
    const int tid = TIDX(), wid = __builtin_amdgcn_readfirstlane(tid >> 6), lane = tid & 63, wr = wid >> 2, wc = wid & 3, fr = lane & 15, fq = lane >> 4;
    const int K = S.K, nt = K / BK;
    unsigned voffA[2], voffB[2];
#pragma unroll
    for (int i = 0; i < 2; ++i) { int R, C; stage_rc(tid * 16 + i * 8192, R, C); const int Rb = Epi::PERM ? ((R & ~31) + perm32(R & 31)) : R;
        voffA[i] = (unsigned)(R * K + C) * 2u; voffB[i] = (unsigned)(Rb * K + C) * 2u; }
    const size_t kstep = (size_t)(BK * 2);
    const size_t hstep = (size_t)HALF * K * 2;
    const size_t tstep = 2 * hstep;
    const unsigned ldsw = (unsigned)wid * 1024u;
    const int aoff = lds_byte(wr * 64 + fr, fq * 8), boff = lds_byte(wc * 32 + fr, fq * 8);
#define PG8_SA(b, h) (((b) * 2 + (h)) * HTB)
#define PG8_SB(b, h) ((4 + (b) * 2 + (h)) * HTB)
#define PG8_STAGE(bufoff, gbase, voff) do { _Pragma("unroll") for (int _i = 0; _i < 2; ++_i) \
        __builtin_amdgcn_global_load_lds((const unsigned*)((const char*)(gbase) + (voff)[_i]), (LAS unsigned*)(lds + (bufoff) + ldsw + _i * 8192), 16, 0, 0); } while (0)
#define PG8_LDA(dst, b, h) do { _Pragma("unroll") for (int m = 0; m < 4; ++m) _Pragma("unroll") for (int k = 0; k < 2; ++k) dst[m][k] = *(const LAS bf16x8*)(lds + PG8_SA(b, h) + aoff + m * 2048 + k * 1024); } while (0)
#define PG8_LDB(dst, b, h) do { _Pragma("unroll") for (int n = 0; n < 2; ++n) _Pragma("unroll") for (int k = 0; k < 2; ++k) dst[n][k] = *(const LAS bf16x8*)(lds + PG8_SB(b, h) + boff + n * 2048 + k * 1024); } while (0)
#define PG8_MMA(ai, bj, At, Bt) do { __builtin_amdgcn_s_setprio(1); _Pragma("unroll") for (int m = 0; m < 4; ++m) _Pragma("unroll") for (int n = 0; n < 2; ++n) _Pragma("unroll") for (int k = 0; k < 2; ++k) \
        acc[ai][bj][m][n] = __builtin_amdgcn_mfma_f32_16x16x32_bf16(Bt[n][k], At[m][k], acc[ai][bj][m][n], 0, 0, 0); __builtin_amdgcn_s_setprio(0); } while (0)
#define PG8_WAIT_V(n) asm volatile("s_waitcnt vmcnt(" #n ")" ::: "memory")
#define PG8_WAIT_L(n) asm volatile("s_waitcnt lgkmcnt(" #n ")" ::: "memory")
#define PG8_BAR __builtin_amdgcn_s_barrier()
#define PG8_SCHED __builtin_amdgcn_sched_barrier(0)
    Unit cur, nxt; int ui = 0;
    if (!S.next(0, cur)) return;
    f32x4 acc[2][2][4][2];
#pragma unroll
    for (int a = 0; a < 2; ++a)
#pragma unroll
        for (int b = 0; b < 2; ++b)
#pragma unroll
            for (int m = 0; m < 4; ++m)
#pragma unroll
                for (int n = 0; n < 2; ++n) acc[a][b][m][n] = (f32x4){0.f, 0.f, 0.f, 0.f};
    bf16x8 At[4][2], B0[2][2], B1[2][2];
    const char* cA = S.A + (size_t)cur.gi * S.strideA + (size_t)cur.pm * tstep; const char* cB = S.Bt + (size_t)cur.gi * S.strideB + (size_t)cur.pn * tstep;
    S.a_ready(cur);
    PG8_STAGE(PG8_SB(0, 0), cB, voffB); PG8_STAGE(PG8_SA(0, 0), cA, voffA); PG8_STAGE(PG8_SB(0, 1), cB + hstep, voffB); PG8_STAGE(PG8_SA(0, 1), cA + hstep, voffA);
    if (wr == 1) PG8_BAR;
    PG8_WAIT_V(4); PG8_BAR;
    PG8_STAGE(PG8_SB(1, 0), cB + kstep, voffB); PG8_STAGE(PG8_SA(1, 0), cA + kstep, voffA); PG8_STAGE(PG8_SB(1, 1), cB + hstep + kstep, voffB);
    PG8_WAIT_V(6); PG8_BAR;
    for (;;) {
        const bool has_next = S.next(ui + 1, nxt);
        const char* nA = has_next ? S.A + (size_t)nxt.gi * S.strideA + (size_t)nxt.pm * tstep : cA; const char* nB = has_next ? S.Bt + (size_t)nxt.gi * S.strideB + (size_t)nxt.pn * tstep : cB;
        for (int t = 0; t < nt; t += 2) {
            const bool last = (t == nt - 2);
            const char* a1 = cA + (size_t)(t + 1) * kstep;
            const char* a2 = last ? nA : cA + (size_t)(t + 2) * kstep; const char* b2 = last ? nB : cB + (size_t)(t + 2) * kstep;
            const char* a3 = a2 + kstep; const char* b3 = b2 + kstep;
            if (last && has_next) S.a_ready(nxt);
            PG8_LDB(B0, 0, 0); PG8_SCHED; PG8_LDA(At, 0, 0); PG8_STAGE(PG8_SA(1, 1), a1 + hstep, voffA);
            PG8_WAIT_L(8); PG8_BAR; PG8_WAIT_L(0); PG8_MMA(0, 0, At, B0); PG8_BAR; PG8_SCHED;
            PG8_LDB(B1, 0, 1); PG8_STAGE(PG8_SB(0, 0), b2, voffB);
            PG8_BAR; PG8_WAIT_L(0); PG8_MMA(0, 1, At, B1); PG8_BAR;
            PG8_LDA(At, 0, 1); PG8_STAGE(PG8_SA(0, 0), a2, voffA);
            PG8_BAR; PG8_WAIT_L(0); PG8_MMA(1, 0, At, B0); PG8_BAR; PG8_SCHED;
            PG8_STAGE(PG8_SB(0, 1), b2 + hstep, voffB);
            PG8_WAIT_V(6); PG8_BAR; PG8_MMA(1, 1, At, B1); PG8_BAR;
            PG8_LDB(B0, 1, 0); PG8_SCHED; PG8_LDA(At, 1, 0); PG8_STAGE(PG8_SA(0, 1), a2 + hstep, voffA);
            PG8_WAIT_L(8); PG8_BAR; PG8_WAIT_L(0); PG8_MMA(0, 0, At, B0); PG8_BAR; PG8_SCHED;
            PG8_LDB(B1, 1, 1); PG8_STAGE(PG8_SB(1, 0), b3, voffB);
            PG8_BAR; PG8_WAIT_L(0); PG8_MMA(0, 1, At, B1); PG8_BAR;
            PG8_LDA(At, 1, 1); PG8_STAGE(PG8_SA(1, 0), a3, voffA);
            PG8_BAR; PG8_WAIT_L(0); PG8_MMA(1, 0, At, B0); PG8_BAR; PG8_SCHED;
            PG8_STAGE(PG8_SB(1, 1), b3 + hstep, voffB);
            PG8_WAIT_V(6); PG8_BAR; PG8_MMA(1, 1, At, B1); PG8_BAR;
        }
        E(acc, cur, wr, wc, fr, fq); S.done(cur);
        if (!has_next) break;
#pragma unroll
        for (int a = 0; a < 2; ++a)
#pragma unroll
            for (int b = 0; b < 2; ++b)
#pragma unroll
                for (int m = 0; m < 4; ++m)
#pragma unroll
                    for (int n = 0; n < 2; ++n) acc[a][b][m][n] = (f32x4){0.f, 0.f, 0.f, 0.f};
        cur = nxt; cA = nA; cB = nB; ++ui;
    }
    PG8_WAIT_V(0);
    if (wr == 0) PG8_BAR;
    PG8_BAR;
#undef PG8_SA
#undef PG8_SB
#undef PG8_STAGE
#undef PG8_LDA
#undef PG8_LDB
#undef PG8_MMA
#undef PG8_WAIT_V
#undef PG8_WAIT_L
#undef PG8_BAR
#undef PG8_SCHED
}
}

typedef f32x4 Acc[2][2][4][2];

struct EpiRes {
    static constexpr bool PERM = true;
    const float* src_lo; const float* src_hi; float* dst; const float* modl; int goff; int dry;
    __device__ __forceinline__ void operator()(const Acc& acc, const pg8::Unit& u, int wr, int wc, int fr, int fq) const {
        const int row0 = u.pm * 256 + wr * 64 + fr, col0 = u.pn * 256 + wc * 32 + 8 * fq;
        const int crow = u.pm < 16 ? 0 : 1 + ((u.pm - 16) >> 3);
        const float* gp = modl + crow * 6144 + goff + col0;
        f32x4 gv[2][2];
#pragma unroll
        for (int bj = 0; bj < 2; ++bj)
#pragma unroll
            for (int n = 0; n < 2; ++n) gv[bj][n] = *(const f32x4*)(gp + bj * 128 + n * 4);
        const float* sb = (u.pm < 16 ? src_lo : src_hi);
#pragma unroll
        for (int ai = 0; ai < 2; ++ai)
#pragma unroll
            for (int m = 0; m < 4; ++m) {
                const size_t ro = (size_t)(row0 + ai * 128 + m * 16) * D + col0;
                f32x4 xv[2][2];
#pragma unroll
                for (int bj = 0; bj < 2; ++bj)
#pragma unroll
                    for (int n = 0; n < 2; ++n) xv[bj][n] = *(const f32x4*)(sb + ro + bj * 128 + n * 4);
#pragma unroll
                for (int bj = 0; bj < 2; ++bj)
#pragma unroll
                    for (int n = 0; n < 2; ++n) if (!dry) *(f32x4*)(dst + ro + bj * 128 + n * 4) = xv[bj][n] + gv[bj][n] * acc[ai][bj][m][n];
            }
    }
};
template <int ACT> struct EpiBf16 {
    static constexpr bool PERM = true;
    bf16_t* o0; bf16_t* o1; bf16_t* o2; int ldc; int wt;
    __device__ __forceinline__ void operator()(const Acc& acc, const pg8::Unit& u, int wr, int wc, int fr, int fq) const {
        const int row0 = u.pm * 256 + wr * 64 + fr, col0 = u.pn * 256 + wc * 32 + 8 * fq;
        bf16_t* base = u.gi == 0 ? o0 : (u.gi == 1 ? o1 : o2);
#pragma unroll
        for (int ai = 0; ai < 2; ++ai)
#pragma unroll
            for (int m = 0; m < 4; ++m) {
                bf16_t* rowp = base + (size_t)(row0 + ai * 128 + m * 16) * ldc + col0;
#pragma unroll
                for (int bj = 0; bj < 2; ++bj) {
                    f32x4 v0 = acc[ai][bj][m][0], v1 = acc[ai][bj][m][1];
                    if (ACT == 1) {
#pragma unroll
                        for (int j = 0; j < 4; ++j) { float a = fmaxf(v0[j], 0.f), b = fmaxf(v1[j], 0.f); v0[j] = a * a; v1[j] = b * b; }
                    }
                    u32x4 w; w.x = cvt_pk_bf16(v0[0], v0[1]); w.y = cvt_pk_bf16(v0[2], v0[3]); w.z = cvt_pk_bf16(v1[0], v1[1]); w.w = cvt_pk_bf16(v1[2], v1[3]);
                    if (wt) asm volatile("global_store_dwordx4 %0, %1, off sc0 sc1\n\ts_nop 1" :: "v"(rowp + bj * 128), "v"(w) : "memory");
                    else *(u32x4*)(rowp + bj * 128) = w;
                }
            }
    }
};
struct EpiGeluUV {
    static constexpr bool PERM = true;
    bf16_t* U; bf16_t* V; float* vst;
    __device__ __forceinline__ void operator()(const Acc& acc, const pg8::Unit& u, int wr, int wc, int fr, int fq) const {
        const int row0 = u.pm * 256 + wr * 64 + fr;
        const bool isv = u.pn >= 4;
        const int col0 = (u.pn & 3) * 256 + wc * 32 + 8 * fq;
        bf16_t* base = isv ? V : U;
#pragma unroll
        for (int ai = 0; ai < 2; ++ai)
#pragma unroll
            for (int m = 0; m < 4; ++m) {
                const int row = row0 + ai * 128 + m * 16;
                bf16_t* rowp = base + (size_t)row * D + col0;
                float s1 = 0.f, s2 = 0.f;
#pragma unroll
                for (int bj = 0; bj < 2; ++bj) {
                    f32x4 v0 = acc[ai][bj][m][0], v1 = acc[ai][bj][m][1];
#pragma unroll
                    for (int j = 0; j < 4; ++j) { v0[j] = gelu_tanh(v0[j]); v1[j] = gelu_tanh(v1[j]); s1 += v0[j] + v1[j]; s2 += v0[j] * v0[j] + v1[j] * v1[j]; }
                    u32x4 w; w.x = cvt_pk_bf16(v0[0], v0[1]); w.y = cvt_pk_bf16(v0[2], v0[3]); w.z = cvt_pk_bf16(v1[0], v1[1]); w.w = cvt_pk_bf16(v1[2], v1[3]);
                    *(u32x4*)(rowp + bj * 128) = w;
                }
                if (isv) {
                    s1 += __shfl_xor(s1, 16); s1 += __shfl_xor(s1, 32);
                    s2 += __shfl_xor(s2, 16); s2 += __shfl_xor(s2, 32);
                    if (fq == 0) *(f32x2*)(vst + ((size_t)row * 16 + (u.pn - 4) * 4 + wc) * 2) = (f32x2){s1, s2};
                }
            }
    }
};

__device__ void wconv_tiled(const float* __restrict__ src, int K, int N, bf16_t* dst, int ldd, LAS float* tile, int bid, int G) {
    const int tid = TIDX(); const int tn = N / 64, ntiles = (K / 64) * tn;
    for (int t = bid; t < ntiles; t += G) {
        const int k0 = (t / tn) * 64, n0 = (t % tn) * 64;
#pragma unroll
        for (int i = 0; i < 8; ++i) { const int idx = tid + 512 * i, kk = idx >> 6, nn = idx & 63; tile[kk * 65 + nn] = src[(size_t)(k0 + kk) * N + n0 + nn]; }
        __syncthreads();
        { const int n = tid >> 3, kc = tid & 7; float v[8];
#pragma unroll
          for (int j = 0; j < 8; ++j) v[j] = tile[(kc * 8 + j) * 65 + n];
          u32x4 w; w.x = cvt_pk_bf16(v[0], v[1]); w.y = cvt_pk_bf16(v[2], v[3]); w.z = cvt_pk_bf16(v[4], v[5]); w.w = cvt_pk_bf16(v[6], v[7]);
          *(u32x4*)(dst + (size_t)(n0 + n) * ldd + k0 + kc * 8) = w; }
        __syncthreads();
    }
}
__device__ void wconv_tiled256(const float* __restrict__ src, int K, int N, bf16_t* dst, int ldd, LAS float* tile, int bid, int G) {
    const int tid = TIDX(); const int tn = N / 256, ntiles = (K / 64) * tn;
    const int lane = tid & 63, wave = tid >> 6;
    for (int t = bid; t < ntiles; t += G) {
        const int k0 = (t / tn) * 64, n0 = (t % tn) * 256;
        f32x4 v[8];
#pragma unroll
        for (int i = 0; i < 8; ++i) { const int idx = tid + 512 * i, kk = idx >> 6, n4 = idx & 63; v[i] = *(const f32x4*)(src + (size_t)(k0 + kk) * N + n0 + n4 * 4); }
#pragma unroll
        for (int i = 0; i < 8; ++i) { const int idx = tid + 512 * i, kk = idx >> 6, n4 = idx & 63; *(LAS f32x4*)(tile + kk * 260 + n4 * 4) = v[i]; }
        __syncthreads();
        { const int n = lane + 64 * (wave & 3);
#pragma unroll
          for (int q = 0; q < 4; ++q) { const int kc = 4 * (wave >> 2) + q; float x[8];
#pragma unroll
            for (int j = 0; j < 8; ++j) x[j] = tile[(kc * 8 + j) * 260 + n];
            u32x4 w; w.x = cvt_pk_bf16(x[0], x[1]); w.y = cvt_pk_bf16(x[2], x[3]); w.z = cvt_pk_bf16(x[4], x[5]); w.w = cvt_pk_bf16(x[6], x[7]);
            *(u32x4*)(dst + (size_t)(n0 + n) * ldd + k0 + kc * 8) = w; } }
        __syncthreads();
    }
}
__device__ void wconv_tiled_frag(const float* __restrict__ src, int N, bf16_t* dst, int nrow0, LAS float* tile, int bid, int G) {
    const int tid = TIDX(); const int tn = N / 64, ntiles = 16 * tn;
    for (int t = bid; t < ntiles; t += G) {
        const int k0 = (t / tn) * 64, n0 = (t % tn) * 64;
#pragma unroll
        for (int i = 0; i < 8; ++i) { const int idx = tid + 512 * i, kk = idx >> 6, nn = idx & 63; tile[kk * 65 + nn] = src[(size_t)(k0 + kk) * N + n0 + nn]; }
        __syncthreads();
        { const int n = tid >> 3, kc = tid & 7; float v[8];
#pragma unroll
          for (int j = 0; j < 8; ++j) v[j] = tile[(kc * 8 + j) * 65 + n];
          u32x4 w; w.x = cvt_pk_bf16(v[0], v[1]); w.y = cvt_pk_bf16(v[2], v[3]); w.z = cvt_pk_bf16(v[4], v[5]); w.w = cvt_pk_bf16(v[6], v[7]);
          const int na = nrow0 + n0 + n, k = k0 + kc * 8;
          *(u32x4*)(dst + ((size_t)(((na >> 4) * 32 + (k >> 5)) * 64 + ((k >> 3) & 3) * 16 + (na & 15))) * 8) = w; }
        __syncthreads();
    }
}
__device__ void wconv_direct(const float* __restrict__ src, int K, int N, bf16_t* dst) {
    const int gsz = GDIM() * NTHREADS;
    for (int e = BIDX() * NTHREADS + TIDX(); e < K * N; e += gsz) { const int n = e / K, k = e - n * K; dst[e] = f2bf(src[(size_t)k * N + n]); }
}
__device__ void wconv_mlp(KP p, int l, LAS float* tile) {
    const int G = GDIM(), b = BIDX();
    wconv_tiled256(p->in[I_M1] + (size_t)l * D * DFF, D, DFF, (bf16_t*)(p->ws + W_MLP1T), D, tile, b, G);
    wconv_tiled256(p->in[I_M2] + (size_t)l * D * DFF, DFF, D, (bf16_t*)(p->ws + W_MLP2T), DFF, tile, b, G);
}
__device__ void wconv_sgu(KP p, int l, LAS float* tile) {
    const int i = l >> 1, G = GDIM(), b = BIDX();
    wconv_tiled256(p->in[I_SWIN] + (size_t)i * D * 2048, D, 2048, (bf16_t*)(p->ws + W_INT), D, tile, b, G);
    wconv_tiled256(p->in[I_SWOUT] + (size_t)i * D * D, D, D, (bf16_t*)(p->ws + W_OUTT), D, tile, (b + 128) % G, G);
    { const float* s = p->in[I_SWS] + (size_t)i * 16 * 128 * 128; bf16_t* d = (bf16_t*)(p->ws + W_S);
      for (int e = BIDX() * NTHREADS + TIDX(); e < 16 * 128 * 128; e += G * NTHREADS) d[e] = f2bf(s[e]); }
    wconv_mlp(p, l, tile);
}
__device__ void wconv_rwkv_main(KP p, int l, LAS float* tile) {
    const int il = l >> 1, G = GDIM(), b = BIDX();
    wconv_tiled256(p->in[I_WR] + (size_t)il * D * D, D, D, (bf16_t*)(p->ws + W_RT), D, tile, b, G);
    wconv_tiled256(p->in[I_WK] + (size_t)il * D * D, D, D, (bf16_t*)(p->ws + W_KT), D, tile, (b + 64) % G, G);
    wconv_tiled256(p->in[I_WV] + (size_t)il * D * D, D, D, (bf16_t*)(p->ws + W_VT), D, tile, (b + 128) % G, G);
    wconv_tiled256(p->in[I_WO] + (size_t)il * D * D, D, D, (bf16_t*)(p->ws + W_OT), D, tile, (b + 192) % G, G);
    for (int d = 0; d < 2; ++d) {
        wconv_direct(p->in[I_W2] + (size_t)(il * 2 + d) * 64 * D, 64, D, (bf16_t*)(p->ws + W_W2T) + (size_t)d * D * 64);
        wconv_direct(p->in[I_A2] + (size_t)(il * 2 + d) * 64 * D, 64, D, (bf16_t*)(p->ws + W_A2T) + (size_t)d * D * 64);
    }
    if (il == 1) wconv_direct(p->in[I_V2], 32, D, (bf16_t*)(p->ws + W_V2T));
    wconv_direct(p->in[I_G2] + (size_t)il * 128 * D, 128, D, (bf16_t*)(p->ws + W_G2T));
    wconv_mlp(p, l, tile);
}
__device__ void wconv_rwkv_lora_down(KP p, int l, LAS float* tile) {
    const int il = l >> 1, G = GDIM(), b = BIDX();
    bf16_t* ld = (bf16_t*)(p->ws + W_LD);
    for (int d = 0; d < 2; ++d) {
        wconv_tiled_frag(p->in[I_W1] + (size_t)(il * 2 + d) * D * 64, 64, ld, d * 64, tile, (b + d * 16) % G, G);
        wconv_tiled_frag(p->in[I_A1] + (size_t)(il * 2 + d) * D * 64, 64, ld, 128 + d * 64, tile, (b + 32 + d * 16) % G, G);
    }
    wconv_tiled_frag(p->in[I_G1] + (size_t)il * D * 128, 128, ld, 256, tile, (b + 64) % G, G);
    if (il == 1) {
        const float* src = p->in[I_V1];
        for (int e = BIDX() * NTHREADS + TIDX(); e < D * 32; e += G * NTHREADS) { const int k = e >> 5, na = 384 + (e & 31);
            ld[((size_t)(((na >> 4) * 32 + (k >> 5)) * 64 + ((k >> 3) & 3) * 16 + (na & 15))) * 8 + (k & 7)] = f2bf(src[e]); }
    }
}

__device__ void ada_phase(KP p, LAS unsigned char* lds) {
    LAS float* sc = (LAS float*)lds;
    LAS float* red = sc + 9 * 1024;
    const int tid = TIDX(), G = GDIM();
    float* mod = (float*)(p->ws + WS_MOD);
    if ((int)BIDX() < 192) {
        for (int e = tid; e < 9 * 1024; e += NTHREADS) { const int r = e >> 10, k = e & 1023; const float x = r == 0 ? p->in[I_CCTX][k] : p->in[I_C][(r - 1) * 1024 + k]; sc[e] = x * rcpf_(1.0f + __expf(-x)); }
        __syncthreads();
    }
    for (int item = BIDX(); item < 192; item += G) {
        const int l = item / 48, c0 = (item % 48) * 128, col4 = tid & 31, kq = tid >> 5;
        const float* wp = p->in[I_ADAW] + ((size_t)l * 1024 + kq * 64) * 6144 + c0 + col4 * 4;
        f32x4 acc[9];
#pragma unroll
        for (int r = 0; r < 9; ++r) acc[r] = (f32x4){0.f, 0.f, 0.f, 0.f};
#pragma unroll 8
        for (int kk = 0; kk < 64; ++kk) {
            const f32x4 w = *(const f32x4*)(wp + (size_t)kk * 6144);
#pragma unroll
            for (int r = 0; r < 9; ++r) acc[r] += sc[r * 1024 + kq * 64 + kk] * w;
        }
#pragma unroll
        for (int r = 0; r < 9; ++r) *(LAS f32x4*)(red + ((kq * 9 + r) * 128 + col4 * 4)) = acc[r];
        __syncthreads();
        for (int o = tid; o < 9 * 128; o += NTHREADS) {
            const int r = o >> 7, cc = o & 127; float s = p->in[I_ADAB][l * 6144 + c0 + cc];
#pragma unroll
            for (int q = 0; q < 16; ++q) s += red[(q * 9 + r) * 128 + cc];
            mod[(size_t)(l * 9 + r) * 6144 + c0 + cc] = s;
        }
        __syncthreads();
    }
}

__device__ void norm_phase(KP p, int l, int which, bool from_input, bf16_t* H) {
    const int lane = TIDX() & 63, gw = BIDX() * 8 + (TIDX() >> 6), nw = GDIM() * 8;
    const float* g = p->in[which ? I_N2G : I_N1G] + l * D;
    const float* mod = (const float*)(p->ws + WS_MOD);
    f32x4 ggr[4];
#pragma unroll
    for (int i = 0; i < 4; ++i) ggr[i] = *(const f32x4*)(g + i * 256 + lane * 4);
    for (int row = gw; row < T; row += 4 * nw) {
        f32x4 v[4][4]; int rws[4]; bool has[4];
#pragma unroll
        for (int q = 0; q < 4; ++q) {
            rws[q] = row + q * nw; has[q] = rws[q] < T;
            const float* xp = xrow_ptr(p, from_input, has[q] ? rws[q] : row);
#pragma unroll
            for (int i = 0; i < 4; ++i) v[q][i] = *(const f32x4*)(xp + i * 256 + lane * 4);
        }
#pragma unroll
        for (int q = 0; q < 4; ++q) {
            if (!has[q]) break;
            const int r_ = rws[q];
            const float* md = mod + (size_t)(l * 9 + cond_row(r_)) * 6144 + (which ? 3072 : 0);
            float ss = 0.f;
#pragma unroll
            for (int i = 0; i < 4; ++i) { const f32x4 x = v[q][i]; ss += x[0] * x[0] + x[1] * x[1] + x[2] * x[2] + x[3] * x[3]; }
            ss = wave_sum(ss);
            const float rstd = rsqrtf(ss * (1.0f / 1024.0f) + 1e-6f);
#pragma unroll
            for (int i = 0; i < 4; ++i) {
                const int c = i * 256 + lane * 4;
                const f32x4 gg = ggr[i], sh = *(const f32x4*)(md + c), sc = *(const f32x4*)(md + 1024 + c);
                const f32x4 o = v[q][i] * rstd * gg * (1.0f + sc) + sh;
                u32x2 w; w.x = cvt_pk_bf16(o[0], o[1]); w.y = cvt_pk_bf16(o[2], o[3]);
                *(u32x2*)(H + (size_t)r_ * D + c) = w;
            }
        }
    }
}
__device__ void final_norm_phase(KP p) {
    const int lane = TIDX() & 63, gw = BIDX() * 8 + (TIDX() >> 6), nw = GDIM() * 8;
    const float* g = p->in[I_FG];
    f32x4 gv[4];
#pragma unroll
    for (int i = 0; i < 4; ++i) gv[i] = *(const f32x4*)(g + i * 256 + lane * 4);
    for (int row = gw; row < T; row += 4 * nw) {
        f32x4 v[4][4]; bool has[4];
#pragma unroll
        for (int q = 0; q < 4; ++q) {
            has[q] = row + q * nw < T;
            const float* xp = p->out + (size_t)(has[q] ? row + q * nw : row) * D;
#pragma unroll
            for (int i = 0; i < 4; ++i) v[q][i] = *(const f32x4*)(xp + i * 256 + lane * 4);
        }
#pragma unroll
        for (int q = 0; q < 4; ++q) {
            if (!has[q]) break;
            float* xp = p->out + (size_t)(row + q * nw) * D;
            float ss = 0.f;
#pragma unroll
            for (int i = 0; i < 4; ++i) { const f32x4 x = v[q][i]; ss += x[0] * x[0] + x[1] * x[1] + x[2] * x[2] + x[3] * x[3]; }
            ss = wave_sum(ss);
            const float rstd = rsqrtf(ss * (1.0f / 1024.0f) + 1e-6f);
#pragma unroll
            for (int i = 0; i < 4; ++i) __builtin_nontemporal_store(v[q][i] * rstd * gv[i], (f32x4*)(xp + i * 256 + lane * 4));
        }
    }
}

constexpr int HBS = 1028;
__device__ void rmix_phase(KP p, int l, LAS unsigned char* lds) {
    const int il = l >> 1;
    LAS float* hb = (LAS float*)lds;
    const int tid = TIDX(), lane = tid & 63, wave = tid >> 6, G = GDIM();
    const float* g = p->in[I_N1G] + l * D;
    const float* mu = p->in[I_MU] + (size_t)il * 6 * D;
    const float* mod = (const float*)(p->ws + WS_MOD);
    bf16_t* XR = (bf16_t*)(p->ws + BIG(1)); bf16_t* XK = (bf16_t*)(p->ws + BIG(2)); bf16_t* XV = (bf16_t*)(p->ws + BIG(3));
    const bf16_t* LD = (const bf16_t*)(p->ws + W_LD);
    LAS float* mul = (LAS float*)(lds + 76 * 1024);
    for (int e = tid; e < 6 * 256; e += NTHREADS) *(LAS f32x4*)(mul + 4 * e) = *(const f32x4*)(mu + 4 * e);
    __syncthreads();
#define RMIX_LOADROWS(tile_) do { const int t0_ = (tile_) * 16; \
        const int s0_ = t0_ < TC ? (t0_ & ~255) : TC + ((t0_ - TC) & ~2047), L_ = t0_ < TC ? 256 : 2048; \
        _Pragma("unroll") for (int ri = 0; ri < 3; ++ri) { \
            const int r = wave + 8 * ri, t = t0_ - 1 + r; \
            ok[ri] = (r < 18) && (t >= s0_) && (t < s0_ + L_); \
            if (ok[ri]) { const float* xp = p->out + (size_t)t * D; \
                _Pragma("unroll") for (int i = 0; i < 4; ++i) v[ri][i] = *(const f32x4*)(xp + i * 256 + lane * 4); } \
            else { _Pragma("unroll") for (int i = 0; i < 4; ++i) v[ri][i] = (f32x4){0.f, 0.f, 0.f, 0.f}; } } } while (0)
    f32x4 v[3][4]; bool ok[3];
    if (BIDX() < T / 16) RMIX_LOADROWS(BIDX());
    for (int tile = BIDX(); tile < T / 16; tile += G) {
        const int t0 = tile * 16;
        const float* md = mod + (size_t)(l * 9 + cond_row(t0)) * 6144;
        {
#pragma unroll
            for (int ri = 0; ri < 3; ++ri) {
                const int r = wave + 8 * ri;
                if (r < 18) {
                    float ss = 0.f;
#pragma unroll
                    for (int i = 0; i < 4; ++i) ss += v[ri][i][0] * v[ri][i][0] + v[ri][i][1] * v[ri][i][1] + v[ri][i][2] * v[ri][i][2] + v[ri][i][3] * v[ri][i][3];
                    ss = wave_sum(ss);
                    const float rstd = rsqrtf(ss * (1.0f / 1024.0f) + 1e-6f);
#pragma unroll
                    for (int i = 0; i < 4; ++i) {
                        const int c = i * 256 + lane * 4;
                        const f32x4 gg = *(const f32x4*)(g + c), sh = *(const f32x4*)(md + c), sc = *(const f32x4*)(md + 1024 + c);
                        *(LAS f32x4*)(hb + r * HBS + c) = ok[ri] ? (v[ri][i] * rstd * gg * (1.0f + sc) + sh) : (f32x4){0.f, 0.f, 0.f, 0.f};
                    }
                }
            }
        }
        __syncthreads();
        {
            const int row = tid >> 5, q = tid & 31;
#pragma unroll
            for (int pc = 0; pc < 4; ++pc) {
                const int c = pc * 256 + q * 8;
                f32x4 hp[2], hc[2], hn[2], xx[2];
#pragma unroll
                for (int e = 0; e < 2; ++e) { hp[e] = *(const LAS f32x4*)(hb + row * HBS + c + 4 * e); hc[e] = *(const LAS f32x4*)(hb + (row + 1) * HBS + c + 4 * e); hn[e] = *(const LAS f32x4*)(hb + (row + 2) * HBS + c + 4 * e);
                    xx[e] = 0.5f * (hp[e] + hn[e]) - hc[e]; }
                const size_t off = (size_t)(t0 + row) * D + c;
#pragma unroll
                for (int jj = 0; jj < 3; ++jj) {
                    const int j = jj == 0 ? 0 : (jj == 1 ? 2 : 3);
                    const f32x4 m0 = *(const LAS f32x4*)(mul + j * D + c), m1 = *(const LAS f32x4*)(mul + j * D + c + 4);
                    const f32x4 o0 = hc[0] + xx[0] * m0, o1 = hc[1] + xx[1] * m1;
                    u32x4 w; w.x = cvt_pk_bf16(o0[0], o0[1]); w.y = cvt_pk_bf16(o0[2], o0[3]); w.z = cvt_pk_bf16(o1[0], o1[1]); w.w = cvt_pk_bf16(o1[2], o1[3]);
                    bf16_t* dst = jj == 0 ? XR : (jj == 1 ? XK : XV);
                    *(u32x4*)(dst + off) = w;
                }
            }
        }
        if (tile + G < T / 16) RMIX_LOADROWS(tile + G);
        if (wave < 6 || (wave == 6 && il == 1)) {
            int jmu, nrow0, ntl, act, ldo, oc0; bf16_t* outp;
            if (wave < 2) { jmu = 1; nrow0 = wave * 64; ntl = 4; act = 1; outp = (bf16_t*)(p->ws + WS_TW); ldo = 128; oc0 = wave * 64; }
            else if (wave < 4) { jmu = 4; nrow0 = 128 + (wave - 2) * 64; ntl = 4; act = 0; outp = (bf16_t*)(p->ws + WS_A1O); ldo = 128; oc0 = (wave - 2) * 64; }
            else if (wave < 6) { jmu = 5; nrow0 = 256 + (wave - 4) * 64; ntl = 4; act = 2; outp = (bf16_t*)(p->ws + WS_SG); ldo = 128; oc0 = (wave - 4) * 64; }
            else { jmu = 3; nrow0 = 384; ntl = 2; act = 0; outp = (bf16_t*)(p->ws + WS_V1O); ldo = 32; oc0 = 0; }
            const int tok = lane & 15, kg = lane >> 4;
            f32x4 acc[4];
#pragma unroll
            for (int n = 0; n < 4; ++n) acc[n] = (f32x4){0.f, 0.f, 0.f, 0.f};
            const LAS float* mup = mul + jmu * D;
            for (int ks0 = 0; ks0 < 32; ks0 += 4) {
                bf16x8 af[4][4];
#pragma unroll
                for (int kk = 0; kk < 4; ++kk)
#pragma unroll
                    for (int n = 0; n < 4; ++n) if (n < ntl) af[kk][n] = *(const bf16x8*)(LD + ((size_t)(((nrow0 >> 4) + n) * 32 + ks0 + kk) * 64 + lane) * 8);
#pragma unroll
                for (int kk = 0; kk < 4; ++kk) {
                    const int k = (ks0 + kk) * 32 + kg * 8;
                    float xm[8];
#pragma unroll
                    for (int e = 0; e < 2; ++e) {
                        const f32x4 hp = *(const LAS f32x4*)(hb + tok * HBS + k + 4 * e), hc = *(const LAS f32x4*)(hb + (tok + 1) * HBS + k + 4 * e), hn = *(const LAS f32x4*)(hb + (tok + 2) * HBS + k + 4 * e);
                        const f32x4 m = *(const LAS f32x4*)(mup + k + 4 * e);
                        const f32x4 o = hc + (0.5f * (hp + hn) - hc) * m;
                        xm[4 * e] = o[0]; xm[4 * e + 1] = o[1]; xm[4 * e + 2] = o[2]; xm[4 * e + 3] = o[3];
                    }
                    u32x4 bw; bw.x = cvt_pk_bf16(xm[0], xm[1]); bw.y = cvt_pk_bf16(xm[2], xm[3]); bw.z = cvt_pk_bf16(xm[4], xm[5]); bw.w = cvt_pk_bf16(xm[6], xm[7]);
                    const bf16x8 bfrag = __builtin_bit_cast(bf16x8, bw);
#pragma unroll
                    for (int n = 0; n < 4; ++n) if (n < ntl) acc[n] = __builtin_amdgcn_mfma_f32_16x16x32_bf16(af[kk][n], bfrag, acc[n], 0, 0, 0);
                }
            }
#pragma unroll
            for (int n = 0; n < 4; ++n) if (n < ntl) {
                f32x4 v = acc[n];
#pragma unroll
                for (int j = 0; j < 4; ++j) v[j] = act == 1 ? tanhf_(v[j]) : (act == 2 ? sigmoidf_(v[j]) : v[j]);
                u32x2 w; w.x = cvt_pk_bf16(v[0], v[1]); w.y = cvt_pk_bf16(v[2], v[3]);
                *(u32x2*)(outp + (size_t)(t0 + tok) * ldo + oc0 + n * 16 + kg * 4) = w;
            }
        }
        __syncthreads();
    }
}

__device__ void sgu_mix_phase(KP p, int l, LAS unsigned char* lds) {
    const int i = l >> 1;
    LAS bf16_t* vt = (LAS bf16_t*)lds;
    const int tid = TIDX(), lane = tid & 63, wave = tid >> 6, G = GDIM();
    const float* lng = p->in[I_SLNG] + i * D; const float* lnb = p->in[I_SLNB] + i * D; const float* bs = p->in[I_SBS] + i * 16 * 128;
    const float* vst = (const float*)(p->ws + WS_VST);
    const bf16_t* U = (const bf16_t*)(p->ws + BIG(2)); const bf16_t* V = (const bf16_t*)(p->ws + BIG(3)); bf16_t* UV = (bf16_t*)(p->ws + BIG(4));
    const bf16_t* WS = (const bf16_t*)(p->ws + W_S);
    const int g = BIDX() & 15;
    f32x4 lgr[4], lbr[4];
    { const int c0 = 64 * g + (tid & 3) * 16;
#pragma unroll
      for (int e = 0; e < 4; ++e) { lgr[e] = *(const f32x4*)(lng + c0 + 4 * e); lbr[e] = *(const f32x4*)(lnb + c0 + 4 * e); } }
    bf16x8 wfr[4];
#pragma unroll
    for (int ks = 0; ks < 4; ++ks) wfr[ks] = *(const bf16x8*)(WS + ((size_t)g * 128 + wave * 16 + (lane & 15)) * 128 + ks * 32 + (lane >> 4) * 8);
    for (int ch = (BIDX() < (G & ~15)) ? (BIDX() >> 4) : T; ch < T / 128; ch += (G >> 4)) {
        {
            const int s = tid >> 2, q = tid & 3, tok = ch * 128 + s, c0 = 64 * g + q * 16;
            float a1, a2;
            { const f32x4 p0 = *(const f32x4*)(vst + (size_t)tok * 32 + 8 * q), p1 = *(const f32x4*)(vst + (size_t)tok * 32 + 8 * q + 4);
              a1 = (p0[0] + p0[2]) + (p1[0] + p1[2]); a2 = (p0[1] + p0[3]) + (p1[1] + p1[3]);
              a1 += dpp_f<0xB1>(a1); a1 += dpp_f<0x4E>(a1); a2 += dpp_f<0xB1>(a2); a2 += dpp_f<0x4E>(a2); }
            const float m1 = a1 * (1.0f / 1024.0f), m2 = a2 * (1.0f / 1024.0f);
            const float rstd = rsqrtf(fmaxf(m2 - m1 * m1, 0.f) + 1e-6f);
            const u32x4 a = *(const u32x4*)(V + (size_t)tok * D + c0), b = *(const u32x4*)(V + (size_t)tok * D + c0 + 8);
            const unsigned wv[8] = {a.x, a.y, a.z, a.w, b.x, b.y, b.z, b.w};
#pragma unroll
            for (int e = 0; e < 8; ++e) {
                const float x0 = (bflo(wv[e]) - m1) * rstd * lgr[e >> 1][(2 * e) & 3] + lbr[e >> 1][(2 * e) & 3], x1 = (bfhi(wv[e]) - m1) * rstd * lgr[e >> 1][(2 * e + 1) & 3] + lbr[e >> 1][(2 * e + 1) & 3];
                vt[(q * 16 + 2 * e) * 136 + s] = f2bf(x0); vt[(q * 16 + 2 * e + 1) * 136 + s] = f2bf(x1);
            }
        }
        __syncthreads();
        {
            const int tl = lane & 15, kg = lane >> 4, tt = wave * 16 + tl;
            f32x4 acc[4];
#pragma unroll
            for (int n = 0; n < 4; ++n) acc[n] = (f32x4){0.f, 0.f, 0.f, 0.f};
#pragma unroll
            for (int ks = 0; ks < 4; ++ks) {
                const bf16x8 bfrag = wfr[ks];
#pragma unroll
                for (int n = 0; n < 4; ++n) {
                    const bf16x8 afrag = *(const LAS bf16x8*)(vt + (n * 16 + tl) * 136 + ks * 32 + kg * 8);
                    acc[n] = __builtin_amdgcn_mfma_f32_16x16x32_bf16(afrag, bfrag, acc[n], 0, 0, 0);
                }
            }
            const int tok = ch * 128 + tt; const float bb = bs[g * 128 + tt];
#pragma unroll
            for (int n = 0; n < 4; ++n) {
                const int c = 64 * g + n * 16 + kg * 4;
                const u32x2 uu = *(const u32x2*)(U + (size_t)tok * D + c);
                const float o0 = (acc[n][0] + bb) * bflo(uu.x), o1 = (acc[n][1] + bb) * bfhi(uu.x), o2 = (acc[n][2] + bb) * bflo(uu.y), o3 = (acc[n][3] + bb) * bfhi(uu.y);
                u32x2 w; w.x = cvt_pk_bf16(o0, o1); w.y = cvt_pk_bf16(o2, o3);
                *(u32x2*)(UV + (size_t)tok * D + c) = w;
            }
        }
        __syncthreads();
    }
}

constexpr int STS = 388;
constexpr int SCAN_HALF_BYTES = (2 * 16 * STS + 2 * 16 * 64) * 4;
#define SVX_GLOAD_A(P, tok0_, L_, d_, h_, chunk) do { const int tt_ = (chunk) * 16 + ts, t_ = (tok0_) + ((d_) ? (L_) - 1 - tt_ : tt_); \
    const unsigned hb_ = (unsigned)(t_ * D + (h_) * 64) * 2u; \
    P##k0 = *(const u32x2*)(wsb + (unsigned)(BIG(5) + hb_ + 8 * kgrp)); P##k1 = *(const u32x2*)(wsb + (unsigned)(BIG(5) + hb_ + 32 + 8 * kgrp)); \
    P##k2 = *(const u32x2*)(wsb + (unsigned)(BIG(5) + hb_ + 64 + 8 * kgrp)); P##k3 = *(const u32x2*)(wsb + (unsigned)(BIG(5) + hb_ + 96 + 8 * kgrp)); \
    P##r = *(const u32x2*)(wsb + (unsigned)(BIG(4) + hb_ + 2 * cown)); P##v = *(const u32x2*)(wsb + (unsigned)(vboff + hb_ + 2 * cown)); \
    if (il == 1) P##vf = *(const u32x2*)(wsb + (unsigned)(BIG(0) + hb_ + 2 * cown)); } while (0)
#define SVX_GLOAD_B(P, tok0_, L_, d_, h_, chunk) do { const int tt_ = (chunk) * 16 + ts, t_ = (tok0_) + ((d_) ? (L_) - 1 - tt_ : tt_); \
    const unsigned lo_ = (unsigned)(t_ * 128 + (d_) * 64 + kgrp * 8) * 2u; \
    P##tw0 = *(const bf16x8*)(wsb + (unsigned)(WS_TW + lo_)); P##tw1 = *(const bf16x8*)(wsb + (unsigned)(WS_TW + lo_ + 64)); \
    P##a0 = *(const bf16x8*)(wsb + (unsigned)(WS_A1O + lo_)); P##a1 = *(const bf16x8*)(wsb + (unsigned)(WS_A1O + lo_ + 64)); \
    if (il == 1) P##v1 = *(const bf16x8*)(wsb + (unsigned)(WS_V1O + (unsigned)(t_ * 32 + kgrp * 8) * 2u)); } while (0)
#define SVX_GLOAD(P, tok0_, L_, d_, h_, chunk) do { SVX_GLOAD_A(P, tok0_, L_, d_, h_, chunk); SVX_GLOAD_B(P, tok0_, L_, d_, h_, chunk); } while (0)
#define SVX_CONSTS(d_, h_) \
    const int ch_ = (h_) * 64 + cown; \
    const unsigned wrow_ = (unsigned)((d_) * D * 64 + ((h_) * 64 + 16 * hw + ts) * 64 + kgrp * 8) * 2u; \
    const bf16x8 wz0 = *(const bf16x8*)(wsb + (unsigned)(W_W2T + wrow_)), wz1 = *(const bf16x8*)(wsb + (unsigned)(W_W2T + wrow_ + 64)); \
    const bf16x8 wa0 = *(const bf16x8*)(wsb + (unsigned)(W_A2T + wrow_)), wa1 = *(const bf16x8*)(wsb + (unsigned)(W_A2T + wrow_ + 64)); \
    bf16x8 wv = wz0; f32x4 v0c = (f32x4){0.f, 0.f, 0.f, 0.f}; \
    if (il == 1) { wv = *(const bf16x8*)(wsb + (unsigned)(W_V2T + (unsigned)(((h_) * 64 + 16 * hw + ts) * 32 + kgrp * 8) * 2u)); v0c = *(const f32x4*)(p->in[I_V0] + ch_); } \
    const f32x4 w0c = *(const f32x4*)(p->in[I_W0] + (size_t)(il * 2 + (d_)) * D + ch_), a0c = *(const f32x4*)(p->in[I_A0] + (size_t)(il * 2 + (d_)) * D + ch_); \
    const f32x4 kac = *(const f32x4*)(p->in[I_KA] + il * D + ch_), rkc = *(const f32x4*)(p->in[I_RK] + il * D + ch_); \
    const float* kkp_ = p->in[I_KK] + il * D + (h_) * 64 + 4 * kgrp;
#define SVX_STAGE(P, tok0_, L_, d_, h_, chunk, stg_, bufi) do { const int tt_ = (chunk) * 16 + ts, t_ = (tok0_) + ((d_) ? (L_) - 1 - tt_ : tt_); \
    f32x4 accz = (f32x4){0.f, 0.f, 0.f, 0.f}, acca = accz; \
    accz = __builtin_amdgcn_mfma_f32_16x16x32_bf16(wz0, P##tw0, accz, 0, 0, 0); accz = __builtin_amdgcn_mfma_f32_16x16x32_bf16(wz1, P##tw1, accz, 0, 0, 0); \
    acca = __builtin_amdgcn_mfma_f32_16x16x32_bf16(wa0, P##a0, acca, 0, 0, 0); acca = __builtin_amdgcn_mfma_f32_16x16x32_bf16(wa1, P##a1, acca, 0, 0, 0); \
    f32x4 kf, kx, sq; \
    { const f32x4 kq_ = (f32x4){bflo(P##k0.x), bfhi(P##k0.x), bflo(P##k0.y), bfhi(P##k0.y)}; const f32x4 xq_ = kq_ * *(const f32x4*)(kkp_); sq = xq_ * xq_; kf = kq_; kx = xq_; } \
    { const f32x4 kq_ = (f32x4){bflo(P##k1.x), bfhi(P##k1.x), bflo(P##k1.y), bfhi(P##k1.y)}; const f32x4 xq_ = kq_ * *(const f32x4*)(kkp_ + 16); sq += xq_ * xq_; if (hw == 1) { kf = kq_; kx = xq_; } } \
    { const f32x4 kq_ = (f32x4){bflo(P##k2.x), bfhi(P##k2.x), bflo(P##k2.y), bfhi(P##k2.y)}; const f32x4 xq_ = kq_ * *(const f32x4*)(kkp_ + 32); sq += xq_ * xq_; if (hw == 2) { kf = kq_; kx = xq_; } } \
    { const f32x4 kq_ = (f32x4){bflo(P##k3.x), bfhi(P##k3.x), bflo(P##k3.y), bfhi(P##k3.y)}; const f32x4 xq_ = kq_ * *(const f32x4*)(kkp_ + 48); sq += xq_ * xq_; if (hw == 3) { kf = kq_; kx = xq_; } } \
    float ss = (sq[0] + sq[1]) + (sq[2] + sq[3]); ss += __shfl_xor(ss, 16); ss += __shfl_xor(ss, 32); \
    const float inv = __builtin_amdgcn_rsqf(fmaxf(ss, 1e-24f)); \
    const f32x4 zz = accz + w0c, ap = acca + a0c; \
    f32x4 nkk, wv_, bv_, kd_, rv_, vv_; \
    rv_ = (f32x4){bflo(P##r.x), bfhi(P##r.x), bflo(P##r.y), bfhi(P##r.y)}; vv_ = (f32x4){bflo(P##v.x), bfhi(P##v.x), bflo(P##v.y), bfhi(P##v.y)}; \
    if (il == 1) { f32x4 accv = (f32x4){0.f, 0.f, 0.f, 0.f}; accv = __builtin_amdgcn_mfma_f32_16x16x32_bf16(wv, P##v1, accv, 0, 0, 0); \
        const f32x4 vf_ = (f32x4){bflo(P##vf.x), bfhi(P##vf.x), bflo(P##vf.y), bfhi(P##vf.y)}; \
        _Pragma("unroll") for (int j = 0; j < 4; ++j) vv_[j] = vv_[j] + (vf_[j] - vv_[j]) * sigmoidf_(v0c[j] + accv[j]); \
        if ((d_) == 0) { u32x2 w_; w_.x = cvt_pk_bf16(vv_[0], vv_[1]); w_.y = cvt_pk_bf16(vv_[2], vv_[3]); *(u32x2*)(wsb + (unsigned)(BIG(7) + (unsigned)(t_ * D + (h_) * 64 + cown) * 2u)) = w_; } } \
    float bsum = 0.f; \
    _Pragma("unroll") for (int j = 0; j < 4; ++j) { \
        const float kk = kx[j] * inv, a = sigmoidf_(ap[j]); \
        const float lw = -0.6065306597f * sigmoidf_(zz[j]);            \
        float li = lw; li += dpp_f<0x111>(li); li += dpp_f<0x112>(li); li += dpp_f<0x114>(li); li += dpp_f<0x118>(li);     \
        const float pin = __expf(li), pex = __expf(li - lw), ipn = rcpf_(pin); \
        const float kdj = kf[j] * (1.0f + (a - 1.0f) * kac[j]); \
        bsum += rv_[j] * kdj * rkc[j]; \
        nkk[j] = -kk * pex; wv_[j] = pin; bv_[j] = kk * a * ipn; kd_[j] = kdj * ipn; rv_[j] = rv_[j] * pin; } \
    bsum += __shfl_xor(bsum, 16); bsum += __shfl_xor(bsum, 32); \
    if (kgrp == 0) *(float*)(wsb + (unsigned)(BIG(3) + (unsigned)((((d_) * T + t_) * 16 + (h_)) * 4 + hw) * 4u)) = bsum; \
    LAS float* sp_ = (stg_) + ((bufi) * 16 + ts) * STS + cown; \
    *(LAS f32x4*)(sp_) = nkk; *(LAS f32x4*)(sp_ + 64) = wv_; *(LAS f32x4*)(sp_ + 128) = bv_; *(LAS f32x4*)(sp_ + 192) = kd_; *(LAS f32x4*)(sp_ + 256) = rv_; *(LAS f32x4*)(sp_ + 320) = vv_; } while (0)
#define SVX_YSTORE(tok0_, L_, d_, h_, chunk, ybuf_, bufi) do { const int tt_ = (chunk) * 16 + ts, t_ = (tok0_) + ((d_) ? (L_) - 1 - tt_ : tt_); \
    const f32x4 y_ = *(const LAS f32x4*)((ybuf_) + ((bufi) * 16 + ts) * 64 + cown); \
    u32x2 w_; w_.x = cvt_pk_bf16(y_[0], y_[1]); w_.y = cvt_pk_bf16(y_[2], y_[3]); \
    *(u32x2*)(wsb + (unsigned)(BIG(1) + (unsigned)(d_) * (unsigned)BIGSZ + (unsigned)(t_ * D + (h_) * 64 + cown) * 2u)) = w_; } while (0)
#define SCAN_LDV(X, sp_) do { \
    X##nk0 = *(const LAS f32x4*)((sp_) + 8 * cg); X##nk1 = *(const LAS f32x4*)((sp_) + 8 * cg + 4); \
    X##b0 = *(const LAS f32x4*)((sp_) + 128 + 8 * cg); X##b1 = *(const LAS f32x4*)((sp_) + 128 + 8 * cg + 4); \
    X##k0 = *(const LAS f32x4*)((sp_) + 192 + 8 * cg); X##k1 = *(const LAS f32x4*)((sp_) + 192 + 8 * cg + 4); \
    X##r0 = *(const LAS f32x4*)((sp_) + 256 + 8 * cg); X##r1 = *(const LAS f32x4*)((sp_) + 256 + 8 * cg + 4); \
    X##vr = *(const LAS f32x2*)((sp_) + 320 + 16 * hw + 2 * rg); } while (0)
#define SCAN_STEP(X, yp_) do { \
    const f32x2 nk[4] = {{X##nk0[0], X##nk0[1]}, {X##nk0[2], X##nk0[3]}, {X##nk1[0], X##nk1[1]}, {X##nk1[2], X##nk1[3]}}; \
    const f32x2 bb[4] = {{X##b0[0], X##b0[1]}, {X##b0[2], X##b0[3]}, {X##b1[0], X##b1[1]}, {X##b1[2], X##b1[3]}}; \
    const f32x2 kd[4] = {{X##k0[0], X##k0[1]}, {X##k0[2], X##k0[3]}, {X##k1[0], X##k1[1]}, {X##k1[2], X##k1[3]}}; \
    const f32x2 rr[4] = {{X##r0[0], X##r0[1]}, {X##r0[2], X##r0[3]}, {X##r1[0], X##r1[1]}, {X##r1[2], X##r1[3]}}; \
    float yo[2]; \
    _Pragma("unroll") for (int a = 0; a < 2; ++a) { \
        f32x2 t = s[a][0] * nk[0]; t += s[a][1] * nk[1]; t += s[a][2] * nk[2]; t += s[a][3] * nk[3]; \
        const float sa = red8(t[0] + t[1]); \
        const f32x2 sa2 = (f32x2){sa, sa}, v2 = (f32x2){X##vr[a], X##vr[a]}; \
        _Pragma("unroll") for (int bp = 0; bp < 4; ++bp) s[a][bp] = s[a][bp] + sa2 * bb[bp] + v2 * kd[bp]; \
        f32x2 y = s[a][0] * rr[0]; y += s[a][1] * rr[1]; y += s[a][2] * rr[2]; y += s[a][3] * rr[3]; \
        yo[a] = y[0] + y[1]; } \
      \
    { float keep_ = cg < 4 ? yo[0] : yo[1]; const float send_ = cg < 4 ? yo[1] : yo[0]; \
      keep_ += dpp_f<0x141>(send_); keep_ += dpp_f<0xB1>(keep_); keep_ += dpp_f<0x4E>(keep_); \
      if ((cg & 3) == 0) *(LAS float*)((yp_) + (cg >> 2)) = keep_; } } while (0)
#define SCAN_RENORM(sp15_) do { const f32x4 p0_ = *(const LAS f32x4*)((sp15_) + 64 + 8 * cg), p1_ = *(const LAS f32x4*)((sp15_) + 64 + 8 * cg + 4); \
    const f32x2 pp_[4] = {{p0_[0], p0_[1]}, {p0_[2], p0_[3]}, {p1_[0], p1_[1]}, {p1_[2], p1_[3]}}; \
    _Pragma("unroll") for (int a = 0; a < 2; ++a) _Pragma("unroll") for (int bp = 0; bp < 4; ++bp) s[a][bp] = s[a][bp] * pp_[bp]; } while (0)
__device__ void scan_phase(KP p, int l, LAS unsigned char* lds) {
    const int il = l >> 1;
    const int tid = TIDX(), hb = tid >> 8, ht = tid & 255, hw = ht >> 6, lane = tid & 63, cg = lane & 7, rg = lane >> 3, G = GDIM();
    const int ts = lane & 15, kgrp = lane >> 4, cown = 16 * hw + 4 * kgrp;
    unsigned char* wsb = p->ws; const unsigned vboff = (unsigned)(il == 0 ? BIG(0) : BIG(6));
    LAS float* stg0 = (LAS float*)lds; LAS float* ybuf0 = stg0 + 2 * 16 * STS;
    LAS float* stg1 = (LAS float*)(lds + SCAN_HALF_BYTES); LAS float* ybuf1 = stg1 + 2 * 16 * STS;
    for (int slot = BIDX(); slot < 256; slot += G) {
        const int lh = (slot & 31) >> 1, ldir = slot & 1, ltok0 = TC + (slot >> 5) * 2048;
        f32x2 s[2][4];
        f32x4 Ank0, Ank1, Ab0, Ab1, Ak0, Ak1, Ar0, Ar1; f32x2 Avr;
        f32x4 Bnk0, Bnk1, Bb0, Bb1, Bk0, Bk1, Br0, Br1; f32x2 Bvr;
        if (hb == 0) {
            {
                const float* si = p->in[I_STATE] + ((size_t)(((slot >> 5) * 2 + il) * 2 + ldir) * 16 + lh) * 4096;
#pragma unroll
                for (int a = 0; a < 2; ++a)
#pragma unroll
                    for (int bp = 0; bp < 4; ++bp) s[a][bp] = *(const f32x2*)(si + (16 * hw + 2 * rg + a) * 64 + 8 * cg + 2 * bp);
                float one = 1.0f; asm volatile("" : "+v"(one));
#pragma unroll
                for (int a = 0; a < 2; ++a)
#pragma unroll
                    for (int bp = 0; bp < 4; ++bp) s[a][bp] = s[a][bp] * one;
            }
            for (int ci = 0; ci < 128; ++ci) {
                const int buf = ci & 1;
                LDS_BARRIER();
                __builtin_amdgcn_s_setprio(2);
                const LAS float* sb = stg0 + (buf * 16) * STS; LAS float* yb = ybuf0 + (buf * 16) * 64 + 16 * hw + 2 * rg;
                SCAN_LDV(A, sb);
#pragma unroll
                for (int st = 0; st < 16; st += 2) {
                    SCAN_LDV(B, sb + (st + 1) * STS);
                    SCAN_STEP(A, yb + st * 64);
                    if (st + 2 < 16) SCAN_LDV(A, sb + (st + 2) * STS);
                    SCAN_STEP(B, yb + (st + 1) * 64);
                }
                SCAN_RENORM(sb + 15 * STS);
                __builtin_amdgcn_s_setprio(0);
                LDS_BARRIER();
            }
        } else {
            u32x2 Lk0, Lk1, Lk2, Lk3, Lr, Lv, Lvf; bf16x8 Ltw0, Ltw1, La0, La1, Lv1;
            u32x2 Sk0, Sk1, Sk2, Sk3, Sr, Sv, Svf; bf16x8 Stw0, Stw1, Sa0, Sa1, Sv1;
            Lvf = Svf = (u32x2){0u, 0u}; Lv1 = Sv1 = (bf16x8){0, 0, 0, 0, 0, 0, 0, 0};
#pragma unroll
            for (int a = 0; a < 2; ++a)
#pragma unroll
                for (int bp = 0; bp < 4; ++bp) s[a][bp] = (f32x2){0.f, 0.f};
            {
                SVX_GLOAD(L, ltok0, 2048, ldir, lh, 0);
                const int sid = slot * 2, sh = (sid & 31) >> 1, sd = sid & 1, stok0 = (sid >> 5) * 256;
                SVX_GLOAD(S, stok0, 256, sd, sh, 0);
                { SVX_CONSTS(ldir, lh) SVX_STAGE(L, ltok0, 2048, ldir, lh, 0, stg0, 0); }
                { SVX_CONSTS(sd, sh) SVX_STAGE(S, stok0, 256, sd, sh, 0, stg1, 0); }
                SVX_GLOAD(L, ltok0, 2048, ldir, lh, 1);
            }
            SVX_CONSTS(ldir, lh)
            for (int ci = 0; ci < 128; ++ci) {
                const int buf = ci & 1;
                LDS_BARRIER();
                if (ci + 1 < 128) SVX_STAGE(L, ltok0, 2048, ldir, lh, ci + 1, stg0, buf ^ 1);
                __builtin_amdgcn_sched_barrier(0);
                if (ci + 2 < 128) SVX_GLOAD(L, ltok0, 2048, ldir, lh, ci + 2);
                __builtin_amdgcn_sched_barrier(0);
                const int cj = (ci >> 2) & 15, q = ci & 3, sbuf = cj & 1;
                {
                    const LAS float* sb = stg1 + (sbuf * 16 + 4 * q) * STS; LAS float* yb = ybuf1 + (sbuf * 16 + 4 * q) * 64 + 16 * hw + 2 * rg;
                    SCAN_LDV(A, sb); SCAN_STEP(A, yb); __builtin_amdgcn_sched_barrier(0);
                    SCAN_LDV(A, sb + STS); SCAN_STEP(A, yb + 64); __builtin_amdgcn_sched_barrier(0);
                    SCAN_LDV(A, sb + 2 * STS); SCAN_STEP(A, yb + 128); __builtin_amdgcn_sched_barrier(0);
                    SCAN_LDV(A, sb + 3 * STS); SCAN_STEP(A, yb + 192);
                    if (q == 3) SCAN_RENORM(stg1 + (sbuf * 16 + 15) * STS);
                }
                __builtin_amdgcn_sched_barrier(0);
                const int gc = (ci >> 2) + 1;
                if (gc < 32 && (q == 0 || q == 2)) {
                    const int sid = slot * 2 + (gc >> 4), sh = (sid & 31) >> 1, sd = sid & 1, stok0 = (sid >> 5) * 256;
                    if (q == 0) SVX_GLOAD_A(S, stok0, 256, sd, sh, gc & 15);
                    else { SVX_GLOAD_B(S, stok0, 256, sd, sh, gc & 15); SVX_CONSTS(sd, sh) SVX_STAGE(S, stok0, 256, sd, sh, gc & 15, stg1, gc & 1); }
                }
                LDS_BARRIER();
                SVX_YSTORE(ltok0, 2048, ldir, lh, ci, ybuf0, buf);
                {
                    const int sid = slot * 2 + (ci >> 6), sb_ = sid >> 5, sh = (sid & 31) >> 1, sd = sid & 1, stok0 = sb_ * 256;
                    if (q == 3) SVX_YSTORE(stok0, 256, sd, sh, cj, ybuf1, sbuf);
                    if ((ci & 63) == 63) {
                        float* so = p->out + (size_t)T * D + ((size_t)((sb_ * 2 + il) * 2 + sd) * 16 + sh) * 4096;
#pragma unroll
                        for (int a = 0; a < 2; ++a)
#pragma unroll
                            for (int bp = 0; bp < 4; ++bp) { *(f32x2*)(so + (16 * hw + 2 * rg + a) * 64 + 8 * cg + 2 * bp) = s[a][bp]; s[a][bp] = (f32x2){0.f, 0.f}; }
                    }
                }
            }
        }
        __syncthreads();
    }
}

__device__ void post_phase(KP p, int l) {
    const int il = l >> 1;
    const int lane = TIDX() & 63, gw = BIDX() * 8 + (TIDX() >> 6), nw = GDIM() * 8;
    const int tl = lane & 15, kg = lane >> 4;
    const bf16_t* G2T = (const bf16_t*)(p->ws + W_G2T); const bf16_t* SG = (const bf16_t*)(p->ws + WS_SG);
    const bf16_t* Y0 = (const bf16_t*)(p->ws + BIG(1)); const bf16_t* Y1 = (const bf16_t*)(p->ws + BIG(2));
    const bf16_t* Vb = (const bf16_t*)(p->ws + (il == 0 ? BIG(0) : BIG(7)));
    bf16_t* YG = (bf16_t*)(p->ws + BIG(4));
    const float* BONP = (const float*)(p->ws + BIG(3));
    const float* lng = p->in[I_LNG] + il * D; const float* lnb = p->in[I_LNB] + il * D;
    const int h = gw & 15, tlanes = nw >> 4;
    bf16x8 gfr[4][4]; f32x4 lgv[4], lbv[4];
#pragma unroll
    for (int n = 0; n < 4; ++n) {
#pragma unroll
        for (int ks = 0; ks < 4; ++ks) gfr[ks][n] = *(const bf16x8*)(G2T + (size_t)(h * 64 + n * 16 + tl) * 128 + ks * 32 + kg * 8);
        lgv[n] = *(const f32x4*)(lng + h * 64 + n * 16 + kg * 4); lbv[n] = *(const f32x4*)(lnb + h * 64 + n * 16 + kg * 4);
    }
    for (int tile = (gw < (nw & ~15)) ? (gw >> 4) : T; tile < T / 16; tile += tlanes) {
        const int tok0 = tile * 16, tk = tok0 + tl;
        f32x4 ag[4];
#pragma unroll
        for (int n = 0; n < 4; ++n) ag[n] = (f32x4){0.f, 0.f, 0.f, 0.f};
#pragma unroll
        for (int ks = 0; ks < 4; ++ks) {
            const bf16x8 bg = *(const bf16x8*)(SG + (size_t)tk * 128 + ks * 32 + kg * 8);
#pragma unroll
            for (int n = 0; n < 4; ++n) ag[n] = __builtin_amdgcn_mfma_f32_16x16x32_bf16(gfr[ks][n], bg, ag[n], 0, 0, 0);
        }
        f32x4 y[4]; float s1 = 0.f;
#pragma unroll
        for (int n = 0; n < 4; ++n) {
            const size_t off = (size_t)tk * D + h * 64 + n * 16 + kg * 4;
            const u32x2 a = *(const u32x2*)(Y0 + off), b = *(const u32x2*)(Y1 + off);
            y[n] = (f32x4){bflo(a.x) + bflo(b.x), bfhi(a.x) + bfhi(b.x), bflo(a.y) + bflo(b.y), bfhi(a.y) + bfhi(b.y)};
            s1 += y[n][0] + y[n][1] + y[n][2] + y[n][3];
        }
        s1 += __shfl_xor(s1, 16); s1 += __shfl_xor(s1, 32);
        const float mean = s1 * (1.0f / 64.0f); float s2 = 0.f;
#pragma unroll
        for (int n = 0; n < 4; ++n)
#pragma unroll
            for (int j = 0; j < 4; ++j) { const float dd = y[n][j] - mean; s2 += dd * dd; }
        s2 += __shfl_xor(s2, 16); s2 += __shfl_xor(s2, 32);
        const float rstd = rsqrtf(s2 * (1.0f / 64.0f) + 64e-5f);
        const f32x4 bq0 = *(const f32x4*)(BONP + ((size_t)tk * 16 + h) * 4), bq1 = *(const f32x4*)(BONP + ((size_t)(T + tk) * 16 + h) * 4);
        const float bon = ((bq0[0] + bq0[1]) + (bq0[2] + bq0[3])) + ((bq1[0] + bq1[1]) + (bq1[2] + bq1[3]));
#pragma unroll
        for (int n = 0; n < 4; ++n) {
            const int c = h * 64 + n * 16 + kg * 4; const size_t off = (size_t)tk * D + c;
            const u32x2 vv = *(const u32x2*)(Vb + off);
            const float vx[4] = {bflo(vv.x), bfhi(vv.x), bflo(vv.y), bfhi(vv.y)};
            const f32x4 gg = lgv[n], gb = lbv[n];
            float o[4];
#pragma unroll
            for (int j = 0; j < 4; ++j) o[j] = ((y[n][j] - mean) * rstd * gg[j] + gb[j] + bon * vx[j]) * ag[n][j];
            u32x2 w; w.x = cvt_pk_bf16(o[0], o[1]); w.y = cvt_pk_bf16(o[2], o[3]);
            *(u32x2*)(YG + off) = w;
        }
    }
}


#define XB_TMO      128
#define XB_XCNT(j)  (256  + 64 * (j))
#define XB_XSUB(j)  (1280 + 64 * (j))
#define XB_XGEN(j)  (2304 + 64 * (j))
#define XB_TOP      3328
#define XB_TOPGEN   3392
#define XCD_BAR_WORDS 3456
#define XB_SPIN_CAP (1u << 22)
__device__ __forceinline__ unsigned xb_ld(unsigned* p)              { return __hip_atomic_load(p, __ATOMIC_RELAXED, __HIP_MEMORY_SCOPE_AGENT); }
__device__ __forceinline__ unsigned xb_add(unsigned* p, unsigned v) { return __hip_atomic_fetch_add(p, v, __ATOMIC_RELAXED, __HIP_MEMORY_SCOPE_AGENT); }
__device__ __forceinline__ unsigned xb_xcc_id() { return (unsigned)__builtin_amdgcn_s_getreg((3 << 11) | 20) & 0xFu; }
#define XB_SPIN(cond, bar) do { unsigned _sp = 0; while (cond) { __builtin_amdgcn_s_sleep(1); \
    if ((++_sp & 255u) == 0u) { if (xb_ld(&(bar)[XB_TMO])) break; if (_sp > XB_SPIN_CAP) { atomicAdd(&(bar)[XB_TMO], 1u); break; } } } } while (0)
__device__ __forceinline__ void xcd_barrier_complete(unsigned* bar, unsigned x, unsigned& nloc, unsigned& nx) {
    const unsigned G = gridDim.x;
    unsigned sum, cnt, mine, sp = 0u;
    for (;;) {
        sum = 0u; cnt = 0u; mine = 0u;
#pragma unroll
        for (unsigned j = 0; j < 16; ++j) { const unsigned c = xb_ld(&bar[XB_XCNT(j)]); sum += c; cnt += (c > 0u) ? 1u : 0u; mine = (j == x) ? c : mine; }
        if (sum == G) break;
        __builtin_amdgcn_s_sleep(1);
        if ((++sp & 255u) == 0u) { if (xb_ld(&bar[XB_TMO])) break; if (sp > XB_SPIN_CAP) { atomicAdd(&bar[XB_TMO], 1u); break; } }
    }
    nloc = mine > 0u ? mine : 1u; nx = cnt > 0u ? cnt : 1u;
}
__device__ __forceinline__ void xcd_barrier(unsigned* bar, volatile LAS unsigned* st) {
    asm volatile("s_waitcnt vmcnt(0)" ::: "memory");
    __syncthreads();
    if (threadIdx.x == 0) {
        const unsigned x = xb_xcc_id();
        __builtin_amdgcn_s_waitcnt(0);
        unsigned nloc = st[0], nx = st[1];
        if (nloc == 0u) { xcd_barrier_complete(bar, x, nloc, nx); st[0] = nloc; st[1] = nx; }
        const unsigned old = xb_add(&bar[XB_XSUB(x)], 1u);
        const unsigned gen = old / nloc;
        if (old + 1u == (gen + 1u) * nloc) {
            __builtin_amdgcn_fence(__ATOMIC_RELEASE, "agent");
            asm volatile("s_waitcnt vmcnt(0)" ::: "memory");
            const unsigned og = xb_add(&bar[XB_TOP], 1u);
            const unsigned tg = og / nx;
            if (og + 1u == (tg + 1u) * nx) xb_add(&bar[XB_TOPGEN], 1u);
            else XB_SPIN(xb_ld(&bar[XB_TOPGEN]) == tg, bar);
            __builtin_amdgcn_fence(__ATOMIC_ACQUIRE, "agent");
            xb_add(&bar[XB_XGEN(x)], 1u);
            asm volatile("s_waitcnt vmcnt(0)" ::: "memory");
        } else {
            XB_SPIN(xb_ld(&bar[XB_XGEN(x)]) == gen, bar);
            __builtin_amdgcn_fence(__ATOMIC_ACQUIRE, "agent");
            asm volatile("s_waitcnt vmcnt(0)" ::: "memory");
        }
    }
    __syncthreads();
}

constexpr int N_PHASES = 1 + 7 + 9 + 7 + 9 + 1;


__device__ __forceinline__ int phase_opcode(int ph) {
    if (ph == 0) return 30;
    if (ph == N_PHASES - 1) return 31;
    int q = ph - 1, l;
    if (q < 7) l = 0; else if (q < 16) { l = 1; q -= 7; } else if (q < 23) { l = 2; q -= 16; } else { l = 3; q -= 23; }
    if ((l & 1) == 0) return q < 4 ? q : 10 + (q - 4);
    return q < 6 ? 20 + q : 10 + (q - 6);
}
#define REGION_T0() unsigned long long rt0_ = 0; if (PROFMASK != 0u && blockIdx.x == 0 && threadIdx.x == 0) rt0_ = __builtin_amdgcn_s_memrealtime()
#define REGION_T1(bit) do { if (PROFMASK != 0u && ((PROFMASK >> (bit)) & 1u) && blockIdx.x == 0 && threadIdx.x == 0) ((volatile LAS unsigned*)(lds + 131072))[2] += (unsigned)(__builtin_amdgcn_s_memrealtime() - rt0_); } while (0)
__device__ void run_phase(KP p, int ph, LAS unsigned char* lds) {
    const int G = GDIM(), bid = BIDX();
    unsigned char* ws = p->ws;
    const float* mod = (const float*)(ws + WS_MOD);
    if (ph == 0 && OPEN(30)) {
        if (DUP(14)) { ada_phase(p, lds); wconv_sgu(p, 0, (LAS float*)lds); }
        if (DUP(15)) { const unsigned long long t0 = __builtin_amdgcn_s_memrealtime(); while (__builtin_amdgcn_s_memrealtime() - t0 < 50000ull) __builtin_amdgcn_s_sleep(8); }
        ada_phase(p, lds);
        wconv_sgu(p, 0, (LAS float*)lds);
        return;
    }
    if (ph == N_PHASES - 1) { if (OPEN(31)) final_norm_phase(p); return; }
    int q = ph - 1, l;
    if (q < 7) l = 0; else if (q < 16) { l = 1; q -= 7; } else if (q < 23) { l = 2; q -= 16; } else { l = 3; q -= 23; }
    const bool sgu = (l & 1) == 0;
    const float* modl = mod + (size_t)l * 9 * 6144;
    int op;
    if (sgu) op = q < 4 ? q : 10 + (q - 4); else op = q < 6 ? 20 + q : 10 + (q - 6);
    const float* xp_lo = p->out; const float* xp_hi = p->out;
    if (l == 0 && op == 3) { xp_lo = p->in[I_XP]; xp_hi = p->in[I_XS] - (size_t)TC * D; }
    pg8::Sched S;
    switch (op) {
    case 0: if (!OPEN(0)) break;
        if (l > 0) { if (DUP(2)) wconv_sgu(p, l, (LAS float*)lds); wconv_sgu(p, l, (LAS float*)lds); }
        if (DUP(3)) norm_phase(p, l, 0, l == 0, (bf16_t*)(ws + BIG(1)));
        norm_phase(p, l, 0, l == 0, (bf16_t*)(ws + BIG(1)));
        break;
    case 1: if (!OPEN(1)) break; {
        S.init(ws + BIG(1), 0, ws + W_INT, 0, 8, D, T, 2048, G, bid);
        EpiGeluUV E{(bf16_t*)(ws + BIG(2)), (bf16_t*)(ws + BIG(3)), (float*)(ws + WS_VST)};
        if (DUP(12)) { pg8::gemm_phase(lds, S, E); __syncthreads(); }
        pg8::gemm_phase(lds, S, E);
    } break;
    case 2: if (!OPEN(2)) break; if (DUP(8)) sgu_mix_phase(p, l, lds); sgu_mix_phase(p, l, lds); break;
    case 3: if (!OPEN(3)) break; {
        S.init(ws + BIG(4), 0, ws + W_OUTT, 0, 4, D, T, D, G, bid);
        EpiRes E{xp_lo, xp_hi, p->out, modl, 2048, 0};
        if (DUP(13)) { EpiRes E2 = E; int dry = 1; asm volatile("" : "+s"(dry)); E2.dry = dry; pg8::gemm_phase(lds, S, E2); __syncthreads(); }
        pg8::gemm_phase(lds, S, E);
    } break;
    case 10: if (!OPEN(10)) break;
        if (sgu) { if (DUP(2)) wconv_rwkv_lora_down(p, l + 1, (LAS float*)lds); wconv_rwkv_lora_down(p, l + 1, (LAS float*)lds); }
        if (DUP(3)) norm_phase(p, l, 1, false, (bf16_t*)(ws + BIG(1)));
        norm_phase(p, l, 1, false, (bf16_t*)(ws + BIG(1)));
        break;
    case 11: if (!OPEN(11)) break; {
        const int merged = ((G == 256) && MERGED_MLP) ? 1 : 0;
        S.init(ws + BIG(1), 0, ws + W_MLP1T, 0, 16, D, T, DFF, G, bid, merged, (unsigned*)(ws + WS_RDY) + (size_t)l * 80 * 64);
        EpiBf16<1> E{(bf16_t*)(ws + BIG(2)), nullptr, nullptr, DFF, merged};
        pg8::gemm_phase(lds, S, E);
        if (!merged) break;
    }
    case 12: if (!OPEN(12)) break; {
        const int merged = ((G == 256) && MERGED_MLP) ? 2 : 0;
        pg8::Sched S2;
        S2.init(ws + BIG(2), 0, ws + W_MLP2T, 0, 4, DFF, T, D, G, bid, merged, (unsigned*)(ws + WS_RDY) + (size_t)l * 80 * 64);
        EpiRes E{p->out, p->out, p->out, modl, 5120, 0};
        pg8::gemm_phase(lds, S2, E);
    } break;
    case 20: if (!OPEN(20)) break;
        if (DUP(2)) wconv_rwkv_main(p, l, (LAS float*)lds);
        { REGION_T0(); wconv_rwkv_main(p, l, (LAS float*)lds); __syncthreads(); REGION_T1(26); }
        { REGION_T0(); rmix_phase(p, l, lds); REGION_T1(27); }
        break;
    case 21: if (!OPEN(21)) break; {
        S.init(ws + BIG(1), BIGSZ, ws + W_RT, 2 * MiB, 4, D, T, 3 * D, G, bid);
        EpiBf16<0> E{(bf16_t*)(ws + BIG(4)), (bf16_t*)(ws + BIG(5)), (bf16_t*)(ws + (l == 1 ? BIG(0) : BIG(6))), D, 0};
        if (DUP(11)) { pg8::gemm_phase(lds, S, E); __syncthreads(); }
        pg8::gemm_phase(lds, S, E);
    } break;
    case 22: break;
    case 23: if (!OPEN(23)) break; scan_phase(p, l, lds); break;
    case 24: if (!OPEN(24)) break; if (DUP(7)) post_phase(p, l); post_phase(p, l); break;
    case 25: if (!OPEN(25)) break; {
        S.init(ws + BIG(4), 0, ws + W_OT, 0, 4, D, T, D, G, bid);
        EpiRes E{p->out, p->out, p->out, modl, 2048, 0};
        pg8::gemm_phase(lds, S, E);
    } break;
    default: break;
    }
}

__global__ void __launch_bounds__(NTHREADS, 2) mega(Params p_unused) {
    extern __shared__ __attribute__((aligned(16))) unsigned char smem[];
    LAS unsigned char* lds = (LAS unsigned char*)smem;
#if MULTI_LAUNCH
    run_phase(kparams(), kparams()->ph_lo, lds);
#else
    cg::grid_group grid = cg::this_grid();
    const int lo = kparams()->ph_lo, hi = kparams()->ph_hi;
    volatile LAS unsigned* st = (volatile LAS unsigned*)(lds + 131072);
    if (threadIdx.x == 0) { st[0] = 0u; st[1] = 0u; st[2] = 0u; st[3] = 0u; }
    __syncthreads();
    if (threadIdx.x == 0) (void)xb_add(&((unsigned*)(kparams()->ws + WS_BAR))[XB_XCNT(xb_xcc_id())], 1u);
    if (lo > hi) grid.sync();
    for (int ph = lo; ph < hi; ++ph) {
        if (phase_opcode(ph) == 22) continue;
        if (phase_opcode(ph) == 12 && gridDim.x == 256 && MERGED_MLP) continue;
        unsigned long long t0 = 0;
        if (PROFMASK != 0u && blockIdx.x == 0 && threadIdx.x == 0) t0 = __builtin_amdgcn_s_memrealtime();
        run_phase(kparams(), ph, lds);
        if (ph + 1 < hi) xcd_barrier((unsigned*)(kparams()->ws + WS_BAR), (volatile LAS unsigned*)(lds + 131072));
        if (PROFMASK != 0u && blockIdx.x == 0 && threadIdx.x == 0 && ((PROFMASK >> phase_opcode(ph)) & 1u)) st[2] += (unsigned)(__builtin_amdgcn_s_memrealtime() - t0);
    }
    if (PROFMASK != 0u && blockIdx.x == 0 && threadIdx.x == 0) { const unsigned long long t0 = __builtin_amdgcn_s_memrealtime(); const unsigned long long dt = st[2]; while (__builtin_amdgcn_s_memrealtime() - t0 < dt) __builtin_amdgcn_s_sleep(8); }
#endif
}

extern "C" void kernel_launch(void* const* d_in, const int* in_sizes, int n_in, void* d_out, int out_size, void* d_ws, size_t ws_size, hipStream_t stream) {
    static int grid = 0;
    if (grid == 0) {
        int dev = 0, cus = 0, per_cu = 0;
        hipGetDevice(&dev);
        hipDeviceGetAttribute(&cus, hipDeviceAttributeMultiprocessorCount, dev);
        if (hipFuncSetAttribute((const void*)mega, hipFuncAttributeMaxDynamicSharedMemorySize, LDS_BYTES) != hipSuccess) { fprintf(stderr, "hipFuncSetAttribute failed\n"); grid = -1; return; }
        if (hipOccupancyMaxActiveBlocksPerMultiprocessor(&per_cu, (const void*)mega, NTHREADS, LDS_BYTES) != hipSuccess || per_cu < 1) { fprintf(stderr, "occupancy query failed (%d)\n", per_cu); per_cu = 1; }
        (void)hipGetLastError();
        grid = cus * (per_cu < 1 ? 1 : (per_cu > 1 ? 1 : per_cu));
        if (ws_size < BIG(8)) fprintf(stderr, "workspace too small: %zu < %zu\n", ws_size, (size_t)BIG(8));
    }
    if (grid < 0) return;
    Params hp{};
    for (int i = 0; i < N_IN; ++i) hp.in[i] = (const float*)d_in[i];
    hp.out = (float*)d_out; hp.ws = (unsigned char*)d_ws;
#if MULTI_LAUNCH
    for (int ph = 0; ph < N_PHASES; ++ph) {
        hp.ph_lo = ph; hp.ph_hi = ph + 1;
        hipLaunchKernelGGL(mega, dim3(grid), dim3(NTHREADS), LDS_BYTES, stream, hp);
    }
#else
    hp.ph_lo = 0; hp.ph_hi = N_PHASES;
    if (hipMemsetAsync((char*)d_ws + WS_BAR, 0, 16 * 1024 + 4 * 80 * 256, stream) != hipSuccess) { fprintf(stderr, "memset of barrier words failed\n"); return; }
    void* args[] = {&hp};
    hipError_t e = hipLaunchCooperativeKernel((const void*)mega, dim3(grid), dim3(NTHREADS), args, LDS_BYTES, stream);
    if (e != hipSuccess) fprintf(stderr, "cooperative launch failed: %s (grid %d)\n", hipGetErrorString(e), grid);
#endif
}
```

```cpp
#include <hip/hip_runtime.h>
#include <hip/hip_cooperative_groups.h>
#include <cstdio>
namespace cg = cooperative_groups;

#define LAS __attribute__((address_space(3)))
typedef unsigned short bf16_t;
typedef short bf16x8 __attribute__((ext_vector_type(8)));
typedef float f32x4 __attribute__((ext_vector_type(4)));
typedef float f32x2 __attribute__((ext_vector_type(2)));
typedef unsigned u32x4 __attribute__((ext_vector_type(4)));
typedef unsigned u32x2 __attribute__((ext_vector_type(2)));

#ifndef OPMASK
#define OPMASK 0xFFFFFFFFu
#endif
#define OPEN(b) ((OPMASK >> (b)) & 1u)
#ifndef DUPMASK
#define DUPMASK 0u
#endif
#define DUP(b) ((DUPMASK >> (b)) & 1u)
#ifndef SCANVAR
#define SCANVAR 0
#endif
#ifndef PROFMASK
#define PROFMASK 0u
#endif
#ifndef MERGED_MLP
#define MERGED_MLP 1
#endif
#ifndef MULTI_LAUNCH
#define MULTI_LAUNCH 0
#endif

constexpr int T = 20480, TC = 4096, D = 1024, DFF = 4096;
constexpr int NTHREADS = 512;
constexpr int LDS_BYTES = 131072 + 16;
constexpr size_t MiB = 1u << 20;
constexpr size_t W_MLP1T = 0, W_MLP2T = 8 * MiB, W_INT = 16 * MiB, W_OUTT = 20 * MiB, W_S = 22 * MiB;
constexpr size_t W_RT = 16 * MiB, W_KT = 18 * MiB, W_VT = 20 * MiB, W_OT = 22 * MiB;
constexpr size_t W_LD = 24 * MiB;
constexpr size_t W_W2T = 25 * MiB;
constexpr size_t W_A2T = 25 * MiB + 256 * 1024;
constexpr size_t W_V2T = 25 * MiB + 512 * 1024;
constexpr size_t W_G2T = 25 * MiB + 640 * 1024;
constexpr size_t WS_MOD = 32 * MiB;
constexpr size_t WS_VST = 53 * MiB;
constexpr size_t WS_BON = 34 * MiB;
constexpr size_t WS_TW = 36 * MiB, WS_A1O = 41 * MiB, WS_SG = 46 * MiB, WS_V1O = 51 * MiB;
constexpr size_t WS_BAR = 55 * MiB + 768 * 1024;
constexpr size_t WS_RDY = WS_BAR + 16 * 1024;
constexpr size_t WS_BIG = 56 * MiB, BIGSZ = 40 * MiB;
#define BIG(i) (WS_BIG + (size_t)(i) * BIGSZ)

enum { I_XP = 0, I_XS, I_STATE, I_C, I_CCTX, I_N1G, I_N2G, I_ADAW, I_ADAB, I_SWIN, I_SLNG, I_SLNB, I_SWS, I_SBS, I_SWOUT,
       I_MU, I_WR, I_WK, I_WV, I_WO, I_W0, I_W1, I_W2, I_A0, I_A1, I_A2, I_V0, I_V1, I_V2, I_G1, I_G2, I_KK, I_KA, I_RK, I_LNG, I_LNB,
       I_M1, I_M2, I_FG, N_IN };

struct Params { const float* in[N_IN]; float* out; unsigned char* ws; int ph_lo, ph_hi; };
typedef const __attribute__((address_space(4))) Params* KP;
__device__ __forceinline__ KP kparams() { KP k = (KP)__builtin_amdgcn_kernarg_segment_ptr(); asm volatile("" : "+s"(k)); return k; }

__device__ __forceinline__ int TIDX() { int t = threadIdx.x; asm volatile("" : "+v"(t)); return t; }
__device__ __forceinline__ int BIDX() { int t = blockIdx.x; asm volatile("" : "+s"(t)); return t; }
__device__ __forceinline__ int GDIM() { int t = gridDim.x; asm volatile("" : "+s"(t)); return t; }
__device__ __forceinline__ unsigned cvt_pk_bf16(float lo, float hi) { unsigned r; asm volatile("v_cvt_pk_bf16_f32 %0, %1, %2" : "=v"(r) : "v"(lo), "v"(hi)); return r; }
__device__ __forceinline__ bf16_t f2bf(float f) { unsigned u = __float_as_uint(f); u += 0x7FFFu + ((u >> 16) & 1u); return (bf16_t)(u >> 16); }
__device__ __forceinline__ float bf2f(unsigned b) { return __uint_as_float(b << 16); }
__device__ __forceinline__ float bflo(unsigned w) { return __uint_as_float(w << 16); }
__device__ __forceinline__ float bfhi(unsigned w) { return __uint_as_float(w & 0xFFFF0000u); }
__device__ __forceinline__ float rcpf_(float x) { return __builtin_amdgcn_rcpf(x); }
__device__ __forceinline__ float sigmoidf_(float x) { return rcpf_(1.0f + __expf(-x)); }
__device__ __forceinline__ float tanhf_(float x) { float e = __expf(-2.0f * fabsf(x)); float t = (1.0f - e) * rcpf_(1.0f + e); return x < 0.f ? -t : t; }
__device__ __forceinline__ float gelu_tanh(float x) { float u = 1.5957691216f * (x + 0.044715f * x * x * x); return x * rcpf_(1.0f + __expf(-u)); }
__device__ __forceinline__ float wave_sum(float v) {
#pragma unroll
    for (int o = 32; o >= 1; o >>= 1) v += __shfl_xor(v, o);
    return v;
}
#define LDS_BARRIER() do { asm volatile("s_waitcnt lgkmcnt(0)" ::: "memory"); __builtin_amdgcn_s_barrier(); asm volatile("" ::: "memory"); } while (0)
template <int CTRL> __device__ __forceinline__ float dpp_f(float x) { return __int_as_float(__builtin_amdgcn_update_dpp(0, __float_as_int(x), CTRL, 0xF, 0xF, true)); }
__device__ __forceinline__ float red8(float x) { x += dpp_f<0xB1>(x); x += dpp_f<0x4E>(x); x += dpp_f<0x141>(x); return x; }
__device__ __forceinline__ float red16(float x) { x = red8(x); x += dpp_f<0x140>(x); return x; }
__device__ __forceinline__ int cond_row(int t) { return t < TC ? 0 : 1 + ((t - TC) >> 11); }
__device__ __forceinline__ const float* xrow_ptr(KP p, bool from_input, int row) {
    if (from_input) return row < TC ? p->in[I_XP] + (size_t)row * D : p->in[I_XS] + (size_t)(row - TC) * D;
    return p->out + (size_t)row * D;
}

namespace pg8 {
constexpr int BM = 256, BK = 64, HALF = 128, HTB = HALF * BK * 2, STAGE_BYTES = 8 * HTB, NXCD = 8, WGM = 8;
__device__ __forceinline__ int lds_byte(int r, int c) { const int st = (r >> 4) * 2 + (c >> 5), rr = r & 15, cc = c & 31, ob = rr * 64 + cc * 2; return st * 1024 + (ob ^ (((ob >> 9) & 1) << 5)); }
__device__ __forceinline__ void stage_rc(int b, int& R, int& C) { const int st = b / 1024, sb = b % 1024, swz = sb ^ (((sb >> 9) & 1) << 5); R = (st >> 1) * 16 + swz / 64; C = (st & 1) * 32 + (swz % 64) / 2; }
__device__ __forceinline__ int perm32(int rho) { const int n = rho >> 4, i = rho & 15; return 8 * (i >> 2) + 4 * n + (i & 3); }
struct Unit { int pm, pn, gi; };
struct Sched {
    const char* A; size_t strideA; const char* Bt; size_t strideB; int tpg, K;
    int nM, nN, nwg, G, c, mode;
    unsigned* ready;
    __device__ void init(const void* A_, size_t sA, const void* Bt_, size_t sB, int tpg_, int K_, int M, int Nv, int G_, int c_, int mode_ = 0, unsigned* ready_ = nullptr) {
        A = (const char*)A_; strideA = sA; Bt = (const char*)Bt_; strideB = sB; tpg = tpg_; K = K_; nM = M / BM; nN = Nv / BM; nwg = nM * nN; G = G_; c = c_; mode = mode_; ready = ready_; }
    __device__ bool next(int i, Unit& u) const {
        int pm = 0, pn = 0, gi = 0; bool ok;
        if (mode == 1) {
            const int ui = i < 2 ? i * 256 + c : 512 + (i - 2) * 192 + (c - 64);
            ok = (i < 2) || (c >= 64 && i < 6);
            pm = ui >> 4; pn = ui & 15;
        } else if (mode == 2) {
            const int d = c < 64 ? c + 64 * i : 128 + (c - 64);
            ok = c < 64 ? (i < 2) : (i < 1);
            pm = d >> 2; pn = d & 3;
        } else {
            const long L = (long)i * G + c; ok = L < nwg;
            int wgid = ok ? (int)L : 0; { const int q = nwg / NXCD, r = nwg % NXCD, xcd = wgid % NXCD, off = wgid / NXCD; wgid = (xcd < r ? xcd * (q + 1) : r * (q + 1) + (xcd - r) * q) + off; }
            const int nig = WGM * nN, gid = wgid / nig, fm = gid * WGM, gsz = (nM - fm) < WGM ? (nM - fm) : WGM;
            pm = fm + ((wgid % nig) % gsz); const int pv = (wgid % nig) / gsz; gi = pv / tpg; pn = pv - gi * tpg;
        }
        u.pm = pm; u.pn = pn; u.gi = gi;
        return ok;
    }
    __device__ __forceinline__ void a_ready(const Unit& u) const {
        if (mode != 2) return;
        if (threadIdx.x < 64) {
            unsigned spins = 0;
            while ((unsigned)__builtin_amdgcn_readfirstlane(__hip_atomic_load(ready + 64 * u.pm, __ATOMIC_RELAXED, __HIP_MEMORY_SCOPE_AGENT)) < 128u) {
                __builtin_amdgcn_s_sleep(2); if (++spins > (1u << 24)) break; }
            __builtin_amdgcn_fence(__ATOMIC_ACQUIRE, "agent");
            asm volatile("s_waitcnt vmcnt(0)" ::: "memory");
        }
        asm volatile("" ::: "memory"); __builtin_amdgcn_s_barrier(); asm volatile("" ::: "memory");
    }
    __device__ __forceinline__ void done(const Unit& u) const {
        if (mode != 1) return;
        asm volatile("s_waitcnt vmcnt(0)" ::: "memory");
        if ((threadIdx.x & 63) == 0) __hip_atomic_fetch_add(ready + 64 * u.pm, 1u, __ATOMIC_RELAXED, __HIP_MEMORY_SCOPE_AGENT);
    }
};

template <class Epi>
__device__ __forceinline__ void gemm_phase(LAS unsigned char* lds, const Sched& S, const Epi& E) {
    const int tid = TIDX(), wid = __builtin_amdgcn_readfirstlane(tid >> 6), lane = tid & 63, wr = wid >> 2, wc = wid & 3, fr = lane & 15, fq = lane >> 4;
    const int K = S.K, nt = K / BK;
    unsigned voffA[2], voffB[2];
#pragma unroll
    for (int i = 0; i < 2; ++i) { int R, C; stage_rc(tid * 16 + i * 8192, R, C); const int Rb = Epi::PERM ? ((R & ~31) + perm32(R & 31)) : R;
        voffA[i] = (unsigned)(R * K + C) * 2u; voffB[i] = (unsigned)(Rb * K + C) * 2u; }
    const size_t kstep = (size_t)(BK * 2);
    const size_t hstep = (size_t)HALF * K * 2;
    const size_t tstep = 2 * hstep;
    const unsigned ldsw = (unsigned)wid * 1024u;
    const int aoff = lds_byte(wr * 64 + fr, fq * 8), boff = lds_byte(wc * 32 + fr, fq * 8);
#define PG8_SA(b, h) (((b) * 2 + (h)) * HTB)
#define PG8_SB(b, h) ((4 + (b) * 2 + (h)) * HTB)
#define PG8_STAGE(bufoff, gbase, voff) do { _Pragma("unroll") for (int _i = 0; _i < 2; ++_i) \
        __builtin_amdgcn_global_load_lds((const unsigned*)((const char*)(gbase) + (voff)[_i]), (LAS unsigned*)(lds + (bufoff) + ldsw + _i * 8192), 16, 0, 0); } while (0)
#define PG8_LDA(dst, b, h) do { _Pragma("unroll") for (int m = 0; m < 4; ++m) _Pragma("unroll") for (int k = 0; k < 2; ++k) dst[m][k] = *(const LAS bf16x8*)(lds + PG8_SA(b, h) + aoff + m * 2048 + k * 1024); } while (0)
#define PG8_LDB(dst, b, h) do { _Pragma("unroll") for (int n = 0; n < 2; ++n) _Pragma("unroll") for (int k = 0; k < 2; ++k) dst[n][k] = *(const LAS bf16x8*)(lds + PG8_SB(b, h) + boff + n * 2048 + k * 1024); } while (0)
#define PG8_MMA(ai, bj, At, Bt) do { __builtin_amdgcn_s_setprio(1); _Pragma("unroll") for (int m = 0; m < 4; ++m) _Pragma("unroll") for (int n = 0; n < 2; ++n) _Pragma("unroll") for (int k = 0; k < 2; ++k) \
        acc[ai][bj][m][n] = __builtin_amdgcn_mfma_f32_16x16x32_bf16(Bt[n][k], At[m][k], acc[ai][bj][m][n], 0, 0, 0); __builtin_amdgcn_s_setprio(0); } while (0)
#define PG8_WAIT_V(n) asm volatile("s_waitcnt vmcnt(" #n ")" ::: "memory")
#define PG8_WAIT_L(n) asm volatile("s_waitcnt lgkmcnt(" #n ")" ::: "memory")
#define PG8_BAR __builtin_amdgcn_s_barrier()
#define PG8_SCHED __builtin_amdgcn_sched_barrier(0)
    Unit cur, nxt; int ui = 0;
    if (!S.next(0, cur)) return;
    f32x4 acc[2][2][4][2];
#pragma unroll
    for (int a = 0; a < 2; ++a)
#pragma unroll
        for (int b = 0; b < 2; ++b)
#pragma unroll
            for (int m = 0; m < 4; ++m)
#pragma unroll
                for (int n = 0; n < 2; ++n) acc[a][b][m][n] = (f32x4){0.f, 0.f, 0.f, 0.f};
    bf16x8 At[4][2], B0[2][2], B1[2][2];
    const char* cA = S.A + (size_t)cur.gi * S.strideA + (size_t)cur.pm * tstep; const char* cB = S.Bt + (size_t)cur.gi * S.strideB + (size_t)cur.pn * tstep;
    S.a_ready(cur);
    PG8_STAGE(PG8_SB(0, 0), cB, voffB); PG8_STAGE(PG8_SA(0, 0), cA, voffA); PG8_STAGE(PG8_SB(0, 1), cB + hstep, voffB); PG8_STAGE(PG8_SA(0, 1), cA + hstep, voffA);
    if (wr == 1) PG8_BAR;
    PG8_WAIT_V(4); PG8_BAR;
    PG8_STAGE(PG8_SB(1, 0), cB + kstep, voffB); PG8_STAGE(PG8_SA(1, 0), cA + kstep, voffA); PG8_STAGE(PG8_SB(1, 1), cB + hstep + kstep, voffB);
    PG8_WAIT_V(6); PG8_BAR;
    for (;;) {
        const bool has_next = S.next(ui + 1, nxt);
        const char* nA = has_next ? S.A + (size_t)nxt.gi * S.strideA + (size_t)nxt.pm * tstep : cA; const char* nB = has_next ? S.Bt + (size_t)nxt.gi * S.strideB + (size_t)nxt.pn * tstep : cB;
        for (int t = 0; t < nt; t += 2) {
            const bool last = (t == nt - 2);
            const char* a1 = cA + (size_t)(t + 1) * kstep;
            const char* a2 = last ? nA : cA + (size_t)(t + 2) * kstep; const char* b2 = last ? nB : cB + (size_t)(t + 2) * kstep;
            const char* a3 = a2 + kstep; const char* b3 = b2 + kstep;
            if (last && has_next) S.a_ready(nxt);
            PG8_LDB(B0, 0, 0); PG8_SCHED; PG8_LDA(At, 0, 0); PG8_STAGE(PG8_SA(1, 1), a1 + hstep, voffA);
            PG8_WAIT_L(8); PG8_BAR; PG8_WAIT_L(0); PG8_MMA(0, 0, At, B0); PG8_BAR; PG8_SCHED;
            PG8_LDB(B1, 0, 1); PG8_STAGE(PG8_SB(0, 0), b2, voffB);
            PG8_BAR; PG8_WAIT_L(0); PG8_MMA(0, 1, At, B1); PG8_BAR;
            PG8_LDA(At, 0, 1); PG8_STAGE(PG8_SA(0, 0), a2, voffA);
            PG8_BAR; PG8_WAIT_L(0); PG8_MMA(1, 0, At, B0); PG8_BAR; PG8_SCHED;
            PG8_STAGE(PG8_SB(0, 1), b2 + hstep, voffB);
            PG8_WAIT_V(6); PG8_BAR; PG8_MMA(1, 1, At, B1); PG8_BAR;
            PG8_LDB(B0, 1, 0); PG8_SCHED; PG8_LDA(At, 1, 0); PG8_STAGE(PG8_SA(0, 1), a2 + hstep, voffA);
            PG8_WAIT_L(8); PG8_BAR; PG8_WAIT_L(0); PG8_MMA(0, 0, At, B0); PG8_BAR; PG8_SCHED;
            PG8_LDB(B1, 1, 1); PG8_STAGE(PG8_SB(1, 0), b3, voffB);
            PG8_BAR; PG8_WAIT_L(0); PG8_MMA(0, 1, At, B1); PG8_BAR;
            PG8_LDA(At, 1, 1); PG8_STAGE(PG8_SA(1, 0), a3, voffA);
            PG8_BAR; PG8_WAIT_L(0); PG8_MMA(1, 0, At, B0); PG8_BAR; PG8_SCHED;
            PG8_STAGE(PG8_SB(1, 1), b3 + hstep, voffB);
            PG8_WAIT_V(6); PG8_BAR; PG8_MMA(1, 1, At, B1); PG8_BAR;
        }
        E(acc, cur, wr, wc, fr, fq); S.done(cur);
        if (!has_next) break;
#pragma unroll
        for (int a = 0; a < 2; ++a)
#pragma unroll
            for (int b = 0; b < 2; ++b)
#pragma unroll
                for (int m = 0; m < 4; ++m)
#pragma unroll
                    for (int n = 0; n < 2; ++n) acc[a][b][m][n] = (f32x4){0.f, 0.f, 0.f, 0.f};
        cur = nxt; cA = nA; cB = nB; ++ui;
    }
    PG8_WAIT_V(0);
    if (wr == 0) PG8_BAR;
    PG8_BAR;
#undef PG8_SA
#undef PG8_SB
#undef PG8_STAGE
#undef PG8_LDA
#undef PG8_LDB
#undef PG8_MMA
#undef PG8_WAIT_V
#undef PG8_WAIT_L
#undef PG8_BAR
#undef PG8_SCHED
}
}

typedef f32x4 Acc[2][2][4][2];

struct EpiRes {
    static constexpr bool PERM = true;
    const float* src_lo; const float* src_hi; float* dst; const float* modl; int goff; int dry;
    __device__ __forceinline__ void operator()(const Acc& acc, const pg8::Unit& u, int wr, int wc, int fr, int fq) const {
        const int row0 = u.pm * 256 + wr * 64 + fr, col0 = u.pn * 256 + wc * 32 + 8 * fq;
        const int crow = u.pm < 16 ? 0 : 1 + ((u.pm - 16) >> 3);
        const float* gp = modl + crow * 6144 + goff + col0;
        f32x4 gv[2][2];
#pragma unroll
        for (int bj = 0; bj < 2; ++bj)
#pragma unroll
            for (int n = 0; n < 2; ++n) gv[bj][n] = *(const f32x4*)(gp + bj * 128 + n * 4);
        const float* sb = (u.pm < 16 ? src_lo : src_hi);
#pragma unroll
        for (int ai = 0; ai < 2; ++ai)
#pragma unroll
            for (int m = 0; m < 4; ++m) {
                const size_t ro = (size_t)(row0 + ai * 128 + m * 16) * D + col0;
                f32x4 xv[2][2];
#pragma unroll
                for (int bj = 0; bj < 2; ++bj)
#pragma unroll
                    for (int n = 0; n < 2; ++n) xv[bj][n] = *(const f32x4*)(sb + ro + bj * 128 + n * 4);
#pragma unroll
                for (int bj = 0; bj < 2; ++bj)
#pragma unroll
                    for (int n = 0; n < 2; ++n) if (!dry) *(f32x4*)(dst + ro + bj * 128 + n * 4) = xv[bj][n] + gv[bj][n] * acc[ai][bj][m][n];
            }
    }
};
template <int ACT> struct EpiBf16 {
    static constexpr bool PERM = true;
    bf16_t* o0; bf16_t* o1; bf16_t* o2; int ldc; int wt;
    __device__ __forceinline__ void operator()(const Acc& acc, const pg8::Unit& u, int wr, int wc, int fr, int fq) const {
        const int row0 = u.pm * 256 + wr * 64 + fr, col0 = u.pn * 256 + wc * 32 + 8 * fq;
        bf16_t* base = u.gi == 0 ? o0 : (u.gi == 1 ? o1 : o2);
#pragma unroll
        for (int ai = 0; ai < 2; ++ai)
#pragma unroll
            for (int m = 0; m < 4; ++m) {
                bf16_t* rowp = base + (size_t)(row0 + ai * 128 + m * 16) * ldc + col0;
#pragma unroll
                for (int bj = 0; bj < 2; ++bj) {
                    f32x4 v0 = acc[ai][bj][m][0], v1 = acc[ai][bj][m][1];
                    if (ACT == 1) {
#pragma unroll
                        for (int j = 0; j < 4; ++j) { float a = fmaxf(v0[j], 0.f), b = fmaxf(v1[j], 0.f); v0[j] = a * a; v1[j] = b * b; }
                    }
                    u32x4 w; w.x = cvt_pk_bf16(v0[0], v0[1]); w.y = cvt_pk_bf16(v0[2], v0[3]); w.z = cvt_pk_bf16(v1[0], v1[1]); w.w = cvt_pk_bf16(v1[2], v1[3]);
                    if (wt) asm volatile("global_store_dwordx4 %0, %1, off sc0 sc1\n\ts_nop 1" :: "v"(rowp + bj * 128), "v"(w) : "memory");
                    else *(u32x4*)(rowp + bj * 128) = w;
                }
            }
    }
};
struct EpiGeluUV {
    static constexpr bool PERM = true;
    bf16_t* U; bf16_t* V; float* vst;
    __device__ __forceinline__ void operator()(const Acc& acc, const pg8::Unit& u, int wr, int wc, int fr, int fq) const {
        const int row0 = u.pm * 256 + wr * 64 + fr;
        const bool isv = u.pn >= 4;
        const int col0 = (u.pn & 3) * 256 + wc * 32 + 8 * fq;
        bf16_t* base = isv ? V : U;
#pragma unroll
        for (int ai = 0; ai < 2; ++ai)
#pragma unroll
            for (int m = 0; m < 4; ++m) {
                const int row = row0 + ai * 128 + m * 16;
                bf16_t* rowp = base + (size_t)row * D + col0;
                float s1 = 0.f, s2 = 0.f;
#pragma unroll
                for (int bj = 0; bj < 2; ++bj) {
                    f32x4 v0 = acc[ai][bj][m][0], v1 = acc[ai][bj][m][1];
#pragma unroll
                    for (int j = 0; j < 4; ++j) { v0[j] = gelu_tanh(v0[j]); v1[j] = gelu_tanh(v1[j]); s1 += v0[j] + v1[j]; s2 += v0[j] * v0[j] + v1[j] * v1[j]; }
                    u32x4 w; w.x = cvt_pk_bf16(v0[0], v0[1]); w.y = cvt_pk_bf16(v0[2], v0[3]); w.z = cvt_pk_bf16(v1[0], v1[1]); w.w = cvt_pk_bf16(v1[2], v1[3]);
                    *(u32x4*)(rowp + bj * 128) = w;
                }
                if (isv) {
                    s1 += __shfl_xor(s1, 16); s1 += __shfl_xor(s1, 32);
                    s2 += __shfl_xor(s2, 16); s2 += __shfl_xor(s2, 32);
                    if (fq == 0) *(f32x2*)(vst + ((size_t)row * 16 + (u.pn - 4) * 4 + wc) * 2) = (f32x2){s1, s2};
                }
            }
    }
};

__device__ void wconv_tiled(const float* __restrict__ src, int K, int N, bf16_t* dst, int ldd, LAS float* tile, int bid, int G) {
    const int tid = TIDX(); const int tn = N / 64, ntiles = (K / 64) * tn;
    for (int t = bid; t < ntiles; t += G) {
        const int k0 = (t / tn) * 64, n0 = (t % tn) * 64;
#pragma unroll
        for (int i = 0; i < 8; ++i) { const int idx = tid + 512 * i, kk = idx >> 6, nn = idx & 63; tile[kk * 65 + nn] = __builtin_nontemporal_load(src + (size_t)(k0 + kk) * N + n0 + nn); }
        __syncthreads();
        { const int n = tid >> 3, kc = tid & 7; float v[8];
#pragma unroll
          for (int j = 0; j < 8; ++j) v[j] = tile[(kc * 8 + j) * 65 + n];
          u32x4 w; w.x = cvt_pk_bf16(v[0], v[1]); w.y = cvt_pk_bf16(v[2], v[3]); w.z = cvt_pk_bf16(v[4], v[5]); w.w = cvt_pk_bf16(v[6], v[7]);
          *(u32x4*)(dst + (size_t)(n0 + n) * ldd + k0 + kc * 8) = w; }
        __syncthreads();
    }
}
__device__ void wconv_tiled256(const float* __restrict__ src, int K, int N, bf16_t* dst, int ldd, LAS float* tile, int bid, int G) {
    const int tid = TIDX(); const int tn = N / 256, ntiles = (K / 64) * tn;
    const int lane = tid & 63, wave = tid >> 6;
    for (int t = bid; t < ntiles; t += G) {
        const int k0 = (t / tn) * 64, n0 = (t % tn) * 256;
        f32x4 v[8];
#pragma unroll
        for (int i = 0; i < 8; ++i) { const int idx = tid + 512 * i, kk = idx >> 6, n4 = idx & 63; v[i] = __builtin_nontemporal_load((const f32x4*)(src + (size_t)(k0 + kk) * N + n0 + n4 * 4)); }
#pragma unroll
        for (int i = 0; i < 8; ++i) { const int idx = tid + 512 * i, kk = idx >> 6, n4 = idx & 63; *(LAS f32x4*)(tile + kk * 260 + n4 * 4) = v[i]; }
        __syncthreads();
        { const int n = lane + 64 * (wave & 3);
#pragma unroll
          for (int q = 0; q < 4; ++q) { const int kc = 4 * (wave >> 2) + q; float x[8];
#pragma unroll
            for (int j = 0; j < 8; ++j) x[j] = tile[(kc * 8 + j) * 260 + n];
            u32x4 w; w.x = cvt_pk_bf16(x[0], x[1]); w.y = cvt_pk_bf16(x[2], x[3]); w.z = cvt_pk_bf16(x[4], x[5]); w.w = cvt_pk_bf16(x[6], x[7]);
            *(u32x4*)(dst + (size_t)(n0 + n) * ldd + k0 + kc * 8) = w; } }
        __syncthreads();
    }
}
__device__ void wconv_tiled_frag(const float* __restrict__ src, int N, bf16_t* dst, int nrow0, LAS float* tile, int bid, int G) {
    const int tid = TIDX(); const int tn = N / 64, ntiles = 16 * tn;
    for (int t = bid; t < ntiles; t += G) {
        const int k0 = (t / tn) * 64, n0 = (t % tn) * 64;
#pragma unroll
        for (int i = 0; i < 8; ++i) { const int idx = tid + 512 * i, kk = idx >> 6, nn = idx & 63; tile[kk * 65 + nn] = __builtin_nontemporal_load(src + (size_t)(k0 + kk) * N + n0 + nn); }
        __syncthreads();
        { const int n = tid >> 3, kc = tid & 7; float v[8];
#pragma unroll
          for (int j = 0; j < 8; ++j) v[j] = tile[(kc * 8 + j) * 65 + n];
          u32x4 w; w.x = cvt_pk_bf16(v[0], v[1]); w.y = cvt_pk_bf16(v[2], v[3]); w.z = cvt_pk_bf16(v[4], v[5]); w.w = cvt_pk_bf16(v[6], v[7]);
          const int na = nrow0 + n0 + n, k = k0 + kc * 8;
          *(u32x4*)(dst + ((size_t)(((na >> 4) * 32 + (k >> 5)) * 64 + ((k >> 3) & 3) * 16 + (na & 15))) * 8) = w; }
        __syncthreads();
    }
}
__device__ void wconv_direct(const float* __restrict__ src, int K, int N, bf16_t* dst) {
    const int gsz = GDIM() * NTHREADS;
    for (int e = BIDX() * NTHREADS + TIDX(); e < K * N; e += gsz) { const int n = e / K, k = e - n * K; dst[e] = f2bf(src[(size_t)k * N + n]); }
}
__device__ void wconv_mlp(KP p, int l, LAS float* tile) {
    const int G = GDIM(), b = BIDX();
    wconv_tiled256(p->in[I_M1] + (size_t)l * D * DFF, D, DFF, (bf16_t*)(p->ws + W_MLP1T), D, tile, b, G);
    wconv_tiled256(p->in[I_M2] + (size_t)l * D * DFF, DFF, D, (bf16_t*)(p->ws + W_MLP2T), DFF, tile, b, G);
}
__device__ void wconv_sgu(KP p, int l, LAS float* tile) {
    const int i = l >> 1, G = GDIM(), b = BIDX();
    wconv_tiled256(p->in[I_SWIN] + (size_t)i * D * 2048, D, 2048, (bf16_t*)(p->ws + W_INT), D, tile, b, G);
    wconv_tiled256(p->in[I_SWOUT] + (size_t)i * D * D, D, D, (bf16_t*)(p->ws + W_OUTT), D, tile, (b + 128) % G, G);
    { const float* s = p->in[I_SWS] + (size_t)i * 16 * 128 * 128; bf16_t* d = (bf16_t*)(p->ws + W_S);
      for (int e = BIDX() * NTHREADS + TIDX(); e < 16 * 128 * 128; e += G * NTHREADS) d[e] = f2bf(s[e]); }
    wconv_mlp(p, l, tile);
}
__device__ void wconv_rwkv_main(KP p, int l, LAS float* tile) {
    const int il = l >> 1, G = GDIM(), b = BIDX();
    wconv_tiled256(p->in[I_WR] + (size_t)il * D * D, D, D, (bf16_t*)(p->ws + W_RT), D, tile, b, G);
    wconv_tiled256(p->in[I_WK] + (size_t)il * D * D, D, D, (bf16_t*)(p->ws + W_KT), D, tile, (b + 64) % G, G);
    wconv_tiled256(p->in[I_WV] + (size_t)il * D * D, D, D, (bf16_t*)(p->ws + W_VT), D, tile, (b + 128) % G, G);
    wconv_tiled256(p->in[I_WO] + (size_t)il * D * D, D, D, (bf16_t*)(p->ws + W_OT), D, tile, (b + 192) % G, G);
    for (int d = 0; d < 2; ++d) {
        wconv_direct(p->in[I_W2] + (size_t)(il * 2 + d) * 64 * D, 64, D, (bf16_t*)(p->ws + W_W2T) + (size_t)d * D * 64);
        wconv_direct(p->in[I_A2] + (size_t)(il * 2 + d) * 64 * D, 64, D, (bf16_t*)(p->ws + W_A2T) + (size_t)d * D * 64);
    }
    if (il == 1) wconv_direct(p->in[I_V2], 32, D, (bf16_t*)(p->ws + W_V2T));
    wconv_direct(p->in[I_G2] + (size_t)il * 128 * D, 128, D, (bf16_t*)(p->ws + W_G2T));
    wconv_mlp(p, l, tile);
}
__device__ void wconv_rwkv_lora_down(KP p, int l, LAS float* tile) {
    const int il = l >> 1, G = GDIM(), b = BIDX();
    bf16_t* ld = (bf16_t*)(p->ws + W_LD);
    for (int d = 0; d < 2; ++d) {
        wconv_tiled_frag(p->in[I_W1] + (size_t)(il * 2 + d) * D * 64, 64, ld, d * 64, tile, (b + d * 16) % G, G);
        wconv_tiled_frag(p->in[I_A1] + (size_t)(il * 2 + d) * D * 64, 64, ld, 128 + d * 64, tile, (b + 32 + d * 16) % G, G);
    }
    wconv_tiled_frag(p->in[I_G1] + (size_t)il * D * 128, 128, ld, 256, tile, (b + 64) % G, G);
    if (il == 1) {
        const float* src = p->in[I_V1];
        for (int e = BIDX() * NTHREADS + TIDX(); e < D * 32; e += G * NTHREADS) { const int k = e >> 5, na = 384 + (e & 31);
            ld[((size_t)(((na >> 4) * 32 + (k >> 5)) * 64 + ((k >> 3) & 3) * 16 + (na & 15))) * 8 + (k & 7)] = f2bf(src[e]); }
    }
}

__device__ void ada_phase(KP p, LAS unsigned char* lds) {
    LAS float* sc = (LAS float*)lds;
    LAS float* red = sc + 9 * 1024;
    const int tid = TIDX(), G = GDIM();
    float* mod = (float*)(p->ws + WS_MOD);
    if ((int)BIDX() < 192) {
        for (int e = tid; e < 9 * 1024; e += NTHREADS) { const int r = e >> 10, k = e & 1023; const float x = r == 0 ? p->in[I_CCTX][k] : p->in[I_C][(r - 1) * 1024 + k]; sc[e] = x * rcpf_(1.0f + __expf(-x)); }
        __syncthreads();
    }
    for (int item = BIDX(); item < 192; item += G) {
        const int l = item / 48, c0 = (item % 48) * 128, col4 = tid & 31, kq = tid >> 5;
        const float* wp = p->in[I_ADAW] + ((size_t)l * 1024 + kq * 64) * 6144 + c0 + col4 * 4;
        f32x4 acc[9];
#pragma unroll
        for (int r = 0; r < 9; ++r) acc[r] = (f32x4){0.f, 0.f, 0.f, 0.f};
#pragma unroll 8
        for (int kk = 0; kk < 64; ++kk) {
            const f32x4 w = __builtin_nontemporal_load((const f32x4*)(wp + (size_t)kk * 6144));
#pragma unroll
            for (int r = 0; r < 9; ++r) acc[r] += sc[r * 1024 + kq * 64 + kk] * w;
        }
#pragma unroll
        for (int r = 0; r < 9; ++r) *(LAS f32x4*)(red + ((kq * 9 + r) * 128 + col4 * 4)) = acc[r];
        __syncthreads();
        for (int o = tid; o < 9 * 128; o += NTHREADS) {
            const int r = o >> 7, cc = o & 127; float s = p->in[I_ADAB][l * 6144 + c0 + cc];
#pragma unroll
            for (int q = 0; q < 16; ++q) s += red[(q * 9 + r) * 128 + cc];
            mod[(size_t)(l * 9 + r) * 6144 + c0 + cc] = s;
        }
        __syncthreads();
    }
}

__device__ void norm_phase(KP p, int l, int which, bool from_input, bf16_t* H) {
    const int lane = TIDX() & 63, gw = BIDX() * 8 + (TIDX() >> 6), nw = GDIM() * 8;
    const float* g = p->in[which ? I_N2G : I_N1G] + l * D;
    const float* mod = (const float*)(p->ws + WS_MOD);
    f32x4 ggr[4];
#pragma unroll
    for (int i = 0; i < 4; ++i) ggr[i] = *(const f32x4*)(g + i * 256 + lane * 4);
    for (int row = gw; row < T; row += 4 * nw) {
        f32x4 v[4][4]; int rws[4]; bool has[4];
#pragma unroll
        for (int q = 0; q < 4; ++q) {
            rws[q] = row + q * nw; has[q] = rws[q] < T;
            const float* xp = xrow_ptr(p, from_input, has[q] ? rws[q] : row);
#pragma unroll
            for (int i = 0; i < 4; ++i) v[q][i] = *(const f32x4*)(xp + i * 256 + lane * 4);
        }
#pragma unroll
        for (int q = 0; q < 4; ++q) {
            if (!has[q]) break;
            const int r_ = rws[q];
            const float* md = mod + (size_t)(l * 9 + cond_row(r_)) * 6144 + (which ? 3072 : 0);
            float ss = 0.f;
#pragma unroll
            for (int i = 0; i < 4; ++i) { const f32x4 x = v[q][i]; ss += x[0] * x[0] + x[1] * x[1] + x[2] * x[2] + x[3] * x[3]; }
            ss = wave_sum(ss);
            const float rstd = rsqrtf(ss * (1.0f / 1024.0f) + 1e-6f);
#pragma unroll
            for (int i = 0; i < 4; ++i) {
                const int c = i * 256 + lane * 4;
                const f32x4 gg = ggr[i], sh = *(const f32x4*)(md + c), sc = *(const f32x4*)(md + 1024 + c);
                const f32x4 o = v[q][i] * rstd * gg * (1.0f + sc) + sh;
                u32x2 w; w.x = cvt_pk_bf16(o[0], o[1]); w.y = cvt_pk_bf16(o[2], o[3]);
                *(u32x2*)(H + (size_t)r_ * D + c) = w;
            }
        }
    }
}
__device__ void final_norm_phase(KP p) {
    const int lane = TIDX() & 63, gw = BIDX() * 8 + (TIDX() >> 6), nw = GDIM() * 8;
    const float* g = p->in[I_FG];
    f32x4 gv[4];
#pragma unroll
    for (int i = 0; i < 4; ++i) gv[i] = *(const f32x4*)(g + i * 256 + lane * 4);
    for (int row = gw; row < T; row += 4 * nw) {
        f32x4 v[4][4]; bool has[4];
#pragma unroll
        for (int q = 0; q < 4; ++q) {
            has[q] = row + q * nw < T;
            const float* xp = p->out + (size_t)(has[q] ? row + q * nw : row) * D;
#pragma unroll
            for (int i = 0; i < 4; ++i) v[q][i] = *(const f32x4*)(xp + i * 256 + lane * 4);
        }
#pragma unroll
        for (int q = 0; q < 4; ++q) {
            if (!has[q]) break;
            float* xp = p->out + (size_t)(row + q * nw) * D;
            float ss = 0.f;
#pragma unroll
            for (int i = 0; i < 4; ++i) { const f32x4 x = v[q][i]; ss += x[0] * x[0] + x[1] * x[1] + x[2] * x[2] + x[3] * x[3]; }
            ss = wave_sum(ss);
            const float rstd = rsqrtf(ss * (1.0f / 1024.0f) + 1e-6f);
#pragma unroll
            for (int i = 0; i < 4; ++i) __builtin_nontemporal_store(v[q][i] * rstd * gv[i], (f32x4*)(xp + i * 256 + lane * 4));
        }
    }
}

constexpr int HBS = 1028;
__device__ void rmix_phase(KP p, int l, LAS unsigned char* lds) {
    const int il = l >> 1;
    LAS float* hb = (LAS float*)lds;
    const int tid = TIDX(), lane = tid & 63, wave = tid >> 6, G = GDIM();
    const float* g = p->in[I_N1G] + l * D;
    const float* mu = p->in[I_MU] + (size_t)il * 6 * D;
    const float* mod = (const float*)(p->ws + WS_MOD);
    bf16_t* XR = (bf16_t*)(p->ws + BIG(1)); bf16_t* XK = (bf16_t*)(p->ws + BIG(2)); bf16_t* XV = (bf16_t*)(p->ws + BIG(3));
    const bf16_t* LD = (const bf16_t*)(p->ws + W_LD);
    LAS float* mul = (LAS float*)(lds + 76 * 1024);
    for (int e = tid; e < 6 * 256; e += NTHREADS) *(LAS f32x4*)(mul + 4 * e) = *(const f32x4*)(mu + 4 * e);
    __syncthreads();
#define RMIX_LOADROWS(tile_) do { const int t0_ = (tile_) * 16; \
        const int s0_ = t0_ < TC ? (t0_ & ~255) : TC + ((t0_ - TC) & ~2047), L_ = t0_ < TC ? 256 : 2048; \
        _Pragma("unroll") for (int ri = 0; ri < 3; ++ri) { \
            const int r = wave + 8 * ri, t = t0_ - 1 + r; \
            ok[ri] = (r < 18) && (t >= s0_) && (t < s0_ + L_); \
            if (ok[ri]) { const float* xp = p->out + (size_t)t * D; \
                _Pragma("unroll") for (int i = 0; i < 4; ++i) v[ri][i] = *(const f32x4*)(xp + i * 256 + lane * 4); } \
            else { _Pragma("unroll") for (int i = 0; i < 4; ++i) v[ri][i] = (f32x4){0.f, 0.f, 0.f, 0.f}; } } } while (0)
    f32x4 v[3][4]; bool ok[3];
    if (BIDX() < T / 16) RMIX_LOADROWS(BIDX());
    for (int tile = BIDX(); tile < T / 16; tile += G) {
        const int t0 = tile * 16;
        const float* md = mod + (size_t)(l * 9 + cond_row(t0)) * 6144;
        {
#pragma unroll
            for (int ri = 0; ri < 3; ++ri) {
                const int r = wave + 8 * ri;
                if (r < 18) {
                    float ss = 0.f;
#pragma unroll
                    for (int i = 0; i < 4; ++i) ss += v[ri][i][0] * v[ri][i][0] + v[ri][i][1] * v[ri][i][1] + v[ri][i][2] * v[ri][i][2] + v[ri][i][3] * v[ri][i][3];
                    ss = wave_sum(ss);
                    const float rstd = rsqrtf(ss * (1.0f / 1024.0f) + 1e-6f);
#pragma unroll
                    for (int i = 0; i < 4; ++i) {
                        const int c = i * 256 + lane * 4;
                        const f32x4 gg = *(const f32x4*)(g + c), sh = *(const f32x4*)(md + c), sc = *(const f32x4*)(md + 1024 + c);
                        *(LAS f32x4*)(hb + r * HBS + c) = ok[ri] ? (v[ri][i] * rstd * gg * (1.0f + sc) + sh) : (f32x4){0.f, 0.f, 0.f, 0.f};
                    }
                }
            }
        }
        __syncthreads();
        {
            const int row = tid >> 5, q = tid & 31;
#pragma unroll
            for (int pc = 0; pc < 4; ++pc) {
                const int c = pc * 256 + q * 8;
                f32x4 hp[2], hc[2], hn[2], xx[2];
#pragma unroll
                for (int e = 0; e < 2; ++e) { hp[e] = *(const LAS f32x4*)(hb + row * HBS + c + 4 * e); hc[e] = *(const LAS f32x4*)(hb + (row + 1) * HBS + c + 4 * e); hn[e] = *(const LAS f32x4*)(hb + (row + 2) * HBS + c + 4 * e);
                    xx[e] = 0.5f * (hp[e] + hn[e]) - hc[e]; }
                const size_t off = (size_t)(t0 + row) * D + c;
#pragma unroll
                for (int jj = 0; jj < 3; ++jj) {
                    const int j = jj == 0 ? 0 : (jj == 1 ? 2 : 3);
                    const f32x4 m0 = *(const LAS f32x4*)(mul + j * D + c), m1 = *(const LAS f32x4*)(mul + j * D + c + 4);
                    const f32x4 o0 = hc[0] + xx[0] * m0, o1 = hc[1] + xx[1] * m1;
                    u32x4 w; w.x = cvt_pk_bf16(o0[0], o0[1]); w.y = cvt_pk_bf16(o0[2], o0[3]); w.z = cvt_pk_bf16(o1[0], o1[1]); w.w = cvt_pk_bf16(o1[2], o1[3]);
                    bf16_t* dst = jj == 0 ? XR : (jj == 1 ? XK : XV);
                    *(u32x4*)(dst + off) = w;
                }
            }
        }
        if (tile + G < T / 16) RMIX_LOADROWS(tile + G);
        if (wave < 6 || (wave == 6 && il == 1)) {
            int jmu, nrow0, ntl, act, ldo, oc0; bf16_t* outp;
            if (wave < 2) { jmu = 1; nrow0 = wave * 64; ntl = 4; act = 1; outp = (bf16_t*)(p->ws + WS_TW); ldo = 128; oc0 = wave * 64; }
            else if (wave < 4) { jmu = 4; nrow0 = 128 + (wave - 2) * 64; ntl = 4; act = 0; outp = (bf16_t*)(p->ws + WS_A1O); ldo = 128; oc0 = (wave - 2) * 64; }
            else if (wave < 6) { jmu = 5; nrow0 = 256 + (wave - 4) * 64; ntl = 4; act = 2; outp = (bf16_t*)(p->ws + WS_SG); ldo = 128; oc0 = (wave - 4) * 64; }
            else { jmu = 3; nrow0 = 384; ntl = 2; act = 0; outp = (bf16_t*)(p->ws + WS_V1O); ldo = 32; oc0 = 0; }
            const int tok = lane & 15, kg = lane >> 4;
            f32x4 acc[4];
#pragma unroll
            for (int n = 0; n < 4; ++n) acc[n] = (f32x4){0.f, 0.f, 0.f, 0.f};
            const LAS float* mup = mul + jmu * D;
            for (int ks0 = 0; ks0 < 32; ks0 += 4) {
                bf16x8 af[4][4];
#pragma unroll
                for (int kk = 0; kk < 4; ++kk)
#pragma unroll
                    for (int n = 0; n < 4; ++n) if (n < ntl) af[kk][n] = *(const bf16x8*)(LD + ((size_t)(((nrow0 >> 4) + n) * 32 + ks0 + kk) * 64 + lane) * 8);
#pragma unroll
                for (int kk = 0; kk < 4; ++kk) {
                    const int k = (ks0 + kk) * 32 + kg * 8;
                    float xm[8];
#pragma unroll
                    for (int e = 0; e < 2; ++e) {
                        const f32x4 hp = *(const LAS f32x4*)(hb + tok * HBS + k + 4 * e), hc = *(const LAS f32x4*)(hb + (tok + 1) * HBS + k + 4 * e), hn = *(const LAS f32x4*)(hb + (tok + 2) * HBS + k + 4 * e);
                        const f32x4 m = *(const LAS f32x4*)(mup + k + 4 * e);
                        const f32x4 o = hc + (0.5f * (hp + hn) - hc) * m;
                        xm[4 * e] = o[0]; xm[4 * e + 1] = o[1]; xm[4 * e + 2] = o[2]; xm[4 * e + 3] = o[3];
                    }
                    u32x4 bw; bw.x = cvt_pk_bf16(xm[0], xm[1]); bw.y = cvt_pk_bf16(xm[2], xm[3]); bw.z = cvt_pk_bf16(xm[4], xm[5]); bw.w = cvt_pk_bf16(xm[6], xm[7]);
                    const bf16x8 bfrag = __builtin_bit_cast(bf16x8, bw);
#pragma unroll
                    for (int n = 0; n < 4; ++n) if (n < ntl) acc[n] = __builtin_amdgcn_mfma_f32_16x16x32_bf16(af[kk][n], bfrag, acc[n], 0, 0, 0);
                }
            }
#pragma unroll
            for (int n = 0; n < 4; ++n) if (n < ntl) {
                f32x4 v = acc[n];
#pragma unroll
                for (int j = 0; j < 4; ++j) v[j] = act == 1 ? tanhf_(v[j]) : (act == 2 ? sigmoidf_(v[j]) : v[j]);
                u32x2 w; w.x = cvt_pk_bf16(v[0], v[1]); w.y = cvt_pk_bf16(v[2], v[3]);
                *(u32x2*)(outp + (size_t)(t0 + tok) * ldo + oc0 + n * 16 + kg * 4) = w;
            }
        }
        __syncthreads();
    }
}

__device__ void sgu_mix_phase(KP p, int l, LAS unsigned char* lds) {
    const int i = l >> 1;
    LAS bf16_t* vt = (LAS bf16_t*)lds;
    const int tid = TIDX(), lane = tid & 63, wave = tid >> 6, G = GDIM();
    const float* lng = p->in[I_SLNG] + i * D; const float* lnb = p->in[I_SLNB] + i * D; const float* bs = p->in[I_SBS] + i * 16 * 128;
    const float* vst = (const float*)(p->ws + WS_VST);
    const bf16_t* U = (const bf16_t*)(p->ws + BIG(2)); const bf16_t* V = (const bf16_t*)(p->ws + BIG(3)); bf16_t* UV = (bf16_t*)(p->ws + BIG(4));
    const bf16_t* WS = (const bf16_t*)(p->ws + W_S);
    const int g = BIDX() & 15;
    f32x4 lgr[4], lbr[4];
    { const int c0 = 64 * g + (tid & 3) * 16;
#pragma unroll
      for (int e = 0; e < 4; ++e) { lgr[e] = *(const f32x4*)(lng + c0 + 4 * e); lbr[e] = *(const f32x4*)(lnb + c0 + 4 * e); } }
    bf16x8 wfr[4];
#pragma unroll
    for (int ks = 0; ks < 4; ++ks) wfr[ks] = *(const bf16x8*)(WS + ((size_t)g * 128 + wave * 16 + (lane & 15)) * 128 + ks * 32 + (lane >> 4) * 8);
    for (int ch = (BIDX() < (G & ~15)) ? (BIDX() >> 4) : T; ch < T / 128; ch += (G >> 4)) {
        {
            const int s = tid >> 2, q = tid & 3, tok = ch * 128 + s, c0 = 64 * g + q * 16;
            float a1, a2;
            { const f32x4 p0 = *(const f32x4*)(vst + (size_t)tok * 32 + 8 * q), p1 = *(const f32x4*)(vst + (size_t)tok * 32 + 8 * q + 4);
              a1 = (p0[0] + p0[2]) + (p1[0] + p1[2]); a2 = (p0[1] + p0[3]) + (p1[1] + p1[3]);
              a1 += dpp_f<0xB1>(a1); a1 += dpp_f<0x4E>(a1); a2 += dpp_f<0xB1>(a2); a2 += dpp_f<0x4E>(a2); }
            const float m1 = a1 * (1.0f / 1024.0f), m2 = a2 * (1.0f / 1024.0f);
            const float rstd = rsqrtf(fmaxf(m2 - m1 * m1, 0.f) + 1e-6f);
            const u32x4 a = *(const u32x4*)(V + (size_t)tok * D + c0), b = *(const u32x4*)(V + (size_t)tok * D + c0 + 8);
            const unsigned wv[8] = {a.x, a.y, a.z, a.w, b.x, b.y, b.z, b.w};
#pragma unroll
            for (int e = 0; e < 8; ++e) {
                const float x0 = (bflo(wv[e]) - m1) * rstd * lgr[e >> 1][(2 * e) & 3] + lbr[e >> 1][(2 * e) & 3], x1 = (bfhi(wv[e]) - m1) * rstd * lgr[e >> 1][(2 * e + 1) & 3] + lbr[e >> 1][(2 * e + 1) & 3];
                vt[(q * 16 + 2 * e) * 136 + s] = f2bf(x0); vt[(q * 16 + 2 * e + 1) * 136 + s] = f2bf(x1);
            }
        }
        __syncthreads();
        {
            const int tl = lane & 15, kg = lane >> 4, tt = wave * 16 + tl;
            f32x4 acc[4];
#pragma unroll
            for (int n = 0; n < 4; ++n) acc[n] = (f32x4){0.f, 0.f, 0.f, 0.f};
#pragma unroll
            for (int ks = 0; ks < 4; ++ks) {
                const bf16x8 bfrag = wfr[ks];
#pragma unroll
                for (int n = 0; n < 4; ++n) {
                    const bf16x8 afrag = *(const LAS bf16x8*)(vt + (n * 16 + tl) * 136 + ks * 32 + kg * 8);
                    acc[n] = __builtin_amdgcn_mfma_f32_16x16x32_bf16(afrag, bfrag, acc[n], 0, 0, 0);
                }
            }
            const int tok = ch * 128 + tt; const float bb = bs[g * 128 + tt];
#pragma unroll
            for (int n = 0; n < 4; ++n) {
                const int c = 64 * g + n * 16 + kg * 4;
                const u32x2 uu = *(const u32x2*)(U + (size_t)tok * D + c);
                const float o0 = (acc[n][0] + bb) * bflo(uu.x), o1 = (acc[n][1] + bb) * bfhi(uu.x), o2 = (acc[n][2] + bb) * bflo(uu.y), o3 = (acc[n][3] + bb) * bfhi(uu.y);
                u32x2 w; w.x = cvt_pk_bf16(o0, o1); w.y = cvt_pk_bf16(o2, o3);
                *(u32x2*)(UV + (size_t)tok * D + c) = w;
            }
        }
        __syncthreads();
    }
}

constexpr int STS = 388;
constexpr int SCAN_HALF_BYTES = (2 * 16 * STS + 2 * 16 * 64) * 4;
#define SVX_GLOAD_A(P, tok0_, L_, d_, h_, chunk) do { const int tt_ = (chunk) * 16 + ts, t_ = (tok0_) + ((d_) ? (L_) - 1 - tt_ : tt_); \
    const unsigned hb_ = (unsigned)(t_ * D + (h_) * 64) * 2u; \
    P##k0 = *(const u32x2*)(wsb + (unsigned)(BIG(5) + hb_ + 8 * kgrp)); P##k1 = *(const u32x2*)(wsb + (unsigned)(BIG(5) + hb_ + 32 + 8 * kgrp)); \
    P##k2 = *(const u32x2*)(wsb + (unsigned)(BIG(5) + hb_ + 64 + 8 * kgrp)); P##k3 = *(const u32x2*)(wsb + (unsigned)(BIG(5) + hb_ + 96 + 8 * kgrp)); \
    P##r = *(const u32x2*)(wsb + (unsigned)(BIG(4) + hb_ + 2 * cown)); P##v = *(const u32x2*)(wsb + (unsigned)(vboff + hb_ + 2 * cown)); \
    if (il == 1) P##vf = *(const u32x2*)(wsb + (unsigned)(BIG(0) + hb_ + 2 * cown)); } while (0)
#define SVX_GLOAD_B(P, tok0_, L_, d_, h_, chunk) do { const int tt_ = (chunk) * 16 + ts, t_ = (tok0_) + ((d_) ? (L_) - 1 - tt_ : tt_); \
    const unsigned lo_ = (unsigned)(t_ * 128 + (d_) * 64 + kgrp * 8) * 2u; \
    P##tw0 = *(const bf16x8*)(wsb + (unsigned)(WS_TW + lo_)); P##tw1 = *(const bf16x8*)(wsb + (unsigned)(WS_TW + lo_ + 64)); \
    P##a0 = *(const bf16x8*)(wsb + (unsigned)(WS_A1O + lo_)); P##a1 = *(const bf16x8*)(wsb + (unsigned)(WS_A1O + lo_ + 64)); \
    if (il == 1) P##v1 = *(const bf16x8*)(wsb + (unsigned)(WS_V1O + (unsigned)(t_ * 32 + kgrp * 8) * 2u)); } while (0)
#define SVX_GLOAD(P, tok0_, L_, d_, h_, chunk) do { SVX_GLOAD_A(P, tok0_, L_, d_, h_, chunk); SVX_GLOAD_B(P, tok0_, L_, d_, h_, chunk); } while (0)
#define SVX_CONSTS(d_, h_) \
    const int ch_ = (h_) * 64 + cown; \
    const unsigned wrow_ = (unsigned)((d_) * D * 64 + ((h_) * 64 + 16 * hw + ts) * 64 + kgrp * 8) * 2u; \
    const bf16x8 wz0 = *(const bf16x8*)(wsb + (unsigned)(W_W2T + wrow_)), wz1 = *(const bf16x8*)(wsb + (unsigned)(W_W2T + wrow_ + 64)); \
    const bf16x8 wa0 = *(const bf16x8*)(wsb + (unsigned)(W_A2T + wrow_)), wa1 = *(const bf16x8*)(wsb + (unsigned)(W_A2T + wrow_ + 64)); \
    bf16x8 wv = wz0; f32x4 v0c = (f32x4){0.f, 0.f, 0.f, 0.f}; \
    if (il == 1) { wv = *(const bf16x8*)(wsb + (unsigned)(W_V2T + (unsigned)(((h_) * 64 + 16 * hw + ts) * 32 + kgrp * 8) * 2u)); v0c = *(const f32x4*)(p->in[I_V0] + ch_); } \
    const f32x4 w0c = *(const f32x4*)(p->in[I_W0] + (size_t)(il * 2 + (d_)) * D + ch_), a0c = *(const f32x4*)(p->in[I_A0] + (size_t)(il * 2 + (d_)) * D + ch_); \
    const f32x4 kac = *(const f32x4*)(p->in[I_KA] + il * D + ch_), rkc = *(const f32x4*)(p->in[I_RK] + il * D + ch_); \
    const float* kkp_ = p->in[I_KK] + il * D + (h_) * 64 + 4 * kgrp;
#define SVX_STAGE(P, tok0_, L_, d_, h_, chunk, stg_, bufi) do { const int tt_ = (chunk) * 16 + ts, t_ = (tok0_) + ((d_) ? (L_) - 1 - tt_ : tt_); \
    f32x4 accz = (f32x4){0.f, 0.f, 0.f, 0.f}, acca = accz; \
    accz = __builtin_amdgcn_mfma_f32_16x16x32_bf16(wz0, P##tw0, accz, 0, 0, 0); accz = __builtin_amdgcn_mfma_f32_16x16x32_bf16(wz1, P##tw1, accz, 0, 0, 0); \
    acca = __builtin_amdgcn_mfma_f32_16x16x32_bf16(wa0, P##a0, acca, 0, 0, 0); acca = __builtin_amdgcn_mfma_f32_16x16x32_bf16(wa1, P##a1, acca, 0, 0, 0); \
    f32x4 kf, kx, sq; \
    { const f32x4 kq_ = (f32x4){bflo(P##k0.x), bfhi(P##k0.x), bflo(P##k0.y), bfhi(P##k0.y)}; const f32x4 xq_ = kq_ * *(const f32x4*)(kkp_); sq = xq_ * xq_; kf = kq_; kx = xq_; } \
    { const f32x4 kq_ = (f32x4){bflo(P##k1.x), bfhi(P##k1.x), bflo(P##k1.y), bfhi(P##k1.y)}; const f32x4 xq_ = kq_ * *(const f32x4*)(kkp_ + 16); sq += xq_ * xq_; if (hw == 1) { kf = kq_; kx = xq_; } } \
    { const f32x4 kq_ = (f32x4){bflo(P##k2.x), bfhi(P##k2.x), bflo(P##k2.y), bfhi(P##k2.y)}; const f32x4 xq_ = kq_ * *(const f32x4*)(kkp_ + 32); sq += xq_ * xq_; if (hw == 2) { kf = kq_; kx = xq_; } } \
    { const f32x4 kq_ = (f32x4){bflo(P##k3.x), bfhi(P##k3.x), bflo(P##k3.y), bfhi(P##k3.y)}; const f32x4 xq_ = kq_ * *(const f32x4*)(kkp_ + 48); sq += xq_ * xq_; if (hw == 3) { kf = kq_; kx = xq_; } } \
    float ss = (sq[0] + sq[1]) + (sq[2] + sq[3]); ss += __shfl_xor(ss, 16); ss += __shfl_xor(ss, 32); \
    const float inv = __builtin_amdgcn_rsqf(fmaxf(ss, 1e-24f)); \
    const f32x4 zz = accz + w0c, ap = acca + a0c; \
    f32x4 nkk, wv_, bv_, kd_, rv_, vv_; \
    rv_ = (f32x4){bflo(P##r.x), bfhi(P##r.x), bflo(P##r.y), bfhi(P##r.y)}; vv_ = (f32x4){bflo(P##v.x), bfhi(P##v.x), bflo(P##v.y), bfhi(P##v.y)}; \
    if (il == 1) { f32x4 accv = (f32x4){0.f, 0.f, 0.f, 0.f}; accv = __builtin_amdgcn_mfma_f32_16x16x32_bf16(wv, P##v1, accv, 0, 0, 0); \
        const f32x4 vf_ = (f32x4){bflo(P##vf.x), bfhi(P##vf.x), bflo(P##vf.y), bfhi(P##vf.y)}; \
        _Pragma("unroll") for (int j = 0; j < 4; ++j) vv_[j] = vv_[j] + (vf_[j] - vv_[j]) * sigmoidf_(v0c[j] + accv[j]); \
        if ((d_) == 0) { u32x2 w_; w_.x = cvt_pk_bf16(vv_[0], vv_[1]); w_.y = cvt_pk_bf16(vv_[2], vv_[3]); *(u32x2*)(wsb + (unsigned)(BIG(7) + (unsigned)(t_ * D + (h_) * 64 + cown) * 2u)) = w_; } } \
    float bsum = 0.f; \
    _Pragma("unroll") for (int j = 0; j < 4; ++j) { \
        const float kk = kx[j] * inv, a = sigmoidf_(ap[j]); \
        const float lw = -0.6065306597f * sigmoidf_(zz[j]);            \
        float li = lw; li += dpp_f<0x111>(li); li += dpp_f<0x112>(li); li += dpp_f<0x114>(li); li += dpp_f<0x118>(li);     \
        const float pin = __expf(li), pex = __expf(li - lw), ipn = rcpf_(pin); \
        const float kdj = kf[j] * (1.0f + (a - 1.0f) * kac[j]); \
        bsum += rv_[j] * kdj * rkc[j]; \
        nkk[j] = -kk * pex; wv_[j] = pin; bv_[j] = kk * a * ipn; kd_[j] = kdj * ipn; rv_[j] = rv_[j] * pin; } \
    bsum += __shfl_xor(bsum, 16); bsum += __shfl_xor(bsum, 32); \
    if (kgrp == 0) *(float*)(wsb + (unsigned)(BIG(3) + (unsigned)((((d_) * T + t_) * 16 + (h_)) * 4 + hw) * 4u)) = bsum; \
    LAS float* sp_ = (stg_) + ((bufi) * 16 + ts) * STS + cown; \
    *(LAS f32x4*)(sp_) = nkk; *(LAS f32x4*)(sp_ + 64) = wv_; *(LAS f32x4*)(sp_ + 128) = bv_; *(LAS f32x4*)(sp_ + 192) = kd_; *(LAS f32x4*)(sp_ + 256) = rv_; *(LAS f32x4*)(sp_ + 320) = vv_; } while (0)
#define SVX_YSTORE(tok0_, L_, d_, h_, chunk, ybuf_, bufi) do { const int tt_ = (chunk) * 16 + ts, t_ = (tok0_) + ((d_) ? (L_) - 1 - tt_ : tt_); \
    const f32x4 y_ = *(const LAS f32x4*)((ybuf_) + ((bufi) * 16 + ts) * 64 + cown); \
    u32x2 w_; w_.x = cvt_pk_bf16(y_[0], y_[1]); w_.y = cvt_pk_bf16(y_[2], y_[3]); \
    *(u32x2*)(wsb + (unsigned)(BIG(1) + (unsigned)(d_) * (unsigned)BIGSZ + (unsigned)(t_ * D + (h_) * 64 + cown) * 2u)) = w_; } while (0)
#define SCAN_LDV(X, sp_) do { \
    X##nk0 = *(const LAS f32x4*)((sp_) + 8 * cg); X##nk1 = *(const LAS f32x4*)((sp_) + 8 * cg + 4); \
    X##b0 = *(const LAS f32x4*)((sp_) + 128 + 8 * cg); X##b1 = *(const LAS f32x4*)((sp_) + 128 + 8 * cg + 4); \
    X##k0 = *(const LAS f32x4*)((sp_) + 192 + 8 * cg); X##k1 = *(const LAS f32x4*)((sp_) + 192 + 8 * cg + 4); \
    X##r0 = *(const LAS f32x4*)((sp_) + 256 + 8 * cg); X##r1 = *(const LAS f32x4*)((sp_) + 256 + 8 * cg + 4); \
    X##vr = *(const LAS f32x2*)((sp_) + 320 + 16 * hw + 2 * rg); } while (0)
#define SCAN_STEP(X, yp_) do { \
    const f32x2 nk[4] = {{X##nk0[0], X##nk0[1]}, {X##nk0[2], X##nk0[3]}, {X##nk1[0], X##nk1[1]}, {X##nk1[2], X##nk1[3]}}; \
    const f32x2 bb[4] = {{X##b0[0], X##b0[1]}, {X##b0[2], X##b0[3]}, {X##b1[0], X##b1[1]}, {X##b1[2], X##b1[3]}}; \
    const f32x2 kd[4] = {{X##k0[0], X##k0[1]}, {X##k0[2], X##k0[3]}, {X##k1[0], X##k1[1]}, {X##k1[2], X##k1[3]}}; \
    const f32x2 rr[4] = {{X##r0[0], X##r0[1]}, {X##r0[2], X##r0[3]}, {X##r1[0], X##r1[1]}, {X##r1[2], X##r1[3]}}; \
    float yo[2]; \
    _Pragma("unroll") for (int a = 0; a < 2; ++a) { \
        f32x2 t = s[a][0] * nk[0]; t += s[a][1] * nk[1]; t += s[a][2] * nk[2]; t += s[a][3] * nk[3]; \
        const float sa = red8(t[0] + t[1]); \
        const f32x2 sa2 = (f32x2){sa, sa}, v2 = (f32x2){X##vr[a], X##vr[a]}; \
        _Pragma("unroll") for (int bp = 0; bp < 4; ++bp) s[a][bp] = s[a][bp] + sa2 * bb[bp] + v2 * kd[bp]; \
        f32x2 y = s[a][0] * rr[0]; y += s[a][1] * rr[1]; y += s[a][2] * rr[2]; y += s[a][3] * rr[3]; \
        yo[a] = y[0] + y[1]; } \
      \
    { float keep_ = cg < 4 ? yo[0] : yo[1]; const float send_ = cg < 4 ? yo[1] : yo[0]; \
      keep_ += dpp_f<0x141>(send_); keep_ += dpp_f<0xB1>(keep_); keep_ += dpp_f<0x4E>(keep_); \
      if ((cg & 3) == 0) *(LAS float*)((yp_) + (cg >> 2)) = keep_; } } while (0)
#define SCAN_RENORM(sp15_) do { const f32x4 p0_ = *(const LAS f32x4*)((sp15_) + 64 + 8 * cg), p1_ = *(const LAS f32x4*)((sp15_) + 64 + 8 * cg + 4); \
    const f32x2 pp_[4] = {{p0_[0], p0_[1]}, {p0_[2], p0_[3]}, {p1_[0], p1_[1]}, {p1_[2], p1_[3]}}; \
    _Pragma("unroll") for (int a = 0; a < 2; ++a) _Pragma("unroll") for (int bp = 0; bp < 4; ++bp) s[a][bp] = s[a][bp] * pp_[bp]; } while (0)
__device__ void scan_phase(KP p, int l, LAS unsigned char* lds) {
    const int il = l >> 1;
    const int tid = TIDX(), hb = tid >> 8, ht = tid & 255, hw = ht >> 6, lane = tid & 63, cg = lane & 7, rg = lane >> 3, G = GDIM();
    const int ts = lane & 15, kgrp = lane >> 4, cown = 16 * hw + 4 * kgrp;
    unsigned char* wsb = p->ws; const unsigned vboff = (unsigned)(il == 0 ? BIG(0) : BIG(6));
    LAS float* stg0 = (LAS float*)lds; LAS float* ybuf0 = stg0 + 2 * 16 * STS;
    LAS float* stg1 = (LAS float*)(lds + SCAN_HALF_BYTES); LAS float* ybuf1 = stg1 + 2 * 16 * STS;
    for (int slot = BIDX(); slot < 256; slot += G) {
        const int lh = (slot & 31) >> 1, ldir = slot & 1, ltok0 = TC + (slot >> 5) * 2048;
        f32x2 s[2][4];
        f32x4 Ank0, Ank1, Ab0, Ab1, Ak0, Ak1, Ar0, Ar1; f32x2 Avr;
        f32x4 Bnk0, Bnk1, Bb0, Bb1, Bk0, Bk1, Br0, Br1; f32x2 Bvr;
        if (hb == 0) {
            {
                const float* si = p->in[I_STATE] + ((size_t)(((slot >> 5) * 2 + il) * 2 + ldir) * 16 + lh) * 4096;
#pragma unroll
                for (int a = 0; a < 2; ++a)
#pragma unroll
                    for (int bp = 0; bp < 4; ++bp) s[a][bp] = *(const f32x2*)(si + (16 * hw + 2 * rg + a) * 64 + 8 * cg + 2 * bp);
                float one = 1.0f; asm volatile("" : "+v"(one));
#pragma unroll
                for (int a = 0; a < 2; ++a)
#pragma unroll
                    for (int bp = 0; bp < 4; ++bp) s[a][bp] = s[a][bp] * one;
            }
            for (int ci = 0; ci < 128; ++ci) {
                const int buf = ci & 1;
                LDS_BARRIER();
                __builtin_amdgcn_s_setprio(2);
                const LAS float* sb = stg0 + (buf * 16) * STS; LAS float* yb = ybuf0 + (buf * 16) * 64 + 16 * hw + 2 * rg;
                SCAN_LDV(A, sb);
#pragma unroll
                for (int st = 0; st < 16; st += 2) {
                    SCAN_LDV(B, sb + (st + 1) * STS);
                    SCAN_STEP(A, yb + st * 64);
                    if (st + 2 < 16) SCAN_LDV(A, sb + (st + 2) * STS);
                    SCAN_STEP(B, yb + (st + 1) * 64);
                }
                SCAN_RENORM(sb + 15 * STS);
                __builtin_amdgcn_s_setprio(0);
                LDS_BARRIER();
            }
        } else {
            u32x2 Lk0, Lk1, Lk2, Lk3, Lr, Lv, Lvf; bf16x8 Ltw0, Ltw1, La0, La1, Lv1;
            u32x2 Sk0, Sk1, Sk2, Sk3, Sr, Sv, Svf; bf16x8 Stw0, Stw1, Sa0, Sa1, Sv1;
            Lvf = Svf = (u32x2){0u, 0u}; Lv1 = Sv1 = (bf16x8){0, 0, 0, 0, 0, 0, 0, 0};
#pragma unroll
            for (int a = 0; a < 2; ++a)
#pragma unroll
                for (int bp = 0; bp < 4; ++bp) s[a][bp] = (f32x2){0.f, 0.f};
            {
                SVX_GLOAD(L, ltok0, 2048, ldir, lh, 0);
                const int sid = slot * 2, sh = (sid & 31) >> 1, sd = sid & 1, stok0 = (sid >> 5) * 256;
                SVX_GLOAD(S, stok0, 256, sd, sh, 0);
                { SVX_CONSTS(ldir, lh) SVX_STAGE(L, ltok0, 2048, ldir, lh, 0, stg0, 0); }
                { SVX_CONSTS(sd, sh) SVX_STAGE(S, stok0, 256, sd, sh, 0, stg1, 0); }
                SVX_GLOAD(L, ltok0, 2048, ldir, lh, 1);
            }
            SVX_CONSTS(ldir, lh)
            for (int ci = 0; ci < 128; ++ci) {
                const int buf = ci & 1;
                LDS_BARRIER();
                if (ci + 1 < 128) SVX_STAGE(L, ltok0, 2048, ldir, lh, ci + 1, stg0, buf ^ 1);
                __builtin_amdgcn_sched_barrier(0);
                if (ci + 2 < 128) SVX_GLOAD(L, ltok0, 2048, ldir, lh, ci + 2);
                __builtin_amdgcn_sched_barrier(0);
                const int cj = (ci >> 2) & 15, q = ci & 3, sbuf = cj & 1;
                {
                    const LAS float* sb = stg1 + (sbuf * 16 + 4 * q) * STS; LAS float* yb = ybuf1 + (sbuf * 16 + 4 * q) * 64 + 16 * hw + 2 * rg;
                    SCAN_LDV(A, sb); SCAN_STEP(A, yb); __builtin_amdgcn_sched_barrier(0);
                    SCAN_LDV(A, sb + STS); SCAN_STEP(A, yb + 64); __builtin_amdgcn_sched_barrier(0);
                    SCAN_LDV(A, sb + 2 * STS); SCAN_STEP(A, yb + 128); __builtin_amdgcn_sched_barrier(0);
                    SCAN_LDV(A, sb + 3 * STS); SCAN_STEP(A, yb + 192);
                    if (q == 3) SCAN_RENORM(stg1 + (sbuf * 16 + 15) * STS);
                }
                __builtin_amdgcn_sched_barrier(0);
                const int gc = (ci >> 2) + 1;
                if (gc < 32 && (q == 0 || q == 2)) {
                    const int sid = slot * 2 + (gc >> 4), sh = (sid & 31) >> 1, sd = sid & 1, stok0 = (sid >> 5) * 256;
                    if (q == 0) SVX_GLOAD_A(S, stok0, 256, sd, sh, gc & 15);
                    else { SVX_GLOAD_B(S, stok0, 256, sd, sh, gc & 15); SVX_CONSTS(sd, sh) SVX_STAGE(S, stok0, 256, sd, sh, gc & 15, stg1, gc & 1); }
                }
                LDS_BARRIER();
                SVX_YSTORE(ltok0, 2048, ldir, lh, ci, ybuf0, buf);
                {
                    const int sid = slot * 2 + (ci >> 6), sb_ = sid >> 5, sh = (sid & 31) >> 1, sd = sid & 1, stok0 = sb_ * 256;
                    if (q == 3) SVX_YSTORE(stok0, 256, sd, sh, cj, ybuf1, sbuf);
                    if ((ci & 63) == 63) {
                        float* so = p->out + (size_t)T * D + ((size_t)((sb_ * 2 + il) * 2 + sd) * 16 + sh) * 4096;
#pragma unroll
                        for (int a = 0; a < 2; ++a)
#pragma unroll
                            for (int bp = 0; bp < 4; ++bp) { *(f32x2*)(so + (16 * hw + 2 * rg + a) * 64 + 8 * cg + 2 * bp) = s[a][bp]; s[a][bp] = (f32x2){0.f, 0.f}; }
                    }
                }
            }
        }
        __syncthreads();
    }
}

__device__ void post_phase(KP p, int l) {
    const int il = l >> 1;
    const int lane = TIDX() & 63, gw = BIDX() * 8 + (TIDX() >> 6), nw = GDIM() * 8;
    const int tl = lane & 15, kg = lane >> 4;
    const bf16_t* G2T = (const bf16_t*)(p->ws + W_G2T); const bf16_t* SG = (const bf16_t*)(p->ws + WS_SG);
    const bf16_t* Y0 = (const bf16_t*)(p->ws + BIG(1)); const bf16_t* Y1 = (const bf16_t*)(p->ws + BIG(2));
    const bf16_t* Vb = (const bf16_t*)(p->ws + (il == 0 ? BIG(0) : BIG(7)));
    bf16_t* YG = (bf16_t*)(p->ws + BIG(4));
    const float* BONP = (const float*)(p->ws + BIG(3));
    const float* lng = p->in[I_LNG] + il * D; const float* lnb = p->in[I_LNB] + il * D;
    const int h = gw & 15, tlanes = nw >> 4;
    bf16x8 gfr[4][4]; f32x4 lgv[4], lbv[4];
#pragma unroll
    for (int n = 0; n < 4; ++n) {
#pragma unroll
        for (int ks = 0; ks < 4; ++ks) gfr[ks][n] = *(const bf16x8*)(G2T + (size_t)(h * 64 + n * 16 + tl) * 128 + ks * 32 + kg * 8);
        lgv[n] = *(const f32x4*)(lng + h * 64 + n * 16 + kg * 4); lbv[n] = *(const f32x4*)(lnb + h * 64 + n * 16 + kg * 4);
    }
    for (int tile = (gw < (nw & ~15)) ? (gw >> 4) : T; tile < T / 16; tile += tlanes) {
        const int tok0 = tile * 16, tk = tok0 + tl;
        f32x4 ag[4];
#pragma unroll
        for (int n = 0; n < 4; ++n) ag[n] = (f32x4){0.f, 0.f, 0.f, 0.f};
#pragma unroll
        for (int ks = 0; ks < 4; ++ks) {
            const bf16x8 bg = *(const bf16x8*)(SG + (size_t)tk * 128 + ks * 32 + kg * 8);
#pragma unroll
            for (int n = 0; n < 4; ++n) ag[n] = __builtin_amdgcn_mfma_f32_16x16x32_bf16(gfr[ks][n], bg, ag[n], 0, 0, 0);
        }
        f32x4 y[4]; float s1 = 0.f;
#pragma unroll
        for (int n = 0; n < 4; ++n) {
            const size_t off = (size_t)tk * D + h * 64 + n * 16 + kg * 4;
            const u32x2 a = *(const u32x2*)(Y0 + off), b = *(const u32x2*)(Y1 + off);
            y[n] = (f32x4){bflo(a.x) + bflo(b.x), bfhi(a.x) + bfhi(b.x), bflo(a.y) + bflo(b.y), bfhi(a.y) + bfhi(b.y)};
            s1 += y[n][0] + y[n][1] + y[n][2] + y[n][3];
        }
        s1 += __shfl_xor(s1, 16); s1 += __shfl_xor(s1, 32);
        const float mean = s1 * (1.0f / 64.0f); float s2 = 0.f;
#pragma unroll
        for (int n = 0; n < 4; ++n)
#pragma unroll
            for (int j = 0; j < 4; ++j) { const float dd = y[n][j] - mean; s2 += dd * dd; }
        s2 += __shfl_xor(s2, 16); s2 += __shfl_xor(s2, 32);
        const float rstd = rsqrtf(s2 * (1.0f / 64.0f) + 64e-5f);
        const f32x4 bq0 = *(const f32x4*)(BONP + ((size_t)tk * 16 + h) * 4), bq1 = *(const f32x4*)(BONP + ((size_t)(T + tk) * 16 + h) * 4);
        const float bon = ((bq0[0] + bq0[1]) + (bq0[2] + bq0[3])) + ((bq1[0] + bq1[1]) + (bq1[2] + bq1[3]));
#pragma unroll
        for (int n = 0; n < 4; ++n) {
            const int c = h * 64 + n * 16 + kg * 4; const size_t off = (size_t)tk * D + c;
            const u32x2 vv = *(const u32x2*)(Vb + off);
            const float vx[4] = {bflo(vv.x), bfhi(vv.x), bflo(vv.y), bfhi(vv.y)};
            const f32x4 gg = lgv[n], gb = lbv[n];
            float o[4];
#pragma unroll
            for (int j = 0; j < 4; ++j) o[j] = ((y[n][j] - mean) * rstd * gg[j] + gb[j] + bon * vx[j]) * ag[n][j];
            u32x2 w; w.x = cvt_pk_bf16(o[0], o[1]); w.y = cvt_pk_bf16(o[2], o[3]);
            *(u32x2*)(YG + off) = w;
        }
    }
}


#define XB_TMO      128
#define XB_XCNT(j)  (256  + 64 * (j))
#define XB_XSUB(j)  (1280 + 64 * (j))
#define XB_XGEN(j)  (2304 + 64 * (j))
#define XB_TOP      3328
#define XB_TOPGEN   3392
#define XCD_BAR_WORDS 3456
#define XB_SPIN_CAP (1u << 22)
__device__ __forceinline__ unsigned xb_ld(unsigned* p)              { return __hip_atomic_load(p, __ATOMIC_RELAXED, __HIP_MEMORY_SCOPE_AGENT); }
__device__ __forceinline__ unsigned xb_add(unsigned* p, unsigned v) { return __hip_atomic_fetch_add(p, v, __ATOMIC_RELAXED, __HIP_MEMORY_SCOPE_AGENT); }
__device__ __forceinline__ unsigned xb_xcc_id() { return (unsigned)__builtin_amdgcn_s_getreg((3 << 11) | 20) & 0xFu; }
#define XB_SPIN(cond, bar) do { unsigned _sp = 0; while (cond) { __builtin_amdgcn_s_sleep(1); \
    if ((++_sp & 255u) == 0u) { if (xb_ld(&(bar)[XB_TMO])) break; if (_sp > XB_SPIN_CAP) { atomicAdd(&(bar)[XB_TMO], 1u); break; } } } } while (0)
__device__ __forceinline__ void xcd_barrier_complete(unsigned* bar, unsigned x, unsigned& nloc, unsigned& nx) {
    const unsigned G = gridDim.x;
    unsigned sum, cnt, mine, sp = 0u;
    for (;;) {
        sum = 0u; cnt = 0u; mine = 0u;
#pragma unroll
        for (unsigned j = 0; j < 16; ++j) { const unsigned c = xb_ld(&bar[XB_XCNT(j)]); sum += c; cnt += (c > 0u) ? 1u : 0u; mine = (j == x) ? c : mine; }
        if (sum == G) break;
        __builtin_amdgcn_s_sleep(1);
        if ((++sp & 255u) == 0u) { if (xb_ld(&bar[XB_TMO])) break; if (sp > XB_SPIN_CAP) { atomicAdd(&bar[XB_TMO], 1u); break; } }
    }
    nloc = mine > 0u ? mine : 1u; nx = cnt > 0u ? cnt : 1u;
}
__device__ __forceinline__ void xcd_barrier(unsigned* bar, volatile LAS unsigned* st) {
    asm volatile("s_waitcnt vmcnt(0)" ::: "memory");
    __syncthreads();
    if (threadIdx.x == 0) {
        const unsigned x = xb_xcc_id();
        __builtin_amdgcn_s_waitcnt(0);
        unsigned nloc = st[0], nx = st[1];
        if (nloc == 0u) { xcd_barrier_complete(bar, x, nloc, nx); st[0] = nloc; st[1] = nx; }
        const unsigned old = xb_add(&bar[XB_XSUB(x)], 1u);
        const unsigned gen = old / nloc;
        if (old + 1u == (gen + 1u) * nloc) {
            __builtin_amdgcn_fence(__ATOMIC_RELEASE, "agent");
            asm volatile("s_waitcnt vmcnt(0)" ::: "memory");
            const unsigned og = xb_add(&bar[XB_TOP], 1u);
            const unsigned tg = og / nx;
            if (og + 1u == (tg + 1u) * nx) xb_add(&bar[XB_TOPGEN], 1u);
            else XB_SPIN(xb_ld(&bar[XB_TOPGEN]) == tg, bar);
            __builtin_amdgcn_fence(__ATOMIC_ACQUIRE, "agent");
            xb_add(&bar[XB_XGEN(x)], 1u);
            asm volatile("s_waitcnt vmcnt(0)" ::: "memory");
        } else {
            XB_SPIN(xb_ld(&bar[XB_XGEN(x)]) == gen, bar);
            __builtin_amdgcn_fence(__ATOMIC_ACQUIRE, "agent");
            asm volatile("s_waitcnt vmcnt(0)" ::: "memory");
        }
    }
    __syncthreads();
}

constexpr int N_PHASES = 1 + 7 + 9 + 7 + 9 + 1;


__device__ __forceinline__ int phase_opcode(int ph) {
    if (ph == 0) return 30;
    if (ph == N_PHASES - 1) return 31;
    int q = ph - 1, l;
    if (q < 7) l = 0; else if (q < 16) { l = 1; q -= 7; } else if (q < 23) { l = 2; q -= 16; } else { l = 3; q -= 23; }
    if ((l & 1) == 0) return q < 4 ? q : 10 + (q - 4);
    return q < 6 ? 20 + q : 10 + (q - 6);
}
#define REGION_T0() unsigned long long rt0_ = 0; if (PROFMASK != 0u && blockIdx.x == 0 && threadIdx.x == 0) rt0_ = __builtin_amdgcn_s_memrealtime()
#define REGION_T1(bit) do { if (PROFMASK != 0u && ((PROFMASK >> (bit)) & 1u) && blockIdx.x == 0 && threadIdx.x == 0) ((volatile LAS unsigned*)(lds + 131072))[2] += (unsigned)(__builtin_amdgcn_s_memrealtime() - rt0_); } while (0)
__device__ void run_phase(KP p, int ph, LAS unsigned char* lds) {
    const int G = GDIM(), bid = BIDX();
    unsigned char* ws = p->ws;
    const float* mod = (const float*)(ws + WS_MOD);
    if (ph == 0 && OPEN(30)) {
        if (DUP(14)) { ada_phase(p, lds); wconv_sgu(p, 0, (LAS float*)lds); }
        if (DUP(15)) { const unsigned long long t0 = __builtin_amdgcn_s_memrealtime(); while (__builtin_amdgcn_s_memrealtime() - t0 < 50000ull) __builtin_amdgcn_s_sleep(8); }
        ada_phase(p, lds);
        wconv_sgu(p, 0, (LAS float*)lds);
        return;
    }
    if (ph == N_PHASES - 1) { if (OPEN(31)) final_norm_phase(p); return; }
    int q = ph - 1, l;
    if (q < 7) l = 0; else if (q < 16) { l = 1; q -= 7; } else if (q < 23) { l = 2; q -= 16; } else { l = 3; q -= 23; }
    const bool sgu = (l & 1) == 0;
    const float* modl = mod + (size_t)l * 9 * 6144;
    int op;
    if (sgu) op = q < 4 ? q : 10 + (q - 4); else op = q < 6 ? 20 + q : 10 + (q - 6);
    const float* xp_lo = p->out; const float* xp_hi = p->out;
    if (l == 0 && op == 3) { xp_lo = p->in[I_XP]; xp_hi = p->in[I_XS] - (size_t)TC * D; }
    pg8::Sched S;
    switch (op) {
    case 0: if (!OPEN(0)) break;
        if (l > 0) { if (DUP(2)) wconv_sgu(p, l, (LAS float*)lds); wconv_sgu(p, l, (LAS float*)lds); }
        if (DUP(3)) norm_phase(p, l, 0, l == 0, (bf16_t*)(ws + BIG(1)));
        norm_phase(p, l, 0, l == 0, (bf16_t*)(ws + BIG(1)));
        break;
    case 1: if (!OPEN(1)) break; {
        S.init(ws + BIG(1), 0, ws + W_INT, 0, 8, D, T, 2048, G, bid);
        EpiGeluUV E{(bf16_t*)(ws + BIG(2)), (bf16_t*)(ws + BIG(3)), (float*)(ws + WS_VST)};
        if (DUP(12)) { pg8::gemm_phase(lds, S, E); __syncthreads(); }
        pg8::gemm_phase(lds, S, E);
    } break;
    case 2: if (!OPEN(2)) break; if (DUP(8)) sgu_mix_phase(p, l, lds); sgu_mix_phase(p, l, lds); break;
    case 3: if (!OPEN(3)) break; {
        S.init(ws + BIG(4), 0, ws + W_OUTT, 0, 4, D, T, D, G, bid);
        EpiRes E{xp_lo, xp_hi, p->out, modl, 2048, 0};
        if (DUP(13)) { EpiRes E2 = E; int dry = 1; asm volatile("" : "+s"(dry)); E2.dry = dry; pg8::gemm_phase(lds, S, E2); __syncthreads(); }
        pg8::gemm_phase(lds, S, E);
    } break;
    case 10: if (!OPEN(10)) break;
        if (sgu) { if (DUP(2)) wconv_rwkv_lora_down(p, l + 1, (LAS float*)lds); wconv_rwkv_lora_down(p, l + 1, (LAS float*)lds); }
        if (DUP(3)) norm_phase(p, l, 1, false, (bf16_t*)(ws + BIG(1)));
        norm_phase(p, l, 1, false, (bf16_t*)(ws + BIG(1)));
        break;
    case 11: if (!OPEN(11)) break; {
        const int merged = ((G == 256) && MERGED_MLP) ? 1 : 0;
        S.init(ws + BIG(1), 0, ws + W_MLP1T, 0, 16, D, T, DFF, G, bid, merged, (unsigned*)(ws + WS_RDY) + (size_t)l * 80 * 64);
        EpiBf16<1> E{(bf16_t*)(ws + BIG(2)), nullptr, nullptr, DFF, merged};
        pg8::gemm_phase(lds, S, E);
        if (!merged) break;
    }
    case 12: if (!OPEN(12)) break; {
        const int merged = ((G == 256) && MERGED_MLP) ? 2 : 0;
        pg8::Sched S2;
        S2.init(ws + BIG(2), 0, ws + W_MLP2T, 0, 4, DFF, T, D, G, bid, merged, (unsigned*)(ws + WS_RDY) + (size_t)l * 80 * 64);
        EpiRes E{p->out, p->out, p->out, modl, 5120, 0};
        pg8::gemm_phase(lds, S2, E);
    } break;
    case 20: if (!OPEN(20)) break;
        if (DUP(2)) wconv_rwkv_main(p, l, (LAS float*)lds);
        { REGION_T0(); wconv_rwkv_main(p, l, (LAS float*)lds); __syncthreads(); REGION_T1(26); }
        { REGION_T0(); rmix_phase(p, l, lds); REGION_T1(27); }
        break;
    case 21: if (!OPEN(21)) break; {
        S.init(ws + BIG(1), BIGSZ, ws + W_RT, 2 * MiB, 4, D, T, 3 * D, G, bid);
        EpiBf16<0> E{(bf16_t*)(ws + BIG(4)), (bf16_t*)(ws + BIG(5)), (bf16_t*)(ws + (l == 1 ? BIG(0) : BIG(6))), D, 0};
        if (DUP(11)) { pg8::gemm_phase(lds, S, E); __syncthreads(); }
        pg8::gemm_phase(lds, S, E);
    } break;
    case 22: break;
    case 23: if (!OPEN(23)) break; scan_phase(p, l, lds); break;
    case 24: if (!OPEN(24)) break; if (DUP(7)) post_phase(p, l); post_phase(p, l); break;
    case 25: if (!OPEN(25)) break; {
        S.init(ws + BIG(4), 0, ws + W_OT, 0, 4, D, T, D, G, bid);
        EpiRes E{p->out, p->out, p->out, modl, 2048, 0};
        pg8::gemm_phase(lds, S, E);
    } break;
    default: break;
    }
}

__global__ void __launch_bounds__(NTHREADS, 2) mega(Params p_unused) {
    extern __shared__ __attribute__((aligned(16))) unsigned char smem[];
    LAS unsigned char* lds = (LAS unsigned char*)smem;
#if MULTI_LAUNCH
    run_phase(kparams(), kparams()->ph_lo, lds);
#else
    cg::grid_group grid = cg::this_grid();
    const int lo = kparams()->ph_lo, hi = kparams()->ph_hi;
    volatile LAS unsigned* st = (volatile LAS unsigned*)(lds + 131072);
    if (threadIdx.x == 0) { st[0] = 0u; st[1] = 0u; st[2] = 0u; st[3] = 0u; }
    __syncthreads();
    if (threadIdx.x == 0) (void)xb_add(&((unsigned*)(kparams()->ws + WS_BAR))[XB_XCNT(xb_xcc_id())], 1u);
    if (lo > hi) grid.sync();
    for (int ph = lo; ph < hi; ++ph) {
        if (phase_opcode(ph) == 22) continue;
        if (phase_opcode(ph) == 12 && gridDim.x == 256 && MERGED_MLP) continue;
        unsigned long long t0 = 0;
        if (PROFMASK != 0u && blockIdx.x == 0 && threadIdx.x == 0) t0 = __builtin_amdgcn_s_memrealtime();
        run_phase(kparams(), ph, lds);
        if (ph + 1 < hi) xcd_barrier((unsigned*)(kparams()->ws + WS_BAR), (volatile LAS unsigned*)(lds + 131072));
        if (PROFMASK != 0u && blockIdx.x == 0 && threadIdx.x == 0 && ((PROFMASK >> phase_opcode(ph)) & 1u)) st[2] += (unsigned)(__builtin_amdgcn_s_memrealtime() - t0);
    }
    if (PROFMASK != 0u && blockIdx.x == 0 && threadIdx.x == 0) { const unsigned long long t0 = __builtin_amdgcn_s_memrealtime(); const unsigned long long dt = st[2]; while (__builtin_amdgcn_s_memrealtime() - t0 < dt) __builtin_amdgcn_s_sleep(8); }
#endif
}

extern "C" void kernel_launch(void* const* d_in, const int* in_sizes, int n_in, void* d_out, int out_size, void* d_ws, size_t ws_size, hipStream_t stream) {
    static int grid = 0;
    if (grid == 0) {
        int dev = 0, cus = 0, per_cu = 0;
        hipGetDevice(&dev);
        hipDeviceGetAttribute(&cus, hipDeviceAttributeMultiprocessorCount, dev);
        if (hipFuncSetAttribute((const void*)mega, hipFuncAttributeMaxDynamicSharedMemorySize, LDS_BYTES) != hipSuccess) { fprintf(stderr, "hipFuncSetAttribute failed\n"); grid = -1; return; }
        if (hipOccupancyMaxActiveBlocksPerMultiprocessor(&per_cu, (const void*)mega, NTHREADS, LDS_BYTES) != hipSuccess || per_cu < 1) { fprintf(stderr, "occupancy query failed (%d)\n", per_cu); per_cu = 1; }
        (void)hipGetLastError();
        grid = cus * (per_cu < 1 ? 1 : (per_cu > 1 ? 1 : per_cu));
        if (ws_size < BIG(8)) fprintf(stderr, "workspace too small: %zu < %zu\n", ws_size, (size_t)BIG(8));
    }
    if (grid < 0) return;
    Params hp{};
    for (int i = 0; i < N_IN; ++i) hp.in[i] = (const float*)d_in[i];
    hp.out = (float*)d_out; hp.ws = (unsigned char*)d_ws;
#if MULTI_LAUNCH
    for (int ph = 0; ph < N_PHASES; ++ph) {
        hp.ph_lo = ph; hp.ph_hi = ph + 1;
        hipLaunchKernelGGL(mega, dim3(grid), dim3(NTHREADS), LDS_BYTES, stream, hp);
    }
#else
    hp.ph_lo = 0; hp.ph_hi = N_PHASES;
    if (hipMemsetAsync((char*)d_ws + WS_BAR, 0, 16 * 1024 + 4 * 80 * 256, stream) != hipSuccess) { fprintf(stderr, "memset of barrier words failed\n"); return; }
    void* args[] = {&hp};
    hipError_t e = hipLaunchCooperativeKernel((const void*)mega, dim3(grid), dim3(NTHREADS), args, LDS_BYTES, stream);
    if (e != hipSuccess) fprintf(stderr, "cooperative launch failed: %s (grid %d)\n", hipGetErrorString(e), grid);
#endif
}
```

```cpp
#include <hip/hip_runtime.h>
#include <hip/hip_cooperative_groups.h>
#include <cstdio>
namespace cg = cooperative_groups;

#define LAS __attribute__((address_space(3)))
typedef unsigned short bf16_t;
typedef short bf16x8 __attribute__((ext_vector_type(8)));
typedef float f32x4 __attribute__((ext_vector_type(4)));
typedef float f32x2 __attribute__((ext_vector_type(2)));
typedef unsigned u32x4 __attribute__((ext_vector_type(4)));
typedef unsigned u32x2 __attribute__((ext_vector_type(2)));

#ifndef OPMASK
#define OPMASK 0xFFFFFFFFu
#endif
#define OPEN(b) ((OPMASK >> (b)) & 1u)
#ifndef DUPMASK
#define DUPMASK 0u
#endif
#define DUP(b) ((DUPMASK >> (b)) & 1u)
#ifndef SCANVAR
#define SCANVAR 0
#endif
#ifndef PROFMASK
#define PROFMASK 0u
#endif
#ifndef MERGED_MLP
#define MERGED_MLP 1
#endif
#ifndef MULTI_LAUNCH
#define MULTI_LAUNCH 0
#endif

constexpr int T = 20480, TC = 4096, D = 1024, DFF = 4096;
constexpr int NTHREADS = 512;
constexpr int LDS_BYTES = 131072 + 16;
constexpr size_t MiB = 1u << 20;
constexpr size_t W_MLP1T = 0, W_MLP2T = 8 * MiB, W_INT = 16 * MiB, W_OUTT = 20 * MiB, W_S = 22 * MiB;
constexpr size_t W_RT = 16 * MiB, W_KT = 18 * MiB, W_VT = 20 * MiB, W_OT = 22 * MiB;
constexpr size_t W_LD = 24 * MiB;
constexpr size_t W_W2T = 25 * MiB;
constexpr size_t W_A2T = 25 * MiB + 256 * 1024;
constexpr size_t W_V2T = 25 * MiB + 512 * 1024;
constexpr size_t W_G2T = 25 * MiB + 640 * 1024;
constexpr size_t WS_MOD = 32 * MiB;
constexpr size_t WS_VST = 53 * MiB;
constexpr size_t WS_BON = 34 * MiB;
constexpr size_t WS_TW = 36 * MiB, WS_A1O = 41 * MiB, WS_SG = 46 * MiB, WS_V1O = 51 * MiB;
constexpr size_t WS_BAR = 55 * MiB + 768 * 1024;
constexpr size_t WS_RDY = WS_BAR + 16 * 1024;
constexpr size_t WS_BIG = 56 * MiB, BIGSZ = 40 * MiB;
#define BIG(i) (WS_BIG + (size_t)(i) * BIGSZ)

enum { I_XP = 0, I_XS, I_STATE, I_C, I_CCTX, I_N1G, I_N2G, I_ADAW, I_ADAB, I_SWIN, I_SLNG, I_SLNB, I_SWS, I_SBS, I_SWOUT,
       I_MU, I_WR, I_WK, I_WV, I_WO, I_W0, I_W1, I_W2, I_A0, I_A1, I_A2, I_V0, I_V1, I_V2, I_G1, I_G2, I_KK, I_KA, I_RK, I_LNG, I_LNB,
       I_M1, I_M2, I_FG, N_IN };

struct Params { const float* in[N_IN]; float* out; unsigned char* ws; int ph_lo, ph_hi; };
typedef const __attribute__((address_space(4))) Params* KP;
__device__ __forceinline__ KP kparams() { KP k = (KP)__builtin_amdgcn_kernarg_segment_ptr(); asm volatile("" : "+s"(k)); return k; }

__device__ __forceinline__ int TIDX() { int t = threadIdx.x; asm volatile("" : "+v"(t)); return t; }
__device__ __forceinline__ int BIDX() { int t = blockIdx.x; asm volatile("" : "+s"(t)); return t; }
__device__ __forceinline__ int GDIM() { int t = gridDim.x; asm volatile("" : "+s"(t)); return t; }
__device__ __forceinline__ unsigned cvt_pk_bf16(float lo, float hi) { unsigned r; asm volatile("v_cvt_pk_bf16_f32 %0, %1, %2" : "=v"(r) : "v"(lo), "v"(hi)); return r; }
__device__ __forceinline__ bf16_t f2bf(float f) { unsigned u = __float_as_uint(f); u += 0x7FFFu + ((u >> 16) & 1u); return (bf16_t)(u >> 16); }
__device__ __forceinline__ float bf2f(unsigned b) { return __uint_as_float(b << 16); }
__device__ __forceinline__ float bflo(unsigned w) { return __uint_as_float(w << 16); }
__device__ __forceinline__ float bfhi(unsigned w) { return __uint_as_float(w & 0xFFFF0000u); }
__device__ __forceinline__ float rcpf_(float x) { return __builtin_amdgcn_rcpf(x); }
__device__ __forceinline__ float sigmoidf_(float x) { return rcpf_(1.0f + __expf(-x)); }
__device__ __forceinline__ float tanhf_(float x) { float e = __expf(-2.0f * fabsf(x)); float t = (1.0f - e) * rcpf_(1.0f + e); return x < 0.f ? -t : t; }
__device__ __forceinline__ float gelu_tanh(float x) { float u = 1.5957691216f * (x + 0.044715f * x * x * x); return x * rcpf_(1.0f + __expf(-u)); }
__device__ __forceinline__ float wave_sum(float v) {
#pragma unroll
    for (int o = 32; o >= 1; o >>= 1) v += __shfl_xor(v, o);
    return v;
}
#define LDS_BARRIER() do { asm volatile("s_waitcnt lgkmcnt(0)" ::: "memory"); __builtin_amdgcn_s_barrier(); asm volatile("" ::: "memory"); } while (0)
template <int CTRL> __device__ __forceinline__ float dpp_f(float x) { return __int_as_float(__builtin_amdgcn_update_dpp(0, __float_as_int(x), CTRL, 0xF, 0xF, true)); }
__device__ __forceinline__ float red8(float x) { x += dpp_f<0xB1>(x); x += dpp_f<0x4E>(x); x += dpp_f<0x141>(x); return x; }
__device__ __forceinline__ float red16(float x) { x = red8(x); x += dpp_f<0x140>(x); return x; }
__device__ __forceinline__ int cond_row(int t) { return t < TC ? 0 : 1 + ((t - TC) >> 11); }
__device__ __forceinline__ const float* xrow_ptr(KP p, bool from_input, int row) {
    if (from_input) return row < TC ? p->in[I_XP] + (size_t)row * D : p->in[I_XS] + (size_t)(row - TC) * D;
    return p->out + (size_t)row * D;
}

namespace pg8 {
constexpr int BM = 256, BK = 64, HALF = 128, HTB = HALF * BK * 2, STAGE_BYTES = 8 * HTB, NXCD = 8, WGM = 8;
__device__ __forceinline__ int lds_byte(int r, int c) { const int st = (r >> 4) * 2 + (c >> 5), rr = r & 15, cc = c & 31, ob = rr * 64 + cc * 2; return st * 1024 + (ob ^ (((ob >> 9) & 1) << 5)); }
__device__ __forceinline__ void stage_rc(int b, int& R, int& C) { const int st = b / 1024, sb = b % 1024, swz = sb ^ (((sb >> 9) & 1) << 5); R = (st >> 1) * 16 + swz / 64; C = (st & 1) * 32 + (swz % 64) / 2; }
__device__ __forceinline__ int perm32(int rho) { const int n = rho >> 4, i = rho & 15; return 8 * (i >> 2) + 4 * n + (i & 3); }
struct Unit { int pm, pn, gi; };
struct Sched {
    const char* A; size_t strideA; const char* Bt; size_t strideB; int tpg, K;
    int nM, nN, nwg, G, c, mode;
    unsigned* ready;
    __device__ void init(const void* A_, size_t sA, const void* Bt_, size_t sB, int tpg_, int K_, int M, int Nv, int G_, int c_, int mode_ = 0, unsigned* ready_ = nullptr) {
        A = (const char*)A_; strideA = sA; Bt = (const char*)Bt_; strideB = sB; tpg = tpg_; K = K_; nM = M / BM; nN = Nv / BM; nwg = nM * nN; G = G_; c = c_; mode = mode_; ready = ready_; }
    __device__ bool next(int i, Unit& u) const {
        int pm = 0, pn = 0, gi = 0; bool ok;
        if (mode == 1) {
            const int ui = i < 2 ? i * 256 + c : 512 + (i - 2) * 192 + (c - 64);
            ok = (i < 2) || (c >= 64 && i < 6);
            pm = ui >> 4; pn = ui & 15;
        } else if (mode == 2) {
            const int d = c < 64 ? c + 64 * i : 128 + (c - 64);
            ok = c < 64 ? (i < 2) : (i < 1);
            pm = d >> 2; pn = d & 3;
        } else {
            const long L = (long)i * G + c; ok = L < nwg;
            int wgid = ok ? (int)L : 0; { const int q = nwg / NXCD, r = nwg % NXCD, xcd = wgid % NXCD, off = wgid / NXCD; wgid = (xcd < r ? xcd * (q + 1) : r * (q + 1) + (xcd - r) * q) + off; }
            const int nig = WGM * nN, gid = wgid / nig, fm = gid * WGM, gsz = (nM - fm) < WGM ? (nM - fm) : WGM;
            pm = fm + ((wgid % nig) % gsz); const int pv = (wgid % nig) / gsz; gi = pv / tpg; pn = pv - gi * tpg;
        }
        u.pm = pm; u.pn = pn; u.gi = gi;
        return ok;
    }
    __device__ __forceinline__ void a_ready(const Unit& u) const {
        if (mode != 2) return;
        if (threadIdx.x < 64) {
            unsigned spins = 0;
            while ((unsigned)__builtin_amdgcn_readfirstlane(__hip_atomic_load(ready + 64 * u.pm, __ATOMIC_RELAXED, __HIP_MEMORY_SCOPE_AGENT)) < 128u) {
                __builtin_amdgcn_s_sleep(2); if (++spins > (1u << 24)) break; }
            __builtin_amdgcn_fence(__ATOMIC_ACQUIRE, "agent");
            asm volatile("s_waitcnt vmcnt(0)" ::: "memory");
        }
        asm volatile("" ::: "memory"); __builtin_amdgcn_s_barrier(); asm volatile("" ::: "memory");
    }
    __device__ __forceinline__ void done(const Unit& u) const {
        if (mode != 1) return;
        asm volatile("s_waitcnt vmcnt(0)" ::: "memory");
        if ((threadIdx.x & 63) == 0) __hip_atomic_fetch_add(ready + 64 * u.pm, 1u, __ATOMIC_RELAXED, __HIP_MEMORY_SCOPE_AGENT);
    }
};

template <class Epi>
__device__ __forceinline__ void gemm_phase(LAS unsigned char* lds, const Sched& S, const Epi& E) {
    const int tid = TIDX(), wid = __builtin_amdgcn_readfirstlane(tid >> 6), lane = tid & 63, wr = wid >> 2, wc = wid & 3, fr = lane & 15, fq = lane >> 4;
    const int K = S.K, nt = K / BK;
    unsigned voffA[2], voffB[2];
#pragma unroll
    for (int i = 0; i < 2; ++i) { int R, C; stage_rc(tid * 16 + i * 8192, R, C); const int Rb = Epi::PERM ? ((R & ~31) + perm32(R & 31)) : R;
        voffA[i] = (unsigned)(R * K + C) * 2u; voffB[i] = (unsigned)(Rb * K + C) * 2u; }
    const size_t kstep = (size_t)(BK * 2);
    const size_t hstep = (size_t)HALF * K * 2;
    const size_t tstep = 2 * hstep;
    const unsigned ldsw = (unsigned)wid * 1024u;
    const int aoff = lds_byte(wr * 64 + fr, fq * 8), boff = lds_byte(wc * 32 + fr, fq * 8);
#define PG8_SA(b, h) (((b) * 2 + (h)) * HTB)
#define PG8_SB(b, h) ((4 + (b) * 2 + (h)) * HTB)
#define PG8_STAGE(bufoff, gbase, voff) do { _Pragma("unroll") for (int _i = 0; _i < 2; ++_i) \
        __builtin_amdgcn_global_load_lds((const unsigned*)((const char*)(gbase) + (voff)[_i]), (LAS unsigned*)(lds + (bufoff) + ldsw + _i * 8192), 16, 0, 0); } while (0)
#define PG8_LDA(dst, b, h) do { _Pragma("unroll") for (int m = 0; m < 4; ++m) _Pragma("unroll") for (int k = 0; k < 2; ++k) dst[m][k] = *(const LAS bf16x8*)(lds + PG8_SA(b, h) + aoff + m * 2048 + k * 1024); } while (0)
#define PG8_LDB(dst, b, h) do { _Pragma("unroll") for (int n = 0; n < 2; ++n) _Pragma("unroll") for (int k = 0; k < 2; ++k) dst[n][k] = *(const LAS bf16x8*)(lds + PG8_SB(b, h) + boff + n * 2048 + k * 1024); } while (0)
#define PG8_MMA(ai, bj, At, Bt) do { __builtin_amdgcn_s_setprio(1); _Pragma("unroll") for (int m = 0; m < 4; ++m) _Pragma("unroll") for (int n = 0; n < 2; ++n) _Pragma("unroll") for (int k = 0; k < 2; ++k) \
        acc[ai][bj][m][n] = __builtin_amdgcn_mfma_f32_16x16x32_bf16(Bt[n][k], At[m][k], acc[ai][bj][m][n], 0, 0, 0); __builtin_amdgcn_s_setprio(0); } while (0)
#define PG8_WAIT_V(n) asm volatile("s_waitcnt vmcnt(" #n ")" ::: "memory")
#define PG8_WAIT_L(n) asm volatile("s_waitcnt lgkmcnt(" #n ")" ::: "memory")
#define PG8_BAR __builtin_amdgcn_s_barrier()
#define PG8_SCHED __builtin_amdgcn_sched_barrier(0)
    Unit cur, nxt; int ui = 0;
    if (!S.next(0, cur)) return;
    f32x4 acc[2][2][4][2];
#pragma unroll
    for (int a = 0; a < 2; ++a)
#pragma unroll
        for (int b = 0; b < 2; ++b)
#pragma unroll
            for (int m = 0; m < 4; ++m)
#pragma unroll
                for (int n = 0; n < 2; ++n) acc[a][b][m][n] = (f32x4){0.f, 0.f, 0.f, 0.f};
    bf16x8 At[4][2], B0[2][2], B1[2][2];
    const char* cA = S.A + (size_t)cur.gi * S.strideA + (size_t)cur.pm * tstep; const char* cB = S.Bt + (size_t)cur.gi * S.strideB + (size_t)cur.pn * tstep;
    S.a_ready(cur);
    PG8_STAGE(PG8_SB(0, 0), cB, voffB); PG8_STAGE(PG8_SA(0, 0), cA, voffA); PG8_STAGE(PG8_SB(0, 1), cB + hstep, voffB); PG8_STAGE(PG8_SA(0, 1), cA + hstep, voffA);
    if (wr == 1) PG8_BAR;
    PG8_WAIT_V(4); PG8_BAR;
    PG8_STAGE(PG8_SB(1, 0), cB + kstep, voffB); PG8_STAGE(PG8_SA(1, 0), cA + kstep, voffA); PG8_STAGE(PG8_SB(1, 1), cB + hstep + kstep, voffB);
    PG8_WAIT_V(6); PG8_BAR;
    for (;;) {
        const bool has_next = S.next(ui + 1, nxt);
        const char* nA = has_next ? S.A + (size_t)nxt.gi * S.strideA + (size_t)nxt.pm * tstep : cA; const char* nB = has_next ? S.Bt + (size_t)nxt.gi * S.strideB + (size_t)nxt.pn * tstep : cB;
        for (int t = 0; t < nt; t += 2) {
            const bool last = (t == nt - 2);
            const char* a1 = cA + (size_t)(t + 1) * kstep;
            const char* a2 = last ? nA : cA + (size_t)(t + 2) * kstep; const char* b2 = last ? nB : cB + (size_t)(t + 2) * kstep;
            const char* a3 = a2 + kstep; const char* b3 = b2 + kstep;
            if (last && has_next) S.a_ready(nxt);
            PG8_LDB(B0, 0, 0); PG8_SCHED; PG8_LDA(At, 0, 0); PG8_STAGE(PG8_SA(1, 1), a1 + hstep, voffA);
            PG8_WAIT_L(8); PG8_BAR; PG8_WAIT_L(0); PG8_MMA(0, 0, At, B0); PG8_BAR; PG8_SCHED;
            PG8_LDB(B1, 0, 1); PG8_STAGE(PG8_SB(0, 0), b2, voffB);
            PG8_BAR; PG8_WAIT_L(0); PG8_MMA(0, 1, At, B1); PG8_BAR;
            PG8_LDA(At, 0, 1); PG8_STAGE(PG8_SA(0, 0), a2, voffA);
            PG8_BAR; PG8_WAIT_L(0); PG8_MMA(1, 0, At, B0); PG8_BAR; PG8_SCHED;
            PG8_STAGE(PG8_SB(0, 1), b2 + hstep, voffB);
            PG8_WAIT_V(6); PG8_BAR; PG8_MMA(1, 1, At, B1); PG8_BAR;
            PG8_LDB(B0, 1, 0); PG8_SCHED; PG8_LDA(At, 1, 0); PG8_STAGE(PG8_SA(0, 1), a2 + hstep, voffA);
            PG8_WAIT_L(8); PG8_BAR; PG8_WAIT_L(0); PG8_MMA(0, 0, At, B0); PG8_BAR; PG8_SCHED;
            PG8_LDB(B1, 1, 1); PG8_STAGE(PG8_SB(1, 0), b3, voffB);
            PG8_BAR; PG8_WAIT_L(0); PG8_MMA(0, 1, At, B1); PG8_BAR;
            PG8_LDA(At, 1, 1); PG8_STAGE(PG8_SA(1, 0), a3, voffA);
            PG8_BAR; PG8_WAIT_L(0); PG8_MMA(1, 0, At, B0); PG8_BAR; PG8_SCHED;
            PG8_STAGE(PG8_SB(1, 1), b3 + hstep, voffB);
            PG8_WAIT_V(6); PG8_BAR; PG8_MMA(1, 1, At, B1); PG8_BAR;
        }
        E(acc, cur, wr, wc, fr, fq); S.done(cur);
        if (!has_next) break;
#pragma unroll
        for (int a = 0; a < 2; ++a)
#pragma unroll
            for (int b = 0; b < 2; ++b)
#pragma unroll
                for (int m = 0; m < 4; ++m)
#pragma unroll
                    for (int n = 0; n < 2; ++n) acc[a][b][m][n] = (f32x4){0.f, 0.f, 0.f, 0.f};
        cur = nxt; cA = nA; cB = nB; ++ui;
    }
    PG8_WAIT_V(0);
    if (wr == 0) PG8_BAR;
    PG8_BAR;
#undef PG8_SA
#undef PG8_SB
#undef PG8_STAGE
#undef PG8_LDA
#undef PG8_LDB
#undef PG8_MMA
#undef PG8_WAIT_V
#undef PG8_WAIT_L
#undef PG8_BAR
#undef PG8_SCHED
}
}

typedef f32x4 Acc[2][2][4][2];

struct EpiRes {
    static constexpr bool PERM = true;
    const float* src_lo; const float* src_hi; float* dst; const float* modl; int goff; int dry;
    __device__ __forceinline__ void operator()(const Acc& acc, const pg8::Unit& u, int wr, int wc, int fr, int fq) const {
        const int row0 = u.pm * 256 + wr * 64 + fr, col0 = u.pn * 256 + wc * 32 + 8 * fq;
        const int crow = u.pm < 16 ? 0 : 1 + ((u.pm - 16) >> 3);
        const float* gp = modl + crow * 6144 + goff + col0;
        f32x4 gv[2][2];
#pragma unroll
        for (int bj = 0; bj < 2; ++bj)
#pragma unroll
            for (int n = 0; n < 2; ++n) gv[bj][n] = *(const f32x4*)(gp + bj * 128 + n * 4);
        const float* sb = (u.pm < 16 ? src_lo : src_hi);
#pragma unroll
        for (int ai = 0; ai < 2; ++ai)
#pragma unroll
            for (int m = 0; m < 4; ++m) {
                const size_t ro = (size_t)(row0 + ai * 128 + m * 16) * D + col0;
                f32x4 xv[2][2];
#pragma unroll
                for (int bj = 0; bj < 2; ++bj)
#pragma unroll
                    for (int n = 0; n < 2; ++n) xv[bj][n] = *(const f32x4*)(sb + ro + bj * 128 + n * 4);
#pragma unroll
                for (int bj = 0; bj < 2; ++bj)
#pragma unroll
                    for (int n = 0; n < 2; ++n) if (!dry) *(f32x4*)(dst + ro + bj * 128 + n * 4) = xv[bj][n] + gv[bj][n] * acc[ai][bj][m][n];
            }
    }
};
template <int ACT> struct EpiBf16 {
    static constexpr bool PERM = true;
    bf16_t* o0; bf16_t* o1; bf16_t* o2; int ldc; int wt;
    __device__ __forceinline__ void operator()(const Acc& acc, const pg8::Unit& u, int wr, int wc, int fr, int fq) const {
        const int row0 = u.pm * 256 + wr * 64 + fr, col0 = u.pn * 256 + wc * 32 + 8 * fq;
        bf16_t* base = u.gi == 0 ? o0 : (u.gi == 1 ? o1 : o2);
#pragma unroll
        for (int ai = 0; ai < 2; ++ai)
#pragma unroll
            for (int m = 0; m < 4; ++m) {
                bf16_t* rowp = base + (size_t)(row0 + ai * 128 + m * 16) * ldc + col0;
#pragma unroll
                for (int bj = 0; bj < 2; ++bj) {
                    f32x4 v0 = acc[ai][bj][m][0], v1 = acc[ai][bj][m][1];
                    if (ACT == 1) {
#pragma unroll
                        for (int j = 0; j < 4; ++j) { float a = fmaxf(v0[j], 0.f), b = fmaxf(v1[j], 0.f); v0[j] = a * a; v1[j] = b * b; }
                    }
                    u32x4 w; w.x = cvt_pk_bf16(v0[0], v0[1]); w.y = cvt_pk_bf16(v0[2], v0[3]); w.z = cvt_pk_bf16(v1[0], v1[1]); w.w = cvt_pk_bf16(v1[2], v1[3]);
                    if (wt) asm volatile("global_store_dwordx4 %0, %1, off sc0 sc1\n\ts_nop 1" :: "v"(rowp + bj * 128), "v"(w) : "memory");
                    else *(u32x4*)(rowp + bj * 128) = w;
                }
            }
    }
};
struct EpiGeluUV {
    static constexpr bool PERM = true;
    bf16_t* U; bf16_t* V; float* vst;
    __device__ __forceinline__ void operator()(const Acc& acc, const pg8::Unit& u, int wr, int wc, int fr, int fq) const {
        const int row0 = u.pm * 256 + wr * 64 + fr;
        const bool isv = u.pn >= 4;
        const int col0 = (u.pn & 3) * 256 + wc * 32 + 8 * fq;
        bf16_t* base = isv ? V : U;
#pragma unroll
        for (int ai = 0; ai < 2; ++ai)
#pragma unroll
            for (int m = 0; m < 4; ++m) {
                const int row = row0 + ai * 128 + m * 16;
                bf16_t* rowp = base + (size_t)row * D + col0;
                float s1 = 0.f, s2 = 0.f;
#pragma unroll
                for (int bj = 0; bj < 2; ++bj) {
                    f32x4 v0 = acc[ai][bj][m][0], v1 = acc[ai][bj][m][1];
#pragma unroll
                    for (int j = 0; j < 4; ++j) { v0[j] = gelu_tanh(v0[j]); v1[j] = gelu_tanh(v1[j]); s1 += v0[j] + v1[j]; s2 += v0[j] * v0[j] + v1[j] * v1[j]; }
                    u32x4 w; w.x = cvt_pk_bf16(v0[0], v0[1]); w.y = cvt_pk_bf16(v0[2], v0[3]); w.z = cvt_pk_bf16(v1[0], v1[1]); w.w = cvt_pk_bf16(v1[2], v1[3]);
                    *(u32x4*)(rowp + bj * 128) = w;
                }
                if (isv) {
                    s1 += __shfl_xor(s1, 16); s1 += __shfl_xor(s1, 32);
                    s2 += __shfl_xor(s2, 16); s2 += __shfl_xor(s2, 32);
                    if (fq == 0) *(f32x2*)(vst + ((size_t)row * 16 + (u.pn - 4) * 4 + wc) * 2) = (f32x2){s1, s2};
                }
            }
    }
};

__device__ void wconv_tiled(const float* __restrict__ src, int K, int N, bf16_t* dst, int ldd, LAS float* tile, int bid, int G) {
    const int tid = TIDX(); const int tn = N / 64, ntiles = (K / 64) * tn;
    for (int t = bid; t < ntiles; t += G) {
        const int k0 = (t / tn) * 64, n0 = (t % tn) * 64;
#pragma unroll
        for (int i = 0; i < 8; ++i) { const int idx = tid + 512 * i, kk = idx >> 6, nn = idx & 63; tile[kk * 65 + nn] = __builtin_nontemporal_load(src + (size_t)(k0 + kk) * N + n0 + nn); }
        __syncthreads();
        { const int n = tid >> 3, kc = tid & 7; float v[8];
#pragma unroll
          for (int j = 0; j < 8; ++j) v[j] = tile[(kc * 8 + j) * 65 + n];
          u32x4 w; w.x = cvt_pk_bf16(v[0], v[1]); w.y = cvt_pk_bf16(v[2], v[3]); w.z = cvt_pk_bf16(v[4], v[5]); w.w = cvt_pk_bf16(v[6], v[7]);
          *(u32x4*)(dst + (size_t)(n0 + n) * ldd + k0 + kc * 8) = w; }
        __syncthreads();
    }
}
__device__ void wconv_tiled256(const float* __restrict__ src, int K, int N, bf16_t* dst, int ldd, LAS float* tile, int bid, int G) {
    const int tid = TIDX(); const int tn = N / 256, ntiles = (K / 64) * tn;
    const int lane = tid & 63, wave = tid >> 6;
    for (int t = bid; t < ntiles; t += G) {
        const int k0 = (t / tn) * 64, n0 = (t % tn) * 256;
        f32x4 v[8];
#pragma unroll
        for (int i = 0; i < 8; ++i) { const int idx = tid + 512 * i, kk = idx >> 6, n4 = idx & 63; v[i] = __builtin_nontemporal_load((const f32x4*)(src + (size_t)(k0 + kk) * N + n0 + n4 * 4)); }
#pragma unroll
        for (int i = 0; i < 8; ++i) { const int idx = tid + 512 * i, kk = idx >> 6, n4 = idx & 63; *(LAS f32x4*)(tile + kk * 260 + n4 * 4) = v[i]; }
        __syncthreads();
        { const int n = lane + 64 * (wave & 3);
#pragma unroll
          for (int q = 0; q < 4; ++q) { const int kc = 4 * (wave >> 2) + q; float x[8];
#pragma unroll
            for (int j = 0; j < 8; ++j) x[j] = tile[(kc * 8 + j) * 260 + n];
            u32x4 w; w.x = cvt_pk_bf16(x[0], x[1]); w.y = cvt_pk_bf16(x[2], x[3]); w.z = cvt_pk_bf16(x[4], x[5]); w.w = cvt_pk_bf16(x[6], x[7]);
            *(u32x4*)(dst + (size_t)(n0 + n) * ldd + k0 + kc * 8) = w; } }
        __syncthreads();
    }
}
__device__ void wconv_tiled_frag(const float* __restrict__ src, int N, bf16_t* dst, int nrow0, LAS float* tile, int bid, int G) {
    const int tid = TIDX(); const int tn = N / 64, ntiles = 16 * tn;
    for (int t = bid; t < ntiles; t += G) {
        const int k0 = (t / tn) * 64, n0 = (t % tn) * 64;
#pragma unroll
        for (int i = 0; i < 8; ++i) { const int idx = tid + 512 * i, kk = idx >> 6, nn = idx & 63; tile[kk * 65 + nn] = __builtin_nontemporal_load(src + (size_t)(k0 + kk) * N + n0 + nn); }
        __syncthreads();
        { const int n = tid >> 3, kc = tid & 7; float v[8];
#pragma unroll
          for (int j = 0; j < 8; ++j) v[j] = tile[(kc * 8 + j) * 65 + n];
          u32x4 w; w.x = cvt_pk_bf16(v[0], v[1]); w.y = cvt_pk_bf16(v[2], v[3]); w.z = cvt_pk_bf16(v[4], v[5]); w.w = cvt_pk_bf16(v[6], v[7]);
          const int na = nrow0 + n0 + n, k = k0 + kc * 8;
          *(u32x4*)(dst + ((size_t)(((na >> 4) * 32 + (k >> 5)) * 64 + ((k >> 3) & 3) * 16 + (na & 15))) * 8) = w; }
        __syncthreads();
    }
}
__device__ void wconv_direct(const float* __restrict__ src, int K, int N, bf16_t* dst) {
    const int gsz = GDIM() * NTHREADS;
    for (int e = BIDX() * NTHREADS + TIDX(); e < K * N; e += gsz) { const int n = e / K, k = e - n * K; dst[e] = f2bf(src[(size_t)k * N + n]); }
}
__device__ void wconv_mlp(KP p, int l, LAS float* tile) {
    const int G = GDIM(), b = BIDX();
    wconv_tiled256(p->in[I_M1] + (size_t)l * D * DFF, D, DFF, (bf16_t*)(p->ws + W_MLP1T), D, tile, b, G);
    wconv_tiled256(p->in[I_M2] + (size_t)l * D * DFF, DFF, D, (bf16_t*)(p->ws + W_MLP2T), DFF, tile, b, G);
}
__device__ void wconv_sgu(KP p, int l, LAS float* tile) {
    const int i = l >> 1, G = GDIM(), b = BIDX();
    wconv_tiled256(p->in[I_SWIN] + (size_t)i * D * 2048, D, 2048, (bf16_t*)(p->ws + W_INT), D, tile, b, G);
    wconv_tiled256(p->in[I_SWOUT] + (size_t)i * D * D, D, D, (bf16_t*)(p->ws + W_OUTT), D, tile, (b + 128) % G, G);
    { const float* s = p->in[I_SWS] + (size_t)i * 16 * 128 * 128; bf16_t* d = (bf16_t*)(p->ws + W_S);
      for (int e = BIDX() * NTHREADS + TIDX(); e < 16 * 128 * 128; e += G * NTHREADS) d[e] = f2bf(s[e]); }
    wconv_mlp(p, l, tile);
}
__device__ void wconv_rwkv_main(KP p, int l, LAS float* tile) {
    const int il = l >> 1, G = GDIM(), b = BIDX();
    wconv_tiled256(p->in[I_WR] + (size_t)il * D * D, D, D, (bf16_t*)(p->ws + W_RT), D, tile, b, G);
    wconv_tiled256(p->in[I_WK] + (size_t)il * D * D, D, D, (bf16_t*)(p->ws + W_KT), D, tile, (b + 64) % G, G);
    wconv_tiled256(p->in[I_WV] + (size_t)il * D * D, D, D, (bf16_t*)(p->ws + W_VT), D, tile, (b + 128) % G, G);
    wconv_tiled256(p->in[I_WO] + (size_t)il * D * D, D, D, (bf16_t*)(p->ws + W_OT), D, tile, (b + 192) % G, G);
    for (int d = 0; d < 2; ++d) {
        wconv_direct(p->in[I_W2] + (size_t)(il * 2 + d) * 64 * D, 64, D, (bf16_t*)(p->ws + W_W2T) + (size_t)d * D * 64);
        wconv_direct(p->in[I_A2] + (size_t)(il * 2 + d) * 64 * D, 64, D, (bf16_t*)(p->ws + W_A2T) + (size_t)d * D * 64);
    }
    if (il == 1) wconv_direct(p->in[I_V2], 32, D, (bf16_t*)(p->ws + W_V2T));
    wconv_direct(p->in[I_G2] + (size_t)il * 128 * D, 128, D, (bf16_t*)(p->ws + W_G2T));
    wconv_mlp(p, l, tile);
}
__device__ void wconv_rwkv_lora_down(KP p, int l, LAS float* tile) {
    const int il = l >> 1, G = GDIM(), b = BIDX();
    bf16_t* ld = (bf16_t*)(p->ws + W_LD);
    for (int d = 0; d < 2; ++d) {
        wconv_tiled_frag(p->in[I_W1] + (size_t)(il * 2 + d) * D * 64, 64, ld, d * 64, tile, (b + d * 16) % G, G);
        wconv_tiled_frag(p->in[I_A1] + (size_t)(il * 2 + d) * D * 64, 64, ld, 128 + d * 64, tile, (b + 32 + d * 16) % G, G);
    }
    wconv_tiled_frag(p->in[I_G1] + (size_t)il * D * 128, 128, ld, 256, tile, (b + 64) % G, G);
    if (il == 1) {
        const float* src = p->in[I_V1];
        for (int e = BIDX() * NTHREADS + TIDX(); e < D * 32; e += G * NTHREADS) { const int k = e >> 5, na = 384 + (e & 31);
            ld[((size_t)(((na >> 4) * 32 + (k >> 5)) * 64 + ((k >> 3) & 3) * 16 + (na & 15))) * 8 + (k & 7)] = f2bf(src[e]); }
    }
}

__device__ void ada_phase(KP p, LAS unsigned char* lds) {
    LAS float* sc = (LAS float*)lds;
    LAS float* red = sc + 9 * 1024;
    const int tid = TIDX(), G = GDIM();
    float* mod = (float*)(p->ws + WS_MOD);
    if ((int)BIDX() < 192) {
        for (int e = tid; e < 9 * 1024; e += NTHREADS) { const int r = e >> 10, k = e & 1023; const float x = r == 0 ? p->in[I_CCTX][k] : p->in[I_C][(r - 1) * 1024 + k]; sc[e] = x * rcpf_(1.0f + __expf(-x)); }
        __syncthreads();
    }
    for (int item = BIDX(); item < 192; item += G) {
        const int l = item / 48, c0 = (item % 48) * 128, col4 = tid & 31, kq = tid >> 5;
        const float* wp = p->in[I_ADAW] + ((size_t)l * 1024 + kq * 64) * 6144 + c0 + col4 * 4;
        f32x4 acc[9];
#pragma unroll
        for (int r = 0; r < 9; ++r) acc[r] = (f32x4){0.f, 0.f, 0.f, 0.f};
#pragma unroll 8
        for (int kk = 0; kk < 64; ++kk) {
            const f32x4 w = __builtin_nontemporal_load((const f32x4*)(wp + (size_t)kk * 6144));
#pragma unroll
            for (int r = 0; r < 9; ++r) acc[r] += sc[r * 1024 + kq * 64 + kk] * w;
        }
#pragma unroll
        for (int r = 0; r < 9; ++r) *(LAS f32x4*)(red + ((kq * 9 + r) * 128 + col4 * 4)) = acc[r];
        __syncthreads();
        for (int o = tid; o < 9 * 128; o += NTHREADS) {
            const int r = o >> 7, cc = o & 127; float s = p->in[I_ADAB][l * 6144 + c0 + cc];
#pragma unroll
            for (int q = 0; q < 16; ++q) s += red[(q * 9 + r) * 128 + cc];
            mod[(size_t)(l * 9 + r) * 6144 + c0 + cc] = s;
        }
        __syncthreads();
    }
}

__device__ void norm_phase(KP p, int l, int which, bool from_input, bf16_t* H) {
    const int lane = TIDX() & 63, gw = BIDX() * 8 + (TIDX() >> 6), nw = GDIM() * 8;
    const float* g = p->in[which ? I_N2G : I_N1G] + l * D;
    const float* mod = (const float*)(p->ws + WS_MOD);
    f32x4 ggr[4];
#pragma unroll
    for (int i = 0; i < 4; ++i) ggr[i] = *(const f32x4*)(g + i * 256 + lane * 4);
    for (int row = gw; row < T; row += 4 * nw) {
        f32x4 v[4][4]; int rws[4]; bool has[4];
#pragma unroll
        for (int q = 0; q < 4; ++q) {
            rws[q] = row + q * nw; has[q] = rws[q] < T;
            const float* xp = xrow_ptr(p, from_input, has[q] ? rws[q] : row);
#pragma unroll
            for (int i = 0; i < 4; ++i) v[q][i] = *(const f32x4*)(xp + i * 256 + lane * 4);
        }
#pragma unroll
        for (int q = 0; q < 4; ++q) {
            if (!has[q]) break;
            const int r_ = rws[q];
            const float* md = mod + (size_t)(l * 9 + cond_row(r_)) * 6144 + (which ? 3072 : 0);
            float ss = 0.f;
#pragma unroll
            for (int i = 0; i < 4; ++i) { const f32x4 x = v[q][i]; ss += x[0] * x[0] + x[1] * x[1] + x[2] * x[2] + x[3] * x[3]; }
            ss = wave_sum(ss);
            const float rstd = rsqrtf(ss * (1.0f / 1024.0f) + 1e-6f);
#pragma unroll
            for (int i = 0; i < 4; ++i) {
                const int c = i * 256 + lane * 4;
                const f32x4 gg = ggr[i], sh = *(const f32x4*)(md + c), sc = *(const f32x4*)(md + 1024 + c);
                const f32x4 o = v[q][i] * rstd * gg * (1.0f + sc) + sh;
                u32x2 w; w.x = cvt_pk_bf16(o[0], o[1]); w.y = cvt_pk_bf16(o[2], o[3]);
                *(u32x2*)(H + (size_t)r_ * D + c) = w;
            }
        }
    }
}
__device__ void final_norm_phase(KP p) {
    const int lane = TIDX() & 63, gw = BIDX() * 8 + (TIDX() >> 6), nw = GDIM() * 8;
    const float* g = p->in[I_FG];
    f32x4 gv[4];
#pragma unroll
    for (int i = 0; i < 4; ++i) gv[i] = *(const f32x4*)(g + i * 256 + lane * 4);
    for (int row = gw; row < T; row += 4 * nw) {
        f32x4 v[4][4]; bool has[4];
#pragma unroll
        for (int q = 0; q < 4; ++q) {
            has[q] = row + q * nw < T;
            const float* xp = p->out + (size_t)(has[q] ? row + q * nw : row) * D;
#pragma unroll
            for (int i = 0; i < 4; ++i) v[q][i] = __builtin_nontemporal_load((const f32x4*)(xp + i * 256 + lane * 4));
        }
#pragma unroll
        for (int q = 0; q < 4; ++q) {
            if (!has[q]) break;
            float* xp = p->out + (size_t)(row + q * nw) * D;
            float ss = 0.f;
#pragma unroll
            for (int i = 0; i < 4; ++i) { const f32x4 x = v[q][i]; ss += x[0] * x[0] + x[1] * x[1] + x[2] * x[2] + x[3] * x[3]; }
            ss = wave_sum(ss);
            const float rstd = rsqrtf(ss * (1.0f / 1024.0f) + 1e-6f);
#pragma unroll
            for (int i = 0; i < 4; ++i) __builtin_nontemporal_store(v[q][i] * rstd * gv[i], (f32x4*)(xp + i * 256 + lane * 4));
        }
    }
}

constexpr int HBS = 1028;
__device__ void rmix_phase(KP p, int l, LAS unsigned char* lds) {
    const int il = l >> 1;
    LAS float* hb = (LAS float*)lds;
    const int tid = TIDX(), lane = tid & 63, wave = tid >> 6, G = GDIM();
    const float* g = p->in[I_N1G] + l * D;
    const float* mu = p->in[I_MU] + (size_t)il * 6 * D;
    const float* mod = (const float*)(p->ws + WS_MOD);
    bf16_t* XR = (bf16_t*)(p->ws + BIG(1)); bf16_t* XK = (bf16_t*)(p->ws + BIG(2)); bf16_t* XV = (bf16_t*)(p->ws + BIG(3));
    const bf16_t* LD = (const bf16_t*)(p->ws + W_LD);
    LAS float* mul = (LAS float*)(lds + 76 * 1024);
    for (int e = tid; e < 6 * 256; e += NTHREADS) *(LAS f32x4*)(mul + 4 * e) = *(const f32x4*)(mu + 4 * e);
    __syncthreads();
#define RMIX_LOADROWS(tile_) do { const int t0_ = (tile_) * 16; \
        const int s0_ = t0_ < TC ? (t0_ & ~255) : TC + ((t0_ - TC) & ~2047), L_ = t0_ < TC ? 256 : 2048; \
        _Pragma("unroll") for (int ri = 0; ri < 3; ++ri) { \
            const int r = wave + 8 * ri, t = t0_ - 1 + r; \
            ok[ri] = (r < 18) && (t >= s0_) && (t < s0_ + L_); \
            if (ok[ri]) { const float* xp = p->out + (size_t)t * D; \
                _Pragma("unroll") for (int i = 0; i < 4; ++i) v[ri][i] = *(const f32x4*)(xp + i * 256 + lane * 4); } \
            else { _Pragma("unroll") for (int i = 0; i < 4; ++i) v[ri][i] = (f32x4){0.f, 0.f, 0.f, 0.f}; } } } while (0)
    f32x4 v[3][4]; bool ok[3];
    if (BIDX() < T / 16) RMIX_LOADROWS(BIDX());
    for (int tile = BIDX(); tile < T / 16; tile += G) {
        const int t0 = tile * 16;
        const float* md = mod + (size_t)(l * 9 + cond_row(t0)) * 6144;
        {
#pragma unroll
            for (int ri = 0; ri < 3; ++ri) {
                const int r = wave + 8 * ri;
                if (r < 18) {
                    float ss = 0.f;
#pragma unroll
                    for (int i = 0; i < 4; ++i) ss += v[ri][i][0] * v[ri][i][0] + v[ri][i][1] * v[ri][i][1] + v[ri][i][2] * v[ri][i][2] + v[ri][i][3] * v[ri][i][3];
                    ss = wave_sum(ss);
                    const float rstd = rsqrtf(ss * (1.0f / 1024.0f) + 1e-6f);
#pragma unroll
                    for (int i = 0; i < 4; ++i) {
                        const int c = i * 256 + lane * 4;
                        const f32x4 gg = *(const f32x4*)(g + c), sh = *(const f32x4*)(md + c), sc = *(const f32x4*)(md + 1024 + c);
                        *(LAS f32x4*)(hb + r * HBS + c) = ok[ri] ? (v[ri][i] * rstd * gg * (1.0f + sc) + sh) : (f32x4){0.f, 0.f, 0.f, 0.f};
                    }
                }
            }
        }
        __syncthreads();
        {
            const int row = tid >> 5, q = tid & 31;
#pragma unroll
            for (int pc = 0; pc < 4; ++pc) {
                const int c = pc * 256 + q * 8;
                f32x4 hp[2], hc[2], hn[2], xx[2];
#pragma unroll
                for (int e = 0; e < 2; ++e) { hp[e] = *(const LAS f32x4*)(hb + row * HBS + c + 4 * e); hc[e] = *(const LAS f32x4*)(hb + (row + 1) * HBS + c + 4 * e); hn[e] = *(const LAS f32x4*)(hb + (row + 2) * HBS + c + 4 * e);
                    xx[e] = 0.5f * (hp[e] + hn[e]) - hc[e]; }
                const size_t off = (size_t)(t0 + row) * D + c;
#pragma unroll
                for (int jj = 0; jj < 3; ++jj) {
                    const int j = jj == 0 ? 0 : (jj == 1 ? 2 : 3);
                    const f32x4 m0 = *(const LAS f32x4*)(mul + j * D + c), m1 = *(const LAS f32x4*)(mul + j * D + c + 4);
                    const f32x4 o0 = hc[0] + xx[0] * m0, o1 = hc[1] + xx[1] * m1;
                    u32x4 w; w.x = cvt_pk_bf16(o0[0], o0[1]); w.y = cvt_pk_bf16(o0[2], o0[3]); w.z = cvt_pk_bf16(o1[0], o1[1]); w.w = cvt_pk_bf16(o1[2], o1[3]);
                    bf16_t* dst = jj == 0 ? XR : (jj == 1 ? XK : XV);
                    *(u32x4*)(dst + off) = w;
                }
            }
        }
        if (tile + G < T / 16) RMIX_LOADROWS(tile + G);
        if (wave < 6 || (wave == 6 && il == 1)) {
            int jmu, nrow0, ntl, act, ldo, oc0; bf16_t* outp;
            if (wave < 2) { jmu = 1; nrow0 = wave * 64; ntl = 4; act = 1; outp = (bf16_t*)(p->ws + WS_TW); ldo = 128; oc0 = wave * 64; }
            else if (wave < 4) { jmu = 4; nrow0 = 128 + (wave - 2) * 64; ntl = 4; act = 0; outp = (bf16_t*)(p->ws + WS_A1O); ldo = 128; oc0 = (wave - 2) * 64; }
            else if (wave < 6) { jmu = 5; nrow0 = 256 + (wave - 4) * 64; ntl = 4; act = 2; outp = (bf16_t*)(p->ws + WS_SG); ldo = 128; oc0 = (wave - 4) * 64; }
            else { jmu = 3; nrow0 = 384; ntl = 2; act = 0; outp = (bf16_t*)(p->ws + WS_V1O); ldo = 32; oc0 = 0; }
            const int tok = lane & 15, kg = lane >> 4;
            f32x4 acc[4];
#pragma unroll
            for (int n = 0; n < 4; ++n) acc[n] = (f32x4){0.f, 0.f, 0.f, 0.f};
            const LAS float* mup = mul + jmu * D;
            for (int ks0 = 0; ks0 < 32; ks0 += 4) {
                bf16x8 af[4][4];
#pragma unroll
                for (int kk = 0; kk < 4; ++kk)
#pragma unroll
                    for (int n = 0; n < 4; ++n) if (n < ntl) af[kk][n] = *(const bf16x8*)(LD + ((size_t)(((nrow0 >> 4) + n) * 32 + ks0 + kk) * 64 + lane) * 8);
#pragma unroll
                for (int kk = 0; kk < 4; ++kk) {
                    const int k = (ks0 + kk) * 32 + kg * 8;
                    float xm[8];
#pragma unroll
                    for (int e = 0; e < 2; ++e) {
                        const f32x4 hp = *(const LAS f32x4*)(hb + tok * HBS + k + 4 * e), hc = *(const LAS f32x4*)(hb + (tok + 1) * HBS + k + 4 * e), hn = *(const LAS f32x4*)(hb + (tok + 2) * HBS + k + 4 * e);
                        const f32x4 m = *(const LAS f32x4*)(mup + k + 4 * e);
                        const f32x4 o = hc + (0.5f * (hp + hn) - hc) * m;
                        xm[4 * e] = o[0]; xm[4 * e + 1] = o[1]; xm[4 * e + 2] = o[2]; xm[4 * e + 3] = o[3];
                    }
                    u32x4 bw; bw.x = cvt_pk_bf16(xm[0], xm[1]); bw.y = cvt_pk_bf16(xm[2], xm[3]); bw.z = cvt_pk_bf16(xm[4], xm[5]); bw.w = cvt_pk_bf16(xm[6], xm[7]);
                    const bf16x8 bfrag = __builtin_bit_cast(bf16x8, bw);
#pragma unroll
                    for (int n = 0; n < 4; ++n) if (n < ntl) acc[n] = __builtin_amdgcn_mfma_f32_16x16x32_bf16(af[kk][n], bfrag, acc[n], 0, 0, 0);
                }
            }
#pragma unroll
            for (int n = 0; n < 4; ++n) if (n < ntl) {
                f32x4 v = acc[n];
#pragma unroll
                for (int j = 0; j < 4; ++j) v[j] = act == 1 ? tanhf_(v[j]) : (act == 2 ? sigmoidf_(v[j]) : v[j]);
                u32x2 w; w.x = cvt_pk_bf16(v[0], v[1]); w.y = cvt_pk_bf16(v[2], v[3]);
                *(u32x2*)(outp + (size_t)(t0 + tok) * ldo + oc0 + n * 16 + kg * 4) = w;
            }
        }
        __syncthreads();
    }
}

__device__ void sgu_mix_phase(KP p, int l, LAS unsigned char* lds) {
    const int i = l >> 1;
    LAS bf16_t* vt = (LAS bf16_t*)lds;
    const int tid = TIDX(), lane = tid & 63, wave = tid >> 6, G = GDIM();
    const float* lng = p->in[I_SLNG] + i * D; const float* lnb = p->in[I_SLNB] + i * D; const float* bs = p->in[I_SBS] + i * 16 * 128;
    const float* vst = (const float*)(p->ws + WS_VST);
    const bf16_t* U = (const bf16_t*)(p->ws + BIG(2)); const bf16_t* V = (const bf16_t*)(p->ws + BIG(3)); bf16_t* UV = (bf16_t*)(p->ws + BIG(4));
    const bf16_t* WS = (const bf16_t*)(p->ws + W_S);
    const int g = BIDX() & 15;
    f32x4 lgr[4], lbr[4];
    { const int c0 = 64 * g + (tid & 3) * 16;
#pragma unroll
      for (int e = 0; e < 4; ++e) { lgr[e] = *(const f32x4*)(lng + c0 + 4 * e); lbr[e] = *(const f32x4*)(lnb + c0 + 4 * e); } }
    bf16x8 wfr[4];
#pragma unroll
    for (int ks = 0; ks < 4; ++ks) wfr[ks] = *(const bf16x8*)(WS + ((size_t)g * 128 + wave * 16 + (lane & 15)) * 128 + ks * 32 + (lane >> 4) * 8);
    for (int ch = (BIDX() < (G & ~15)) ? (BIDX() >> 4) : T; ch < T / 128; ch += (G >> 4)) {
        {
            const int s = tid >> 2, q = tid & 3, tok = ch * 128 + s, c0 = 64 * g + q * 16;
            float a1, a2;
            { const f32x4 p0 = *(const f32x4*)(vst + (size_t)tok * 32 + 8 * q), p1 = *(const f32x4*)(vst + (size_t)tok * 32 + 8 * q + 4);
              a1 = (p0[0] + p0[2]) + (p1[0] + p1[2]); a2 = (p0[1] + p0[3]) + (p1[1] + p1[3]);
              a1 += dpp_f<0xB1>(a1); a1 += dpp_f<0x4E>(a1); a2 += dpp_f<0xB1>(a2); a2 += dpp_f<0x4E>(a2); }
            const float m1 = a1 * (1.0f / 1024.0f), m2 = a2 * (1.0f / 1024.0f);
            const float rstd = rsqrtf(fmaxf(m2 - m1 * m1, 0.f) + 1e-6f);
            const u32x4 a = *(const u32x4*)(V + (size_t)tok * D + c0), b = *(const u32x4*)(V + (size_t)tok * D + c0 + 8);
            const unsigned wv[8] = {a.x, a.y, a.z, a.w, b.x, b.y, b.z, b.w};
#pragma unroll
            for (int e = 0; e < 8; ++e) {
                const float x0 = (bflo(wv[e]) - m1) * rstd * lgr[e >> 1][(2 * e) & 3] + lbr[e >> 1][(2 * e) & 3], x1 = (bfhi(wv[e]) - m1) * rstd * lgr[e >> 1][(2 * e + 1) & 3] + lbr[e >> 1][(2 * e + 1) & 3];
                vt[(q * 16 + 2 * e) * 136 + s] = f2bf(x0); vt[(q * 16 + 2 * e + 1) * 136 + s] = f2bf(x1);
            }
        }
        __syncthreads();
        {
            const int tl = lane & 15, kg = lane >> 4, tt = wave * 16 + tl;
            f32x4 acc[4];
#pragma unroll
            for (int n = 0; n < 4; ++n) acc[n] = (f32x4){0.f, 0.f, 0.f, 0.f};
#pragma unroll
            for (int ks = 0; ks < 4; ++ks) {
                const bf16x8 bfrag = wfr[ks];
#pragma unroll
                for (int n = 0; n < 4; ++n) {
                    const bf16x8 afrag = *(const LAS bf16x8*)(vt + (n * 16 + tl) * 136 + ks * 32 + kg * 8);
                    acc[n] = __builtin_amdgcn_mfma_f32_16x16x32_bf16(afrag, bfrag, acc[n], 0, 0, 0);
                }
            }
            const int tok = ch * 128 + tt; const float bb = bs[g * 128 + tt];
#pragma unroll
            for (int n = 0; n < 4; ++n) {
                const int c = 64 * g + n * 16 + kg * 4;
                const u32x2 uu = *(const u32x2*)(U + (size_t)tok * D + c);
                const float o0 = (acc[n][0] + bb) * bflo(uu.x), o1 = (acc[n][1] + bb) * bfhi(uu.x), o2 = (acc[n][2] + bb) * bflo(uu.y), o3 = (acc[n][3] + bb) * bfhi(uu.y);
                u32x2 w; w.x = cvt_pk_bf16(o0, o1); w.y = cvt_pk_bf16(o2, o3);
                *(u32x2*)(UV + (size_t)tok * D + c) = w;
            }
        }
        __syncthreads();
    }
}

constexpr int STS = 388;
constexpr int SCAN_HALF_BYTES = (2 * 16 * STS + 2 * 16 * 64) * 4;
#define SVX_GLOAD_A(P, tok0_, L_, d_, h_, chunk) do { const int tt_ = (chunk) * 16 + ts, t_ = (tok0_) + ((d_) ? (L_) - 1 - tt_ : tt_); \
    const unsigned hb_ = (unsigned)(t_ * D + (h_) * 64) * 2u; \
    P##k0 = *(const u32x2*)(wsb + (unsigned)(BIG(5) + hb_ + 8 * kgrp)); P##k1 = *(const u32x2*)(wsb + (unsigned)(BIG(5) + hb_ + 32 + 8 * kgrp)); \
    P##k2 = *(const u32x2*)(wsb + (unsigned)(BIG(5) + hb_ + 64 + 8 * kgrp)); P##k3 = *(const u32x2*)(wsb + (unsigned)(BIG(5) + hb_ + 96 + 8 * kgrp)); \
    P##r = *(const u32x2*)(wsb + (unsigned)(BIG(4) + hb_ + 2 * cown)); P##v = *(const u32x2*)(wsb + (unsigned)(vboff + hb_ + 2 * cown)); \
    if (il == 1) P##vf = *(const u32x2*)(wsb + (unsigned)(BIG(0) + hb_ + 2 * cown)); } while (0)
#define SVX_GLOAD_B(P, tok0_, L_, d_, h_, chunk) do { const int tt_ = (chunk) * 16 + ts, t_ = (tok0_) + ((d_) ? (L_) - 1 - tt_ : tt_); \
    const unsigned lo_ = (unsigned)(t_ * 128 + (d_) * 64 + kgrp * 8) * 2u; \
    P##tw0 = *(const bf16x8*)(wsb + (unsigned)(WS_TW + lo_)); P##tw1 = *(const bf16x8*)(wsb + (unsigned)(WS_TW + lo_ + 64)); \
    P##a0 = *(const bf16x8*)(wsb + (unsigned)(WS_A1O + lo_)); P##a1 = *(const bf16x8*)(wsb + (unsigned)(WS_A1O + lo_ + 64)); \
    if (il == 1) P##v1 = *(const bf16x8*)(wsb + (unsigned)(WS_V1O + (unsigned)(t_ * 32 + kgrp * 8) * 2u)); } while (0)
#define SVX_GLOAD(P, tok0_, L_, d_, h_, chunk) do { SVX_GLOAD_A(P, tok0_, L_, d_, h_, chunk); SVX_GLOAD_B(P, tok0_, L_, d_, h_, chunk); } while (0)
#define SVX_CONSTS(d_, h_) \
    const int ch_ = (h_) * 64 + cown; \
    const unsigned wrow_ = (unsigned)((d_) * D * 64 + ((h_) * 64 + 16 * hw + ts) * 64 + kgrp * 8) * 2u; \
    const bf16x8 wz0 = *(const bf16x8*)(wsb + (unsigned)(W_W2T + wrow_)), wz1 = *(const bf16x8*)(wsb + (unsigned)(W_W2T + wrow_ + 64)); \
    const bf16x8 wa0 = *(const bf16x8*)(wsb + (unsigned)(W_A2T + wrow_)), wa1 = *(const bf16x8*)(wsb + (unsigned)(W_A2T + wrow_ + 64)); \
    bf16x8 wv = wz0; f32x4 v0c = (f32x4){0.f, 0.f, 0.f, 0.f}; \
    if (il == 1) { wv = *(const bf16x8*)(wsb + (unsigned)(W_V2T + (unsigned)(((h_) * 64 + 16 * hw + ts) * 32 + kgrp * 8) * 2u)); v0c = *(const f32x4*)(p->in[I_V0] + ch_); } \
    const f32x4 w0c = *(const f32x4*)(p->in[I_W0] + (size_t)(il * 2 + (d_)) * D + ch_), a0c = *(const f32x4*)(p->in[I_A0] + (size_t)(il * 2 + (d_)) * D + ch_); \
    const f32x4 kac = *(const f32x4*)(p->in[I_KA] + il * D + ch_), rkc = *(const f32x4*)(p->in[I_RK] + il * D + ch_); \
    const float* kkp_ = p->in[I_KK] + il * D + (h_) * 64 + 4 * kgrp;
#define SVX_STAGE(P, tok0_, L_, d_, h_, chunk, stg_, bufi) do { const int tt_ = (chunk) * 16 + ts, t_ = (tok0_) + ((d_) ? (L_) - 1 - tt_ : tt_); \
    f32x4 accz = (f32x4){0.f, 0.f, 0.f, 0.f}, acca = accz; \
    accz = __builtin_amdgcn_mfma_f32_16x16x32_bf16(wz0, P##tw0, accz, 0, 0, 0); accz = __builtin_amdgcn_mfma_f32_16x16x32_bf16(wz1, P##tw1, accz, 0, 0, 0); \
    acca = __builtin_amdgcn_mfma_f32_16x16x32_bf16(wa0, P##a0, acca, 0, 0, 0); acca = __builtin_amdgcn_mfma_f32_16x16x32_bf16(wa1, P##a1, acca, 0, 0, 0); \
    f32x4 kf, kx, sq; \
    { const f32x4 kq_ = (f32x4){bflo(P##k0.x), bfhi(P##k0.x), bflo(P##k0.y), bfhi(P##k0.y)}; const f32x4 xq_ = kq_ * *(const f32x4*)(kkp_); sq = xq_ * xq_; kf = kq_; kx = xq_; } \
    { const f32x4 kq_ = (f32x4){bflo(P##k1.x), bfhi(P##k1.x), bflo(P##k1.y), bfhi(P##k1.y)}; const f32x4 xq_ = kq_ * *(const f32x4*)(kkp_ + 16); sq += xq_ * xq_; if (hw == 1) { kf = kq_; kx = xq_; } } \
    { const f32x4 kq_ = (f32x4){bflo(P##k2.x), bfhi(P##k2.x), bflo(P##k2.y), bfhi(P##k2.y)}; const f32x4 xq_ = kq_ * *(const f32x4*)(kkp_ + 32); sq += xq_ * xq_; if (hw == 2) { kf = kq_; kx = xq_; } } \
    { const f32x4 kq_ = (f32x4){bflo(P##k3.x), bfhi(P##k3.x), bflo(P##k3.y), bfhi(P##k3.y)}; const f32x4 xq_ = kq_ * *(const f32x4*)(kkp_ + 48); sq += xq_ * xq_; if (hw == 3) { kf = kq_; kx = xq_; } } \
    float ss = (sq[0] + sq[1]) + (sq[2] + sq[3]); ss += __shfl_xor(ss, 16); ss += __shfl_xor(ss, 32); \
    const float inv = __builtin_amdgcn_rsqf(fmaxf(ss, 1e-24f)); \
    const f32x4 zz = accz + w0c, ap = acca + a0c; \
    f32x4 nkk, wv_, bv_, kd_, rv_, vv_; \
    rv_ = (f32x4){bflo(P##r.x), bfhi(P##r.x), bflo(P##r.y), bfhi(P##r.y)}; vv_ = (f32x4){bflo(P##v.x), bfhi(P##v.x), bflo(P##v.y), bfhi(P##v.y)}; \
    if (il == 1) { f32x4 accv = (f32x4){0.f, 0.f, 0.f, 0.f}; accv = __builtin_amdgcn_mfma_f32_16x16x32_bf16(wv, P##v1, accv, 0, 0, 0); \
        const f32x4 vf_ = (f32x4){bflo(P##vf.x), bfhi(P##vf.x), bflo(P##vf.y), bfhi(P##vf.y)}; \
        _Pragma("unroll") for (int j = 0; j < 4; ++j) vv_[j] = vv_[j] + (vf_[j] - vv_[j]) * sigmoidf_(v0c[j] + accv[j]); \
        if ((d_) == 0) { u32x2 w_; w_.x = cvt_pk_bf16(vv_[0], vv_[1]); w_.y = cvt_pk_bf16(vv_[2], vv_[3]); *(u32x2*)(wsb + (unsigned)(BIG(7) + (unsigned)(t_ * D + (h_) * 64 + cown) * 2u)) = w_; } } \
    float bsum = 0.f; \
    _Pragma("unroll") for (int j = 0; j < 4; ++j) { \
        const float kk = kx[j] * inv, a = sigmoidf_(ap[j]); \
        const float lw = -0.6065306597f * sigmoidf_(zz[j]);            \
        float li = lw; li += dpp_f<0x111>(li); li += dpp_f<0x112>(li); li += dpp_f<0x114>(li); li += dpp_f<0x118>(li);     \
        const float pin = __expf(li), pex = __expf(li - lw), ipn = rcpf_(pin); \
        const float kdj = kf[j] * (1.0f + (a - 1.0f) * kac[j]); \
        bsum += rv_[j] * kdj * rkc[j]; \
        nkk[j] = -kk * pex; wv_[j] = pin; bv_[j] = kk * a * ipn; kd_[j] = kdj * ipn; rv_[j] = rv_[j] * pin; } \
    bsum += __shfl_xor(bsum, 16); bsum += __shfl_xor(bsum, 32); \
    if (kgrp == 0) *(float*)(wsb + (unsigned)(BIG(3) + (unsigned)((((d_) * T + t_) * 16 + (h_)) * 4 + hw) * 4u)) = bsum; \
    LAS float* sp_ = (stg_) + ((bufi) * 16 + ts) * STS + cown; \
    *(LAS f32x4*)(sp_) = nkk; *(LAS f32x4*)(sp_ + 64) = wv_; *(LAS f32x4*)(sp_ + 128) = bv_; *(LAS f32x4*)(sp_ + 192) = kd_; *(LAS f32x4*)(sp_ + 256) = rv_; *(LAS f32x4*)(sp_ + 320) = vv_; } while (0)
#define SVX_YSTORE(tok0_, L_, d_, h_, chunk, ybuf_, bufi) do { const int tt_ = (chunk) * 16 + ts, t_ = (tok0_) + ((d_) ? (L_) - 1 - tt_ : tt_); \
    const f32x4 y_ = *(const LAS f32x4*)((ybuf_) + ((bufi) * 16 + ts) * 64 + cown); \
    u32x2 w_; w_.x = cvt_pk_bf16(y_[0], y_[1]); w_.y = cvt_pk_bf16(y_[2], y_[3]); \
    *(u32x2*)(wsb + (unsigned)(BIG(1) + (unsigned)(d_) * (unsigned)BIGSZ + (unsigned)(t_ * D + (h_) * 64 + cown) * 2u)) = w_; } while (0)
#define SCAN_LDV(X, sp_) do { \
    X##nk0 = *(const LAS f32x4*)((sp_) + 8 * cg); X##nk1 = *(const LAS f32x4*)((sp_) + 8 * cg + 4); \
    X##b0 = *(const LAS f32x4*)((sp_) + 128 + 8 * cg); X##b1 = *(const LAS f32x4*)((sp_) + 128 + 8 * cg + 4); \
    X##k0 = *(const LAS f32x4*)((sp_) + 192 + 8 * cg); X##k1 = *(const LAS f32x4*)((sp_) + 192 + 8 * cg + 4); \
    X##r0 = *(const LAS f32x4*)((sp_) + 256 + 8 * cg); X##r1 = *(const LAS f32x4*)((sp_) + 256 + 8 * cg + 4); \
    X##vr = *(const LAS f32x2*)((sp_) + 320 + 16 * hw + 2 * rg); } while (0)
#define SCAN_STEP(X, yp_) do { \
    const f32x2 nk[4] = {{X##nk0[0], X##nk0[1]}, {X##nk0[2], X##nk0[3]}, {X##nk1[0], X##nk1[1]}, {X##nk1[2], X##nk1[3]}}; \
    const f32x2 bb[4] = {{X##b0[0], X##b0[1]}, {X##b0[2], X##b0[3]}, {X##b1[0], X##b1[1]}, {X##b1[2], X##b1[3]}}; \
    const f32x2 kd[4] = {{X##k0[0], X##k0[1]}, {X##k0[2], X##k0[3]}, {X##k1[0], X##k1[1]}, {X##k1[2], X##k1[3]}}; \
    const f32x2 rr[4] = {{X##r0[0], X##r0[1]}, {X##r0[2], X##r0[3]}, {X##r1[0], X##r1[1]}, {X##r1[2], X##r1[3]}}; \
    float yo[2]; \
    _Pragma("unroll") for (int a = 0; a < 2; ++a) { \
        f32x2 t = s[a][0] * nk[0]; t += s[a][1] * nk[1]; t += s[a][2] * nk[2]; t += s[a][3] * nk[3]; \
        const float sa = red8(t[0] + t[1]); \
        const f32x2 sa2 = (f32x2){sa, sa}, v2 = (f32x2){X##vr[a], X##vr[a]}; \
        _Pragma("unroll") for (int bp = 0; bp < 4; ++bp) s[a][bp] = s[a][bp] + sa2 * bb[bp] + v2 * kd[bp]; \
        f32x2 y = s[a][0] * rr[0]; y += s[a][1] * rr[1]; y += s[a][2] * rr[2]; y += s[a][3] * rr[3]; \
        yo[a] = y[0] + y[1]; } \
      \
    { float keep_ = cg < 4 ? yo[0] : yo[1]; const float send_ = cg < 4 ? yo[1] : yo[0]; \
      keep_ += dpp_f<0x141>(send_); keep_ += dpp_f<0xB1>(keep_); keep_ += dpp_f<0x4E>(keep_); \
      if ((cg & 3) == 0) *(LAS float*)((yp_) + (cg >> 2)) = keep_; } } while (0)
#define SCAN_RENORM(sp15_) do { const f32x4 p0_ = *(const LAS f32x4*)((sp15_) + 64 + 8 * cg), p1_ = *(const LAS f32x4*)((sp15_) + 64 + 8 * cg + 4); \
    const f32x2 pp_[4] = {{p0_[0], p0_[1]}, {p0_[2], p0_[3]}, {p1_[0], p1_[1]}, {p1_[2], p1_[3]}}; \
    _Pragma("unroll") for (int a = 0; a < 2; ++a) _Pragma("unroll") for (int bp = 0; bp < 4; ++bp) s[a][bp] = s[a][bp] * pp_[bp]; } while (0)
__device__ void scan_phase(KP p, int l, LAS unsigned char* lds) {
    const int il = l >> 1;
    const int tid = TIDX(), hb = tid >> 8, ht = tid & 255, hw = ht >> 6, lane = tid & 63, cg = lane & 7, rg = lane >> 3, G = GDIM();
    const int ts = lane & 15, kgrp = lane >> 4, cown = 16 * hw + 4 * kgrp;
    unsigned char* wsb = p->ws; const unsigned vboff = (unsigned)(il == 0 ? BIG(0) : BIG(6));
    LAS float* stg0 = (LAS float*)lds; LAS float* ybuf0 = stg0 + 2 * 16 * STS;
    LAS float* stg1 = (LAS float*)(lds + SCAN_HALF_BYTES); LAS float* ybuf1 = stg1 + 2 * 16 * STS;
    for (int slot = BIDX(); slot < 256; slot += G) {
        const int lh = (slot & 31) >> 1, ldir = slot & 1, ltok0 = TC + (slot >> 5) * 2048;
        f32x2 s[2][4];
        f32x4 Ank0, Ank1, Ab0, Ab1, Ak0, Ak1, Ar0, Ar1; f32x2 Avr;
        f32x4 Bnk0, Bnk1, Bb0, Bb1, Bk0, Bk1, Br0, Br1; f32x2 Bvr;
        if (hb == 0) {
            {
                const float* si = p->in[I_STATE] + ((size_t)(((slot >> 5) * 2 + il) * 2 + ldir) * 16 + lh) * 4096;
#pragma unroll
                for (int a = 0; a < 2; ++a)
#pragma unroll
                    for (int bp = 0; bp < 4; ++bp) s[a][bp] = __builtin_nontemporal_load((const f32x2*)(si + (16 * hw + 2 * rg + a) * 64 + 8 * cg + 2 * bp));
                float one = 1.0f; asm volatile("" : "+v"(one));
#pragma unroll
                for (int a = 0; a < 2; ++a)
#pragma unroll
                    for (int bp = 0; bp < 4; ++bp) s[a][bp] = s[a][bp] * one;
            }
            for (int ci = 0; ci < 128; ++ci) {
                const int buf = ci & 1;
                LDS_BARRIER();
                __builtin_amdgcn_s_setprio(2);
                const LAS float* sb = stg0 + (buf * 16) * STS; LAS float* yb = ybuf0 + (buf * 16) * 64 + 16 * hw + 2 * rg;
                SCAN_LDV(A, sb);
#pragma unroll
                for (int st = 0; st < 16; st += 2) {
                    SCAN_LDV(B, sb + (st + 1) * STS);
                    SCAN_STEP(A, yb + st * 64);
                    if (st + 2 < 16) SCAN_LDV(A, sb + (st + 2) * STS);
                    SCAN_STEP(B, yb + (st + 1) * 64);
                }
                SCAN_RENORM(sb + 15 * STS);
                __builtin_amdgcn_s_setprio(0);
                LDS_BARRIER();
            }
        } else {
            u32x2 Lk0, Lk1, Lk2, Lk3, Lr, Lv, Lvf; bf16x8 Ltw0, Ltw1, La0, La1, Lv1;
            u32x2 Sk0, Sk1, Sk2, Sk3, Sr, Sv, Svf; bf16x8 Stw0, Stw1, Sa0, Sa1, Sv1;
            Lvf = Svf = (u32x2){0u, 0u}; Lv1 = Sv1 = (bf16x8){0, 0, 0, 0, 0, 0, 0, 0};
#pragma unroll
            for (int a = 0; a < 2; ++a)
#pragma unroll
                for (int bp = 0; bp < 4; ++bp) s[a][bp] = (f32x2){0.f, 0.f};
            {
                SVX_GLOAD(L, ltok0, 2048, ldir, lh, 0);
                const int sid = slot * 2, sh = (sid & 31) >> 1, sd = sid & 1, stok0 = (sid >> 5) * 256;
                SVX_GLOAD(S, stok0, 256, sd, sh, 0);
                { SVX_CONSTS(ldir, lh) SVX_STAGE(L, ltok0, 2048, ldir, lh, 0, stg0, 0); }
                { SVX_CONSTS(sd, sh) SVX_STAGE(S, stok0, 256, sd, sh, 0, stg1, 0); }
                SVX_GLOAD(L, ltok0, 2048, ldir, lh, 1);
            }
            SVX_CONSTS(ldir, lh)
            for (int ci = 0; ci < 128; ++ci) {
                const int buf = ci & 1;
                LDS_BARRIER();
                if (ci + 1 < 128) SVX_STAGE(L, ltok0, 2048, ldir, lh, ci + 1, stg0, buf ^ 1);
                __builtin_amdgcn_sched_barrier(0);
                if (ci + 2 < 128) SVX_GLOAD(L, ltok0, 2048, ldir, lh, ci + 2);
                __builtin_amdgcn_sched_barrier(0);
                const int cj = (ci >> 2) & 15, q = ci & 3, sbuf = cj & 1;
                {
                    const LAS float* sb = stg1 + (sbuf * 16 + 4 * q) * STS; LAS float* yb = ybuf1 + (sbuf * 16 + 4 * q) * 64 + 16 * hw + 2 * rg;
                    SCAN_LDV(A, sb); SCAN_STEP(A, yb); __builtin_amdgcn_sched_barrier(0);
                    SCAN_LDV(A, sb + STS); SCAN_STEP(A, yb + 64); __builtin_amdgcn_sched_barrier(0);
                    SCAN_LDV(A, sb + 2 * STS); SCAN_STEP(A, yb + 128); __builtin_amdgcn_sched_barrier(0);
                    SCAN_LDV(A, sb + 3 * STS); SCAN_STEP(A, yb + 192);
                    if (q == 3) SCAN_RENORM(stg1 + (sbuf * 16 + 15) * STS);
                }
                __builtin_amdgcn_sched_barrier(0);
                const int gc = (ci >> 2) + 1;
                if (gc < 32 && (q == 0 || q == 2)) {
                    const int sid = slot * 2 + (gc >> 4), sh = (sid & 31) >> 1, sd = sid & 1, stok0 = (sid >> 5) * 256;
                    if (q == 0) SVX_GLOAD_A(S, stok0, 256, sd, sh, gc & 15);
                    else { SVX_GLOAD_B(S, stok0, 256, sd, sh, gc & 15); SVX_CONSTS(sd, sh) SVX_STAGE(S, stok0, 256, sd, sh, gc & 15, stg1, gc & 1); }
                }
                LDS_BARRIER();
                SVX_YSTORE(ltok0, 2048, ldir, lh, ci, ybuf0, buf);
                {
                    const int sid = slot * 2 + (ci >> 6), sb_ = sid >> 5, sh = (sid & 31) >> 1, sd = sid & 1, stok0 = sb_ * 256;
                    if (q == 3) SVX_YSTORE(stok0, 256, sd, sh, cj, ybuf1, sbuf);
                    if ((ci & 63) == 63) {
                        float* so = p->out + (size_t)T * D + ((size_t)((sb_ * 2 + il) * 2 + sd) * 16 + sh) * 4096;
#pragma unroll
                        for (int a = 0; a < 2; ++a)
#pragma unroll
                            for (int bp = 0; bp < 4; ++bp) { __builtin_nontemporal_store(s[a][bp], (f32x2*)(so + (16 * hw + 2 * rg + a) * 64 + 8 * cg + 2 * bp)); s[a][bp] = (f32x2){0.f, 0.f}; }
                    }
                }
            }
        }
        __syncthreads();
    }
}

__device__ void post_phase(KP p, int l) {
    const int il = l >> 1;
    const int lane = TIDX() & 63, gw = BIDX() * 8 + (TIDX() >> 6), nw = GDIM() * 8;
    const int tl = lane & 15, kg = lane >> 4;
    const bf16_t* G2T = (const bf16_t*)(p->ws + W_G2T); const bf16_t* SG = (const bf16_t*)(p->ws + WS_SG);
    const bf16_t* Y0 = (const bf16_t*)(p->ws + BIG(1)); const bf16_t* Y1 = (const bf16_t*)(p->ws + BIG(2));
    const bf16_t* Vb = (const bf16_t*)(p->ws + (il == 0 ? BIG(0) : BIG(7)));
    bf16_t* YG = (bf16_t*)(p->ws + BIG(4));
    const float* BONP = (const float*)(p->ws + BIG(3));
    const float* lng = p->in[I_LNG] + il * D; const float* lnb = p->in[I_LNB] + il * D;
    const int h = gw & 15, tlanes = nw >> 4;
    bf16x8 gfr[4][4]; f32x4 lgv[4], lbv[4];
#pragma unroll
    for (int n = 0; n < 4; ++n) {
#pragma unroll
        for (int ks = 0; ks < 4; ++ks) gfr[ks][n] = *(const bf16x8*)(G2T + (size_t)(h * 64 + n * 16 + tl) * 128 + ks * 32 + kg * 8);
        lgv[n] = *(const f32x4*)(lng + h * 64 + n * 16 + kg * 4); lbv[n] = *(const f32x4*)(lnb + h * 64 + n * 16 + kg * 4);
    }
    for (int tile = (gw < (nw & ~15)) ? (gw >> 4) : T; tile < T / 16; tile += tlanes) {
        const int tok0 = tile * 16, tk = tok0 + tl;
        f32x4 ag[4];
#pragma unroll
        for (int n = 0; n < 4; ++n) ag[n] = (f32x4){0.f, 0.f, 0.f, 0.f};
#pragma unroll
        for (int ks = 0; ks < 4; ++ks) {
            const bf16x8 bg = *(const bf16x8*)(SG + (size_t)tk * 128 + ks * 32 + kg * 8);
#pragma unroll
            for (int n = 0; n < 4; ++n) ag[n] = __builtin_amdgcn_mfma_f32_16x16x32_bf16(gfr[ks][n], bg, ag[n], 0, 0, 0);
        }
        f32x4 y[4]; float s1 = 0.f;
#pragma unroll
        for (int n = 0; n < 4; ++n) {
            const size_t off = (size_t)tk * D + h * 64 + n * 16 + kg * 4;
            const u32x2 a = *(const u32x2*)(Y0 + off), b = *(const u32x2*)(Y1 + off);
            y[n] = (f32x4){bflo(a.x) + bflo(b.x), bfhi(a.x) + bfhi(b.x), bflo(a.y) + bflo(b.y), bfhi(a.y) + bfhi(b.y)};
            s1 += y[n][0] + y[n][1] + y[n][2] + y[n][3];
        }
        s1 += __shfl_xor(s1, 16); s1 += __shfl_xor(s1, 32);
        const float mean = s1 * (1.0f / 64.0f); float s2 = 0.f;
#pragma unroll
        for (int n = 0; n < 4; ++n)
#pragma unroll
            for (int j = 0; j < 4; ++j) { const float dd = y[n][j] - mean; s2 += dd * dd; }
        s2 += __shfl_xor(s2, 16); s2 += __shfl_xor(s2, 32);
        const float rstd = rsqrtf(s2 * (1.0f / 64.0f) + 64e-5f);
        const f32x4 bq0 = *(const f32x4*)(BONP + ((size_t)tk * 16 + h) * 4), bq1 = *(const f32x4*)(BONP + ((size_t)(T + tk) * 16 + h) * 4);
        const float bon = ((bq0[0] + bq0[1]) + (bq0[2] + bq0[3])) + ((bq1[0] + bq1[1]) + (bq1[2] + bq1[3]));
#pragma unroll
        for (int n = 0; n < 4; ++n) {
            const int c = h * 64 + n * 16 + kg * 4; const size_t off = (size_t)tk * D + c;
            const u32x2 vv = *(const u32x2*)(Vb + off);
            const float vx[4] = {bflo(vv.x), bfhi(vv.x), bflo(vv.y), bfhi(vv.y)};
            const f32x4 gg = lgv[n], gb = lbv[n];
            float o[4];
#pragma unroll
            for (int j = 0; j < 4; ++j) o[j] = ((y[n][j] - mean) * rstd * gg[j] + gb[j] + bon * vx[j]) * ag[n][j];
            u32x2 w; w.x = cvt_pk_bf16(o[0], o[1]); w.y = cvt_pk_bf16(o[2], o[3]);
            *(u32x2*)(YG + off) = w;
        }
    }
}


#define XB_TMO      128
#define XB_XCNT(j)  (256  + 64 * (j))
#define XB_XSUB(j)  (1280 + 64 * (j))
#define XB_XGEN(j)  (2304 + 64 * (j))
#define XB_TOP      3328
#define XB_TOPGEN   3392
#define XCD_BAR_WORDS 3456
#define XB_SPIN_CAP (1u << 22)
__device__ __forceinline__ unsigned xb_ld(unsigned* p)              { return __hip_atomic_load(p, __ATOMIC_RELAXED, __HIP_MEMORY_SCOPE_AGENT); }
__device__ __forceinline__ unsigned xb_add(unsigned* p, unsigned v) { return __hip_atomic_fetch_add(p, v, __ATOMIC_RELAXED, __HIP_MEMORY_SCOPE_AGENT); }
__device__ __forceinline__ unsigned xb_xcc_id() { return (unsigned)__builtin_amdgcn_s_getreg((3 << 11) | 20) & 0xFu; }
#define XB_SPIN(cond, bar) do { unsigned _sp = 0; while (cond) { __builtin_amdgcn_s_sleep(1); \
    if ((++_sp & 255u) == 0u) { if (xb_ld(&(bar)[XB_TMO])) break; if (_sp > XB_SPIN_CAP) { atomicAdd(&(bar)[XB_TMO], 1u); break; } } } } while (0)
__device__ __forceinline__ void xcd_barrier_complete(unsigned* bar, unsigned x, unsigned& nloc, unsigned& nx) {
    const unsigned G = gridDim.x;
    unsigned sum, cnt, mine, sp = 0u;
    for (;;) {
        sum = 0u; cnt = 0u; mine = 0u;
#pragma unroll
        for (unsigned j = 0; j < 16; ++j) { const unsigned c = xb_ld(&bar[XB_XCNT(j)]); sum += c; cnt += (c > 0u) ? 1u : 0u; mine = (j == x) ? c : mine; }
        if (sum == G) break;
        __builtin_amdgcn_s_sleep(1);
        if ((++sp & 255u) == 0u) { if (xb_ld(&bar[XB_TMO])) break; if (sp > XB_SPIN_CAP) { atomicAdd(&bar[XB_TMO], 1u); break; } }
    }
    nloc = mine > 0u ? mine : 1u; nx = cnt > 0u ? cnt : 1u;
}
__device__ __forceinline__ void xcd_barrier(unsigned* bar, volatile LAS unsigned* st) {
    asm volatile("s_waitcnt vmcnt(0)" ::: "memory");
    __syncthreads();
    if (threadIdx.x == 0) {
        const unsigned x = xb_xcc_id();
        __builtin_amdgcn_s_waitcnt(0);
        unsigned nloc = st[0], nx = st[1];
        if (nloc == 0u) { xcd_barrier_complete(bar, x, nloc, nx); st[0] = nloc; st[1] = nx; }
        const unsigned old = xb_add(&bar[XB_XSUB(x)], 1u);
        const unsigned gen = old / nloc;
        if (old + 1u == (gen + 1u) * nloc) {
            __builtin_amdgcn_fence(__ATOMIC_RELEASE, "agent");
            asm volatile("s_waitcnt vmcnt(0)" ::: "memory");
            const unsigned og = xb_add(&bar[XB_TOP], 1u);
            const unsigned tg = og / nx;
            if (og + 1u == (tg + 1u) * nx) xb_add(&bar[XB_TOPGEN], 1u);
            else XB_SPIN(xb_ld(&bar[XB_TOPGEN]) == tg, bar);
            __builtin_amdgcn_fence(__ATOMIC_ACQUIRE, "agent");
            xb_add(&bar[XB_XGEN(x)], 1u);
            asm volatile("s_waitcnt vmcnt(0)" ::: "memory");
        } else {
            XB_SPIN(xb_ld(&bar[XB_XGEN(x)]) == gen, bar);
            __builtin_amdgcn_fence(__ATOMIC_ACQUIRE, "agent");
            asm volatile("s_waitcnt vmcnt(0)" ::: "memory");
        }
    }
    __syncthreads();
}

constexpr int N_PHASES = 1 + 7 + 9 + 7 + 9 + 1;


__device__ __forceinline__ int phase_opcode(int ph) {
    if (ph == 0) return 30;
    if (ph == N_PHASES - 1) return 31;
    int q = ph - 1, l;
    if (q < 7) l = 0; else if (q < 16) { l = 1; q -= 7; } else if (q < 23) { l = 2; q -= 16; } else { l = 3; q -= 23; }
    if ((l & 1) == 0) return q < 4 ? q : 10 + (q - 4);
    return q < 6 ? 20 + q : 10 + (q - 6);
}
#define REGION_T0() unsigned long long rt0_ = 0; if (PROFMASK != 0u && blockIdx.x == 0 && threadIdx.x == 0) rt0_ = __builtin_amdgcn_s_memrealtime()
#define REGION_T1(bit) do { if (PROFMASK != 0u && ((PROFMASK >> (bit)) & 1u) && blockIdx.x == 0 && threadIdx.x == 0) ((volatile LAS unsigned*)(lds + 131072))[2] += (unsigned)(__builtin_amdgcn_s_memrealtime() - rt0_); } while (0)
__device__ void run_phase(KP p, int ph, LAS unsigned char* lds) {
    const int G = GDIM(), bid = BIDX();
    unsigned char* ws = p->ws;
    const float* mod = (const float*)(ws + WS_MOD);
    if (ph == 0 && OPEN(30)) {
        if (DUP(14)) { ada_phase(p, lds); wconv_sgu(p, 0, (LAS float*)lds); }
        if (DUP(15)) { const unsigned long long t0 = __builtin_amdgcn_s_memrealtime(); while (__builtin_amdgcn_s_memrealtime() - t0 < 50000ull) __builtin_amdgcn_s_sleep(8); }
        ada_phase(p, lds);
        wconv_sgu(p, 0, (LAS float*)lds);
        return;
    }
    if (ph == N_PHASES - 1) { if (OPEN(31)) final_norm_phase(p); return; }
    int q = ph - 1, l;
    if (q < 7) l = 0; else if (q < 16) { l = 1; q -= 7; } else if (q < 23) { l = 2; q -= 16; } else { l = 3; q -= 23; }
    const bool sgu = (l & 1) == 0;
    const float* modl = mod + (size_t)l * 9 * 6144;
    int op;
    if (sgu) op = q < 4 ? q : 10 + (q - 4); else op = q < 6 ? 20 + q : 10 + (q - 6);
    const float* xp_lo = p->out; const float* xp_hi = p->out;
    if (l == 0 && op == 3) { xp_lo = p->in[I_XP]; xp_hi = p->in[I_XS] - (size_t)TC * D; }
    pg8::Sched S;
    switch (op) {
    case 0: if (!OPEN(0)) break;
        if (l > 0) { if (DUP(2)) wconv_sgu(p, l, (LAS float*)lds); wconv_sgu(p, l, (LAS float*)lds); }
        if (DUP(3)) norm_phase(p, l, 0, l == 0, (bf16_t*)(ws + BIG(1)));
        norm_phase(p, l, 0, l == 0, (bf16_t*)(ws + BIG(1)));
        break;
    case 1: if (!OPEN(1)) break; {
        S.init(ws + BIG(1), 0, ws + W_INT, 0, 8, D, T, 2048, G, bid);
        EpiGeluUV E{(bf16_t*)(ws + BIG(2)), (bf16_t*)(ws + BIG(3)), (float*)(ws + WS_VST)};
        if (DUP(12)) { pg8::gemm_phase(lds, S, E); __syncthreads(); }
        pg8::gemm_phase(lds, S, E);
    } break;
    case 2: if (!OPEN(2)) break; if (DUP(8)) sgu_mix_phase(p, l, lds); sgu_mix_phase(p, l, lds); break;
    case 3: if (!OPEN(3)) break; {
        S.init(ws + BIG(4), 0, ws + W_OUTT, 0, 4, D, T, D, G, bid);
        EpiRes E{xp_lo, xp_hi, p->out, modl, 2048, 0};
        if (DUP(13)) { EpiRes E2 = E; int dry = 1; asm volatile("" : "+s"(dry)); E2.dry = dry; pg8::gemm_phase(lds, S, E2); __syncthreads(); }
        pg8::gemm_phase(lds, S, E);
    } break;
    case 10: if (!OPEN(10)) break;
        if (sgu) { if (DUP(2)) wconv_rwkv_lora_down(p, l + 1, (LAS float*)lds); wconv_rwkv_lora_down(p, l + 1, (LAS float*)lds); }
        if (DUP(3)) norm_phase(p, l, 1, false, (bf16_t*)(ws + BIG(1)));
        norm_phase(p, l, 1, false, (bf16_t*)(ws + BIG(1)));
        break;
    case 11: if (!OPEN(11)) break; {
        const int merged = ((G == 256) && MERGED_MLP) ? 1 : 0;
        S.init(ws + BIG(1), 0, ws + W_MLP1T, 0, 16, D, T, DFF, G, bid, merged, (unsigned*)(ws + WS_RDY) + (size_t)l * 80 * 64);
        EpiBf16<1> E{(bf16_t*)(ws + BIG(2)), nullptr, nullptr, DFF, merged};
        pg8::gemm_phase(lds, S, E);
        if (!merged) break;
    }
    case 12: if (!OPEN(12)) break; {
        const int merged = ((G == 256) && MERGED_MLP) ? 2 : 0;
        pg8::Sched S2;
        S2.init(ws + BIG(2), 0, ws + W_MLP2T, 0, 4, DFF, T, D, G, bid, merged, (unsigned*)(ws + WS_RDY) + (size_t)l * 80 * 64);
        EpiRes E{p->out, p->out, p->out, modl, 5120, 0};
        pg8::gemm_phase(lds, S2, E);
    } break;
    case 20: if (!OPEN(20)) break;
        if (DUP(2)) wconv_rwkv_main(p, l, (LAS float*)lds);
        { REGION_T0(); wconv_rwkv_main(p, l, (LAS float*)lds); __syncthreads(); REGION_T1(26); }
        { REGION_T0(); rmix_phase(p, l, lds); REGION_T1(27); }
        break;
    case 21: if (!OPEN(21)) break; {
        S.init(ws + BIG(1), BIGSZ, ws + W_RT, 2 * MiB, 4, D, T, 3 * D, G, bid);
        EpiBf16<0> E{(bf16_t*)(ws + BIG(4)), (bf16_t*)(ws + BIG(5)), (bf16_t*)(ws + (l == 1 ? BIG(0) : BIG(6))), D, 0};
        if (DUP(11)) { pg8::gemm_phase(lds, S, E); __syncthreads(); }
        pg8::gemm_phase(lds, S, E);
    } break;
    case 22: break;
    case 23: if (!OPEN(23)) break; scan_phase(p, l, lds); break;
    case 24: if (!OPEN(24)) break; if (DUP(7)) post_phase(p, l); post_phase(p, l); break;
    case 25: if (!OPEN(25)) break; {
        S.init(ws + BIG(4), 0, ws + W_OT, 0, 4, D, T, D, G, bid);
        EpiRes E{p->out, p->out, p->out, modl, 2048, 0};
        pg8::gemm_phase(lds, S, E);
    } break;
    default: break;
    }
}

__global__ void __launch_bounds__(NTHREADS, 2) mega(Params p_unused) {
    extern __shared__ __attribute__((aligned(16))) unsigned char smem[];
    LAS unsigned char* lds = (LAS unsigned char*)smem;
#if MULTI_LAUNCH
    run_phase(kparams(), kparams()->ph_lo, lds);
#else
    cg::grid_group grid = cg::this_grid();
    const int lo = kparams()->ph_lo, hi = kparams()->ph_hi;
    volatile LAS unsigned* st = (volatile LAS unsigned*)(lds + 131072);
    if (threadIdx.x == 0) { st[0] = 0u; st[1] = 0u; st[2] = 0u; st[3] = 0u; }
    __syncthreads();
    if (threadIdx.x == 0) (void)xb_add(&((unsigned*)(kparams()->ws + WS_BAR))[XB_XCNT(xb_xcc_id())], 1u);
    if (lo > hi) grid.sync();
    for (int ph = lo; ph < hi; ++ph) {
        if (phase_opcode(ph) == 22) continue;
        if (phase_opcode(ph) == 12 && gridDim.x == 256 && MERGED_MLP) continue;
        unsigned long long t0 = 0;
        if (PROFMASK != 0u && blockIdx.x == 0 && threadIdx.x == 0) t0 = __builtin_amdgcn_s_memrealtime();
        run_phase(kparams(), ph, lds);
        if (ph + 1 < hi) xcd_barrier((unsigned*)(kparams()->ws + WS_BAR), (volatile LAS unsigned*)(lds + 131072));
        if (PROFMASK != 0u && blockIdx.x == 0 && threadIdx.x == 0 && ((PROFMASK >> phase_opcode(ph)) & 1u)) st[2] += (unsigned)(__builtin_amdgcn_s_memrealtime() - t0);
    }
    if (PROFMASK != 0u && blockIdx.x == 0 && threadIdx.x == 0) { const unsigned long long t0 = __builtin_amdgcn_s_memrealtime(); const unsigned long long dt = st[2]; while (__builtin_amdgcn_s_memrealtime() - t0 < dt) __builtin_amdgcn_s_sleep(8); }
#endif
}

extern "C" void kernel_launch(void* const* d_in, const int* in_sizes, int n_in, void* d_out, int out_size, void* d_ws, size_t ws_size, hipStream_t stream) {
    static int grid = 0;
    if (grid == 0) {
        int dev = 0, cus = 0, per_cu = 0;
        hipGetDevice(&dev);
        hipDeviceGetAttribute(&cus, hipDeviceAttributeMultiprocessorCount, dev);
        if (hipFuncSetAttribute((const void*)mega, hipFuncAttributeMaxDynamicSharedMemorySize, LDS_BYTES) != hipSuccess) { fprintf(stderr, "hipFuncSetAttribute failed\n"); grid = -1; return; }
        if (hipOccupancyMaxActiveBlocksPerMultiprocessor(&per_cu, (const void*)mega, NTHREADS, LDS_BYTES) != hipSuccess || per_cu < 1) { fprintf(stderr, "occupancy query failed (%d)\n", per_cu); per_cu = 1; }
        (void)hipGetLastError();
        grid = cus * (per_cu < 1 ? 1 : (per_cu > 1 ? 1 : per_cu));
        if (ws_size < BIG(8)) fprintf(stderr, "workspace too small: %zu < %zu\n", ws_size, (size_t)BIG(8));
    }
    if (grid < 0) return;
    Params hp{};
    for (int i = 0; i < N_IN; ++i) hp.in[i] = (const float*)d_in[i];
    hp.out = (float*)d_out; hp.ws = (unsigned char*)d_ws;
#if MULTI_LAUNCH
    for (int ph = 0; ph < N_PHASES; ++ph) {
        hp.ph_lo = ph; hp.ph_hi = ph + 1;
        hipLaunchKernelGGL(mega, dim3(grid), dim3(NTHREADS), LDS_BYTES, stream, hp);
    }
#else
    hp.ph_lo = 0; hp.ph_hi = N_PHASES;
    if (hipMemsetAsync((char*)d_ws + WS_BAR, 0, 16 * 1024 + 4 * 80 * 256, stream) != hipSuccess) { fprintf(stderr, "memset of barrier words failed\n"); return; }
    void* args[] = {&hp};
    hipError_t e = hipLaunchCooperativeKernel((const void*)mega, dim3(grid), dim3(NTHREADS), args, LDS_BYTES, stream);
    if (e != hipSuccess) fprintf(stderr, "cooperative launch failed: %s (grid %d)\n", hipGetErrorString(e), grid);
#endif
}
```
